# Optimizing an MI355X kernel written in HIP

```python
import math
import jax, jax.numpy as jnp
from jax import lax
import numpy as np

D_MODEL = 1024
BATCH = 1
SEQ = 16384
DEPTH = 2

A_HEADS = 4
A_HEAD_DIM = 64
A_WIDTH = A_HEADS * 2 * A_HEAD_DIM
Q_BLOCK = 128
B_WIDTH = 512
B_GROUPS = 4
B_GROUP_DIM = B_WIDTH // B_GROUPS
B_CHUNK = 128
C_HEADS = 8
C_HEAD_DIM = 64
C_WIDTH = C_HEADS * C_HEAD_DIM
C_PATTERNS = ((128, 1), (512, 4), (2048, 16))
C_BLOCK = 128
N_BRANCH = 3
BRANCH_WIDTH = 512
IN_COLS = 4 * A_WIDTH + 3 * B_WIDTH + 4 * C_WIDTH + N_BRANCH * D_MODEL
ROPE_THETA = 500000.0
ROPE_FRAC = 4
EPS = 1e-6

kernel_name = 'hybrid_diffattn_sgu_dilated_gated_merge'


def rmsnorm(t, g):
    tf = t.astype(jnp.float32)
    y = tf * lax.rsqrt(jnp.mean(tf * tf, axis=-1, keepdims=True) + EPS)
    return (y * g.astype(jnp.float32)).astype(t.dtype)


def layernorm(t, g, b):
    tf = t.astype(jnp.float32)
    mu = jnp.mean(tf, axis=-1, keepdims=True)
    var = jnp.mean(jnp.square(tf - mu), axis=-1, keepdims=True)
    y = (tf - mu) * lax.rsqrt(var + EPS)
    return (y * g.astype(jnp.float32) + b.astype(jnp.float32)).astype(t.dtype)


def partial_rope(t, positions):
    dh = t.shape[-1]
    rot = dh // ROPE_FRAC
    half = rot // 2
    inv = jnp.power(jnp.float32(ROPE_THETA), -jnp.arange(half, dtype=jnp.float32) * 2.0 / rot)
    ang = positions.astype(jnp.float32)[:, :, None] * inv
    cos = jnp.cos(ang)[:, :, None, :]
    sin = jnp.sin(ang)[:, :, None, :]
    tf = t.astype(jnp.float32)
    x1 = tf[..., :half]
    x2 = tf[..., half:rot]
    out = jnp.concatenate([x1 * cos - x2 * sin, x2 * cos + x1 * sin, tf[..., rot:]], axis=-1)
    return out.astype(t.dtype)


def split_cols(proj):
    sizes = [A_WIDTH, A_WIDTH, A_WIDTH, A_WIDTH,
             2 * B_WIDTH, B_WIDTH,
             C_WIDTH, C_WIDTH, C_WIDTH, C_WIDTH,
             N_BRANCH * D_MODEL]
    idx = np.cumsum(sizes)[:-1].tolist()
    return jnp.split(proj, idx, axis=-1)


def diff_attention(q, k, v, lam):
    B, S, H, _, d = q.shape
    nb = S // Q_BLOCK
    scale = 1.0 / math.sqrt(d)
    qb = q.reshape(B, nb, Q_BLOCK, H, 2, d).transpose(1, 0, 2, 3, 4, 5)
    kpos = jnp.arange(S)

    def block(args):
        i, qblk = args
        s = jnp.einsum('bqhmd,bkhmd->bhmqk', qblk, k,
                       preferred_element_type=jnp.float32) * scale
        qpos = i * Q_BLOCK + jnp.arange(Q_BLOCK)
        mask = kpos[None, :] <= qpos[:, None]
        s = jnp.where(mask, s, -jnp.inf)
        p = jax.nn.softmax(s, axis=-1)
        pd = p[:, :, 0] - lam * p[:, :, 1]
        return jnp.einsum('bhqk,bkhe->bqhe', pd.astype(v.dtype), v)

    out = lax.map(block, (jnp.arange(nb), qb))
    return out.transpose(1, 0, 2, 3, 4).reshape(B, S, H, 2 * d)


def dilated_window_attention(q, k, v, window, dil):
    B, S, H, dh = q.shape
    L = S // dil
    n_back = window // dil
    nb = -(-L // C_BLOCK)
    Lp = nb * C_BLOCK
    BD = B * dil
    scale = 1.0 / math.sqrt(dh)

    def to_sub(t):
        t = t.reshape(B, L, dil, H, dh).transpose(0, 2, 1, 3, 4).reshape(BD, L, H, dh)
        return jnp.pad(t, ((0, 0), (0, Lp - L), (0, 0), (0, 0)))

    def windows(t):
        t = jnp.pad(t, ((0, 0), (C_BLOCK, 0), (0, 0), (0, 0))).reshape(BD, nb + 1, C_BLOCK, H, dh)
        return jnp.concatenate([t[:, :-1], t[:, 1:]], axis=2)

    qb = to_sub(q).reshape(BD, nb, C_BLOCK, H, dh)
    kw = windows(to_sub(k))
    vw = windows(to_sub(v))
    s = jnp.einsum('bnqhd,bnkhd->bnhqk', qb, kw,
                   preferred_element_type=jnp.float32) * scale
    qi = jnp.arange(nb)[:, None, None] * C_BLOCK + jnp.arange(C_BLOCK)[None, :, None]
    ki = jnp.arange(nb)[:, None, None] * C_BLOCK - C_BLOCK + jnp.arange(2 * C_BLOCK)[None, None, :]
    rel = qi - ki
    mask = (rel >= 0) & (rel <= n_back) & (ki >= 0)
    s = jnp.where(mask[None, :, None], s, -jnp.inf)
    m = jnp.max(s, axis=-1, keepdims=True)
    e = jnp.exp(s - m)
    den = jnp.sum(e, axis=-1)
    o = jnp.einsum('bnhqk,bnkhd->bnqhd', e, vw.astype(jnp.float32))
    den_q = den.transpose(0, 1, 3, 2)
    o = o / den_q[..., None]
    lse = m[..., 0].transpose(0, 1, 3, 2) + jnp.log(den_q)

    def from_sub(t):
        rest = t.shape[3:]
        t = t.reshape((B, dil, Lp) + rest)[:, :, :L]
        t = jnp.moveaxis(t, 1, 2)
        return t.reshape((B, S) + rest)

    return from_sub(o), from_sub(lse)


def hybrid_layer(x, positions, layer_idx, norm_g, w_in, lam_q1, lam_k1, lam_q2, lam_k2,
                 subln_g, sgu_ln_g, sgu_ln_b, sgu_w, sgu_b, w_branch, w_out):
    B, S, D = x.shape
    h = rmsnorm(x, norm_g)
    proj = jnp.einsum('bsd,dc->bsc', h, w_in)
    aq, ak, av, az, buv, bz, cq, ck, cv, cz, gl = split_cols(proj)

    lam_init = 0.8 - 0.6 * math.exp(-0.3 * layer_idx)
    lam = (jnp.exp(jnp.sum(lam_q1.astype(jnp.float32) * lam_k1.astype(jnp.float32)))
           - jnp.exp(jnp.sum(lam_q2.astype(jnp.float32) * lam_k2.astype(jnp.float32)))
           + lam_init)
    qa = partial_rope(aq.reshape(B, S, 2 * A_HEADS, A_HEAD_DIM), positions).reshape(B, S, A_HEADS, 2, A_HEAD_DIM)
    ka = partial_rope(ak.reshape(B, S, 2 * A_HEADS, A_HEAD_DIM), positions).reshape(B, S, A_HEADS, 2, A_HEAD_DIM)
    va = av.reshape(B, S, A_HEADS, 2 * A_HEAD_DIM)
    oa = diff_attention(qa, ka, va, lam)
    oa = rmsnorm(oa, subln_g) * (1.0 - lam_init)
    ya = oa.reshape(B, S, A_WIDTH) * jax.nn.silu(az)

    uv = jax.nn.gelu(buv)
    u, vb = uv[..., :B_WIDTH], uv[..., B_WIDTH:]
    vb = layernorm(vb, sgu_ln_g, sgu_ln_b).reshape(B, S // B_CHUNK, B_CHUNK, B_GROUPS, B_GROUP_DIM)
    w_causal = sgu_w * jnp.tril(jnp.ones((B_CHUNK, B_CHUNK), dtype=sgu_w.dtype))
    mixed = jnp.einsum('gts,bnsgc->bntgc', w_causal, vb) + sgu_b.T[None, None, :, :, None]
    yb = u * mixed.reshape(B, S, B_WIDTH) * jax.nn.silu(bz)

    qc = partial_rope(cq.reshape(B, S, C_HEADS, C_HEAD_DIM), positions)
    kc = partial_rope(ck.reshape(B, S, C_HEADS, C_HEAD_DIM), positions)
    vc = cv.reshape(B, S, C_HEADS, C_HEAD_DIM)
    outs = []
    lses = []
    for window, dil in C_PATTERNS:
        o_p, lse_p = dilated_window_attention(qc, kc, vc, window, dil)
        outs.append(o_p)
        lses.append(lse_p)
    wts = jax.nn.softmax(jnp.stack(lses, axis=0), axis=0)
    oc = jnp.sum(wts[..., None] * jnp.stack(outs, axis=0), axis=0).astype(x.dtype)
    yc = oc.reshape(B, S, C_WIDTH) * jax.nn.silu(cz)

    ys = jnp.stack([ya, yb, yc], axis=0)
    pb = jnp.einsum('nbsc,ncd->nbsd', ys, w_branch)
    gates = jax.nn.sigmoid(gl.reshape(B, S, N_BRANCH, D))
    merged = jnp.einsum('bsnd,nbsd->bsd', gates, pb)
    return x + jnp.einsum('bsd,de->bse', merged, w_out)


def setup_inputs(seed: int = 0) -> dict:
    key = jax.random.key(seed)
    ks = jax.random.split(key, 16)
    f32 = jnp.float32
    x = jax.random.normal(ks[0], (BATCH, SEQ, D_MODEL), f32)
    positions = jnp.broadcast_to(jnp.arange(SEQ, dtype=jnp.int32)[None, :], (BATCH, SEQ))
    norm_g = 1.0 + 0.05 * jax.random.normal(ks[1], (DEPTH, D_MODEL), f32)
    w_in = jax.random.normal(ks[2], (DEPTH, D_MODEL, IN_COLS), f32) * D_MODEL ** -0.5
    lam_q1 = 0.1 * jax.random.normal(ks[3], (DEPTH, A_HEAD_DIM), f32)
    lam_k1 = 0.1 * jax.random.normal(ks[4], (DEPTH, A_HEAD_DIM), f32)
    lam_q2 = 0.1 * jax.random.normal(ks[5], (DEPTH, A_HEAD_DIM), f32)
    lam_k2 = 0.1 * jax.random.normal(ks[6], (DEPTH, A_HEAD_DIM), f32)
    subln_g = 1.0 + 0.05 * jax.random.normal(ks[7], (DEPTH, 2 * A_HEAD_DIM), f32)
    sgu_ln_g = 1.0 + 0.05 * jax.random.normal(ks[8], (DEPTH, B_WIDTH), f32)
    sgu_ln_b = 0.02 * jax.random.normal(ks[9], (DEPTH, B_WIDTH), f32)
    sgu_w = jax.random.normal(ks[10], (DEPTH, B_GROUPS, B_CHUNK, B_CHUNK), f32) * B_CHUNK ** -0.5
    sgu_b = 1.0 + 0.1 * jax.random.normal(ks[11], (DEPTH, B_GROUPS, B_CHUNK), f32)
    w_branch = jax.random.normal(ks[12], (DEPTH, N_BRANCH, BRANCH_WIDTH, D_MODEL), f32) * BRANCH_WIDTH ** -0.5
    w_out = jax.random.normal(ks[13], (DEPTH, D_MODEL, D_MODEL), f32) * (2.0 * D_MODEL) ** -0.5
    final_g = 1.0 + 0.05 * jax.random.normal(ks[14], (D_MODEL,), f32)
    return {'x': x, 'positions': positions, 'norm_g': norm_g, 'w_in': w_in,
            'lam_q1': lam_q1, 'lam_k1': lam_k1, 'lam_q2': lam_q2, 'lam_k2': lam_k2,
            'subln_g': subln_g, 'sgu_ln_g': sgu_ln_g, 'sgu_ln_b': sgu_ln_b,
            'sgu_w': sgu_w, 'sgu_b': sgu_b, 'w_branch': w_branch, 'w_out': w_out,
            'final_g': final_g}


def reference(x, positions, norm_g, w_in, lam_q1, lam_k1, lam_q2, lam_k2, subln_g,
              sgu_ln_g, sgu_ln_b, sgu_w, sgu_b, w_branch, w_out, final_g):
    h = x
    for l in range(DEPTH):
        h = hybrid_layer(h, positions, l, norm_g[l], w_in[l], lam_q1[l], lam_k1[l],
                         lam_q2[l], lam_k2[l], subln_g[l], sgu_ln_g[l], sgu_ln_b[l],
                         sgu_w[l], sgu_b[l], w_branch[l], w_out[l])
    return rmsnorm(h, final_g)
```

```cpp
#include <hip/hip_runtime.h>
#include <hip/hip_cooperative_groups.h>
#include <cstdio>
#include <cstdint>
#include <cmath>
#define MK_ONE_LAUNCH 0
namespace pg8 {
#define PG8_LAS __attribute__((address_space(3)))
typedef unsigned short bf16_t;
typedef short bf16x8 __attribute__((ext_vector_type(8)));
typedef float f32x4 __attribute__((ext_vector_type(4)));
typedef unsigned u32x4 __attribute__((ext_vector_type(4)));
constexpr int BM = 256, BK = 64, HALF = 128, HTB = HALF * BK * 2  , STAGE_BYTES = 8 * HTB, NXCD = 8, WGM = 8;

__host__ __device__ __forceinline__ int lds_byte(int r, int c) { const int st = (r >> 4) * 2 + (c >> 5), rr = r & 15, cc = c & 31, ob = rr * 64 + cc * 2; return st * 1024 + (ob ^ (((ob >> 9) & 1) << 5)); }
__host__ __device__ __forceinline__ void stage_rc(int b, int& R, int& C) { const int st = b / 1024, sb = b % 1024, swz = sb ^ (((sb >> 9) & 1) << 5); R = (st >> 1) * 16 + swz / 64; C = (st & 1) * 32 + (swz % 64) / 2; }
__host__ __device__ __forceinline__ int perm32(int rho) { const int n = rho >> 4, i = rho & 15; return 8 * (i >> 2) + 4 * n + (i & 3); }

struct Unit { int pm, pn; };
struct Gemm { const bf16_t* A; const bf16_t* Bt; int M, N, K; };

struct StaticOrder {
    int nM, nN, nwg, G, c;
    __host__ __device__ void init(int M, int N, int G_, int c_) { nM = M / BM; nN = N / BM; nwg = nM * nN; G = G_; c = c_; }
    __host__ __device__ bool next(int i, Unit& u) const {
        const long L = (long)i * G + c; if (L >= nwg) return false;
        int wgid = (int)L; { const int q = nwg / NXCD, r = nwg % NXCD, xcd = wgid % NXCD, off = wgid / NXCD; wgid = (xcd < r ? xcd * (q + 1) : r * (q + 1) + (xcd - r) * q) + off; }
        const int nig = WGM * nN, gid = wgid / nig, fm = gid * WGM, gsz = (nM - fm) < WGM ? (nM - fm) : WGM;
        u.pm = fm + ((wgid % nig) % gsz); u.pn = (wgid % nig) / gsz; return true;
    }
    __device__ __forceinline__ void a_ready(const Unit&) const {}
    __device__ __forceinline__ void done(const Unit&) const {}
};

__device__ __forceinline__ unsigned cvt_pk_bf16(float lo, float hi) { unsigned r; asm volatile("v_cvt_pk_bf16_f32 %0, %1, %2" : "=v"(r) : "v"(lo), "v"(hi)); return r; }
typedef float f32x2 __attribute__((ext_vector_type(2)));
template <class Epi, class Sched, bool ALIGN_EPI = false, bool SP2 = false>
__device__ __forceinline__ void gemm_phase(PG8_LAS unsigned char* lds, const Gemm g, const Sched& S, const Epi& E) {
    int tid_ = threadIdx.x; asm volatile("" : "+v"(tid_));
    const int tid = tid_, wid = __builtin_amdgcn_readfirstlane(tid >> 6), lane = tid & 63, wr = wid >> 2, wc = wid & 3, fr = lane & 15, fq = lane >> 4;
    const int K = g.K, nt = K / BK;
    unsigned voffA[2], voffB[2];
#pragma unroll
    for (int i = 0; i < 2; ++i) { int R, C; stage_rc(tid * 16 + i * 8192, R, C); const int Rb = Epi::PERM ? ((R & ~31) + perm32(R & 31)) : R;
        voffA[i] = (unsigned)(R * K + C) * 2u; voffB[i] = (unsigned)(Rb * K + C) * 2u; }
    const size_t kstep = (size_t)(BK * 2);
    const size_t hstep = (size_t)HALF * K * 2;
    const size_t tstep = 2 * hstep;
    const unsigned ldsw = (unsigned)wid * 1024u;
    const int aoff = lds_byte(wr * 64 + fr, fq * 8), boff = lds_byte(wc * 32 + fr, fq * 8);
#define PG8_SA(b, h) (((b) * 2 + (h)) * HTB)
#define PG8_SB(b, h) ((4 + (b) * 2 + (h)) * HTB)
#define PG8_STAGE(bufoff, gbase, voff) do { _Pragma("unroll") for (int _i = 0; _i < 2; ++_i) \
        __builtin_amdgcn_global_load_lds((const unsigned*)((const char*)(gbase) + (voff)[_i]), (PG8_LAS unsigned*)(lds + (bufoff) + ldsw + _i * 8192), 16, 0, 0); } while (0)
#define PG8_LDA(dst, b, h) do { _Pragma("unroll") for (int m = 0; m < 4; ++m) _Pragma("unroll") for (int k = 0; k < 2; ++k) dst[m][k] = *(const PG8_LAS bf16x8*)(lds + PG8_SA(b, h) + aoff + m * 2048 + k * 1024); } while (0)
#define PG8_LDB(dst, b, h) do { _Pragma("unroll") for (int n = 0; n < 2; ++n) _Pragma("unroll") for (int k = 0; k < 2; ++k) dst[n][k] = *(const PG8_LAS bf16x8*)(lds + PG8_SB(b, h) + boff + n * 2048 + k * 1024); } while (0)
#define PG8_MMA(ai, bj, At, Bt) do { __builtin_amdgcn_s_setprio(1); _Pragma("unroll") for (int m = 0; m < 4; ++m) _Pragma("unroll") for (int n = 0; n < 2; ++n) _Pragma("unroll") for (int k = 0; k < 2; ++k) \
        acc[ai][bj][m][n] = __builtin_amdgcn_mfma_f32_16x16x32_bf16(Bt[n][k], At[m][k], acc[ai][bj][m][n], 0, 0, 0); __builtin_amdgcn_s_setprio(0); } while (0)
#define PG8_WAIT_V(n) asm volatile("s_waitcnt vmcnt(" #n ")" ::: "memory")
#define PG8_WAIT_L(n) asm volatile("s_waitcnt lgkmcnt(" #n ")" ::: "memory")
#define PG8_BAR __builtin_amdgcn_s_barrier()
#define PG8_SCHED __builtin_amdgcn_sched_barrier(0)
    Unit cur, nxt; int ui = 0;
    if (!S.next(0, cur)) return;
    f32x4 acc[2][2][4][2];
#pragma unroll
    for (int a = 0; a < 2; ++a)
#pragma unroll
        for (int b = 0; b < 2; ++b)
#pragma unroll
            for (int m = 0; m < 4; ++m)
#pragma unroll
                for (int n = 0; n < 2; ++n) acc[a][b][m][n] = (f32x4){0.f, 0.f, 0.f, 0.f};
    bf16x8 At[4][2], B0[2][2], B1[2][2];
    const char* cA = (const char*)g.A + (size_t)cur.pm * tstep; const char* cB = (const char*)g.Bt + (size_t)cur.pn * tstep;
    S.a_ready(cur);
    if constexpr (SP2) {
        PG8_STAGE(PG8_SB(0, 0), cB, voffB); PG8_STAGE(PG8_SB(0, 1), cB + hstep, voffB); PG8_STAGE(PG8_SA(0, 0), cA, voffA); PG8_STAGE(PG8_SA(0, 1), cA + hstep, voffA);
        if (wr == 1) PG8_BAR;
        PG8_WAIT_V(2); PG8_BAR;
        PG8_STAGE(PG8_SB(1, 0), cB + kstep, voffB); PG8_STAGE(PG8_SA(1, 0), cA + kstep, voffA); PG8_STAGE(PG8_SB(1, 1), cB + hstep + kstep, voffB);
        PG8_WAIT_V(6); PG8_BAR;
    } else {
        PG8_STAGE(PG8_SB(0, 0), cB, voffB); PG8_STAGE(PG8_SA(0, 0), cA, voffA); PG8_STAGE(PG8_SB(0, 1), cB + hstep, voffB); PG8_STAGE(PG8_SA(0, 1), cA + hstep, voffA);
        if (wr == 1) PG8_BAR;
        PG8_WAIT_V(4); PG8_BAR;
        PG8_STAGE(PG8_SB(1, 0), cB + kstep, voffB); PG8_STAGE(PG8_SA(1, 0), cA + kstep, voffA); PG8_STAGE(PG8_SB(1, 1), cB + hstep + kstep, voffB);
        PG8_WAIT_V(6); PG8_BAR;
    }
    for (;;) {
        const bool has_next = S.next(ui + 1, nxt);
        const char* nA = has_next ? (const char*)g.A + (size_t)nxt.pm * tstep : cA; const char* nB = has_next ? (const char*)g.Bt + (size_t)nxt.pn * tstep : cB;
        for (int t = 0; t < nt; t += 2) {
            const bool last = (t == nt - 2);
            const char* a1 = cA + (size_t)(t + 1) * kstep;
            const char* a2 = last ? nA : cA + (size_t)(t + 2) * kstep; const char* b2 = last ? nB : cB + (size_t)(t + 2) * kstep;
            const char* a3 = a2 + kstep; const char* b3 = b2 + kstep;
            if (last && has_next) S.a_ready(nxt);
            if constexpr (SP2) {
            PG8_LDB(B0, 0, 0); PG8_LDB(B1, 0, 1); PG8_SCHED; PG8_LDA(At, 0, 0); PG8_STAGE(PG8_SA(1, 1), a1 + hstep, voffA);
            PG8_WAIT_V(8); PG8_WAIT_L(0); PG8_BAR; PG8_MMA(0, 0, At, B0); PG8_MMA(0, 1, At, B1); PG8_BAR; PG8_SCHED;
            PG8_LDA(At, 0, 1); PG8_STAGE(PG8_SB(0, 0), b2, voffB); PG8_STAGE(PG8_SB(0, 1), b2 + hstep, voffB); PG8_STAGE(PG8_SA(0, 0), a2, voffA);
            PG8_WAIT_V(8); PG8_WAIT_L(0); PG8_BAR; PG8_MMA(1, 0, At, B0); PG8_MMA(1, 1, At, B1); PG8_BAR; PG8_SCHED;
            PG8_LDB(B0, 1, 0); PG8_LDB(B1, 1, 1); PG8_SCHED; PG8_LDA(At, 1, 0); PG8_STAGE(PG8_SA(0, 1), a2 + hstep, voffA);
            PG8_WAIT_V(8); PG8_WAIT_L(0); PG8_BAR; PG8_MMA(0, 0, At, B0); PG8_MMA(0, 1, At, B1); PG8_BAR; PG8_SCHED;
            PG8_LDA(At, 1, 1); PG8_STAGE(PG8_SB(1, 0), b3, voffB); PG8_STAGE(PG8_SB(1, 1), b3 + hstep, voffB); PG8_STAGE(PG8_SA(1, 0), a3, voffA);
            PG8_WAIT_V(8); PG8_WAIT_L(0); PG8_BAR; PG8_MMA(1, 0, At, B0); PG8_MMA(1, 1, At, B1); PG8_BAR; PG8_SCHED;
            } else {
            PG8_LDB(B0, 0, 0); PG8_SCHED; PG8_LDA(At, 0, 0); PG8_STAGE(PG8_SA(1, 1), a1 + hstep, voffA);
            PG8_WAIT_L(8); PG8_BAR; PG8_WAIT_L(0); PG8_MMA(0, 0, At, B0); PG8_BAR; PG8_SCHED;
            PG8_LDB(B1, 0, 1); PG8_STAGE(PG8_SB(0, 0), b2, voffB);
            PG8_BAR; PG8_WAIT_L(0); PG8_MMA(0, 1, At, B1); PG8_BAR;
            PG8_LDA(At, 0, 1); PG8_STAGE(PG8_SA(0, 0), a2, voffA);
            PG8_BAR; PG8_WAIT_L(0); PG8_MMA(1, 0, At, B0); PG8_BAR; PG8_SCHED;
            PG8_STAGE(PG8_SB(0, 1), b2 + hstep, voffB);
            PG8_WAIT_V(6); PG8_BAR; PG8_MMA(1, 1, At, B1); PG8_BAR;
            PG8_LDB(B0, 1, 0); PG8_SCHED; PG8_LDA(At, 1, 0); PG8_STAGE(PG8_SA(0, 1), a2 + hstep, voffA);
            PG8_WAIT_L(8); PG8_BAR; PG8_WAIT_L(0); PG8_MMA(0, 0, At, B0); PG8_BAR; PG8_SCHED;
            PG8_LDB(B1, 1, 1); PG8_STAGE(PG8_SB(1, 0), b3, voffB);
            PG8_BAR; PG8_WAIT_L(0); PG8_MMA(0, 1, At, B1); PG8_BAR;
            PG8_LDA(At, 1, 1); PG8_STAGE(PG8_SA(1, 0), a3, voffA);
            PG8_BAR; PG8_WAIT_L(0); PG8_MMA(1, 0, At, B0); PG8_BAR; PG8_SCHED;
            PG8_STAGE(PG8_SB(1, 1), b3 + hstep, voffB);
            PG8_WAIT_V(6); PG8_BAR; PG8_MMA(1, 1, At, B1); PG8_BAR;
            }
        }
        if constexpr (ALIGN_EPI) { if (wr == 0) PG8_BAR; }
        if constexpr (!Epi::AFTER_DRAIN) { E(acc, cur, wr, wc, fr, fq); S.done(cur); }
        if (!has_next) break;
#pragma unroll
        for (int a = 0; a < 2; ++a)
#pragma unroll
            for (int b = 0; b < 2; ++b)
#pragma unroll
                for (int m = 0; m < 4; ++m)
#pragma unroll
                    for (int n = 0; n < 2; ++n) acc[a][b][m][n] = (f32x4){0.f, 0.f, 0.f, 0.f};
        cur = nxt; cA = nA; cB = nB; ++ui;
        if constexpr (ALIGN_EPI) { if (wr == 1) PG8_BAR; }
    }
    PG8_WAIT_V(0);
    if constexpr (!ALIGN_EPI) { if (wr == 0) PG8_BAR; }
    PG8_BAR;
    if constexpr (Epi::AFTER_DRAIN) { E.fused(acc, cur, wr, wc, fr, fq, lds, wid, lane); S.done(cur); }
#undef PG8_SA
#undef PG8_SB
#undef PG8_STAGE
#undef PG8_LDA
#undef PG8_LDB
#undef PG8_MMA
#undef PG8_WAIT_V
#undef PG8_WAIT_L
#undef PG8_BAR
#undef PG8_SCHED
}
}
#include <hip/hip_bf16.h>
namespace attn_body {
using bf16=__hip_bfloat16;
using bf16x8=__attribute__((ext_vector_type(8)))short;
using s16x4=__attribute__((ext_vector_type(4)))short;
using f32x16=__attribute__((ext_vector_type(16)))float;
using u32x4=__attribute__((ext_vector_type(4)))unsigned;
constexpr int SEQ=16384,D=64,PQ=512,PK=512,PV=512,PO=1024;
constexpr int NW=8,QBLK=32,QB=QBLK*NW,KVBLK=64,NQB=SEQ/QB;
constexpr int ATTN_UNIT_ROWS=QB;
__device__ __forceinline__ int crow(int r,int hi){return (r&3)+8*(r>>2)+4*hi;}
#define SBAR() __builtin_amdgcn_sched_barrier(0)
__device__ __forceinline__ void cmask(f32x16&p0,f32x16&p1,int jb,int qrel,int hi){
  const float NEG=-INFINITY; int kb=64*jb+4*hi;
  #pragma unroll
  for(int r=0;r<16;++r){int kv=kb+(r&3)+8*(r>>2); if(kv>qrel)p0[r]=NEG; if(kv+32>qrel)p1[r]=NEG;}
}

constexpr int NSLOT=3, SLOTB=8192;
constexpr int LDS_K=0, LDS_V=NSLOT*SLOTB, LDS_WS=2*NSLOT*SLOTB, LDS_OST=LDS_WS+NW*64*4, LDS_BYTES=LDS_OST+NW*4096;
constexpr float C2=0.125f*1.4426950408889634f;
__device__ __forceinline__ void glds16(const void*gsrc,unsigned lds_dst){unsigned keep;
  asm volatile("s_mov_b32 %0, m0\n\ts_mov_b32 m0, %2\n\ts_nop 0\n\tglobal_load_lds_dwordx4 %1, off\n\ts_mov_b32 m0, %0":"=&s"(keep):"v"(gsrc),"s"(lds_dst):"memory");}
__device__ __forceinline__ float max3f(float a,float b,float c){float r;asm("v_max3_f32 %0, %1, %2, %3":"=v"(r):"v"(a),"v"(b),"v"(c));return r;}
__device__ __forceinline__ float max2f(float a,float b){float r;asm("v_max_f32_e32 %0, %1, %2":"=v"(r):"v"(a),"v"(b));return r;}
__device__ __forceinline__ float fadd_s(float a,float b){float r;asm("v_add_f32_e32 %0, %1, %2":"=v"(r):"v"(a),"v"(b));return r;}
__device__ __forceinline__ float fsub_s(float a,float b){float r;asm("v_sub_f32_e32 %0, %1, %2":"=v"(r):"v"(a),"v"(b));return r;}
typedef float f32x2_t __attribute__((ext_vector_type(2))); typedef __bf16 bf16x2_t __attribute__((ext_vector_type(2)));
__device__ __forceinline__ unsigned cvtpk_s(float lo,float hi){f32x2_t v={lo,hi};bf16x2_t b=__builtin_convertvector(v,bf16x2_t);return __builtin_bit_cast(unsigned,b);}
#define WAIT_BAR(N) asm volatile("s_waitcnt vmcnt(" #N ") lgkmcnt(0)\n\ts_barrier":::"memory")

__device__ __forceinline__ void qkt(f32x16&p0,f32x16&p1,const char*Kslot,const bf16x8*qr,const f32x16&negm,int r32,int hi){
  const char*kb=Kslot+hi*1024+r32*16;
  #pragma unroll
  for(int d0=0;d0<4;++d0){
    const bf16x8 b0=*reinterpret_cast<const bf16x8*>(kb+d0*2048);
    const bf16x8 b1=*reinterpret_cast<const bf16x8*>(kb+d0*2048+512);
    if(d0==0){p0=__builtin_amdgcn_mfma_f32_32x32x16_bf16(b0,qr[0],negm,0,0,0);p1=__builtin_amdgcn_mfma_f32_32x32x16_bf16(b1,qr[0],negm,0,0,0);}
    else{p0=__builtin_amdgcn_mfma_f32_32x32x16_bf16(b0,qr[d0],p0,0,0,0);p1=__builtin_amdgcn_mfma_f32_32x32x16_bf16(b1,qr[d0],p1,0,0,0);}}
}
typedef __attribute__((address_space(3))) const char* lds_cptr;
typedef short v4i16_t __attribute__((ext_vector_type(4)));
__device__ __forceinline__ void kload8(bf16x8*kf,lds_cptr kp){
  kf[0]=*(const __attribute__((address_space(3))) bf16x8*)(kp);      kf[1]=*(const __attribute__((address_space(3))) bf16x8*)(kp+512);
  kf[2]=*(const __attribute__((address_space(3))) bf16x8*)(kp+2048); kf[3]=*(const __attribute__((address_space(3))) bf16x8*)(kp+2560);
  kf[4]=*(const __attribute__((address_space(3))) bf16x8*)(kp+4096); kf[5]=*(const __attribute__((address_space(3))) bf16x8*)(kp+4608);
  kf[6]=*(const __attribute__((address_space(3))) bf16x8*)(kp+6144); kf[7]=*(const __attribute__((address_space(3))) bf16x8*)(kp+6656);
}
__device__ __forceinline__ void kload2(bf16x8*kf,lds_cptr kp,int j){ kf[2*j]=*(const __attribute__((address_space(3))) bf16x8*)(kp+j*2048); kf[2*j+1]=*(const __attribute__((address_space(3))) bf16x8*)(kp+j*2048+512); }
__device__ __forceinline__ s16x4 vtr(lds_cptr p){ return __builtin_bit_cast(s16x4,__builtin_amdgcn_ds_read_tr16_b64_v4i16((__attribute__((address_space(3))) v4i16_t*)p)); }
__device__ __forceinline__ float rowmax(const f32x16&p0,const f32x16&p1){
  float a=max3f(p0[0],p0[1],p1[0]),b=max3f(p0[2],p0[3],p1[1]);a=max3f(a,p1[2],p1[3]);
  #pragma unroll
  for(int r=4;r<16;r+=4){a=max3f(a,p0[r],p0[r+1]);b=max3f(b,p0[r+2],p0[r+3]);a=max3f(a,p1[r],p1[r+1]);b=max3f(b,p1[r+2],p1[r+3]);}
  const float m=max2f(a,b);
  auto rr=__builtin_amdgcn_permlane32_swap(__float_as_uint(m),__float_as_uint(m),false,false);
  return max2f(__uint_as_float(rr[0]),__uint_as_float(rr[1]));
}
__device__ __forceinline__ void pv(f32x16*o,int vb,bf16x8 pa0,bf16x8 pa1,bf16x8 pa2,bf16x8 pa3){
  #pragma unroll
  for(int d0=0;d0<2;++d0){s16x4 lo[4],hi[4];
    #pragma unroll
    for(int ks=0;ks<4;++ks){
      asm volatile("ds_read_b64_tr_b16 %0,%1 offset:%c2":"=&v"(lo[ks]):"v"(vb),"i"(d0*4096+ks*1024):"memory");
      asm volatile("ds_read_b64_tr_b16 %0,%1 offset:%c2":"=&v"(hi[ks]):"v"(vb),"i"(d0*4096+ks*1024+512):"memory");}
    asm volatile("s_waitcnt lgkmcnt(0)":::"memory");SBAR();
    #define PK(k) (bf16x8){lo[k][0],lo[k][1],lo[k][2],lo[k][3],hi[k][0],hi[k][1],hi[k][2],hi[k][3]}
    o[d0]=__builtin_amdgcn_mfma_f32_32x32x16_bf16(pa0,PK(0),o[d0],0,0,0);
    o[d0]=__builtin_amdgcn_mfma_f32_32x32x16_bf16(pa1,PK(1),o[d0],0,0,0);
    o[d0]=__builtin_amdgcn_mfma_f32_32x32x16_bf16(pa2,PK(2),o[d0],0,0,0);
    o[d0]=__builtin_amdgcn_mfma_f32_32x32x16_bf16(pa3,PK(3),o[d0],0,0,0);
    #undef PK
  }
}

#ifndef ATTN_STORE16
#define ATTN_STORE16(p,v) (*(u32x4*)(p)=(v))
#endif
template<int THRL> __device__ __forceinline__ void attn_unit(int qb,const bf16*Q,const bf16*__restrict__ Kh,const bf16*__restrict__ Vh,bf16*O,char*shm){
  int tid_=threadIdx.x; asm volatile("":"+v"(tid_)); const int tid=tid_,lane=tid&63,r32=lane&31,hi=lane>>5; const int wid=__builtin_amdgcn_readfirstlane(tid>>6);
  const int q0=qb*QB;
  const bf16*Qw=Q+(long)(q0+wid*QBLK)*PQ;
  const unsigned lds0=(unsigned)(uintptr_t)shm;
  float*wsf=(float*)(shm+LDS_WS)+wid*64;
  const bf16*ksrc=Kh+(long)lane*PK+wid*8;
  const bf16*vsrc=Vh+(long)(16*(wid&3)+(lane>>2))*PV+(wid>>2)*32+(lane&3)*8;
  const unsigned kdst=lds0+LDS_K+wid*1024, vdst=lds0+LDS_V+wid*1024;
  #define DMA_K(t,slot) glds16(ksrc+(long)(t)*KVBLK*PK,(unsigned)__builtin_amdgcn_readfirstlane(kdst+(slot)))
  #define DMA_V(t,slot) glds16(vsrc+(long)(t)*KVBLK*PV,(unsigned)__builtin_amdgcn_readfirstlane(vdst+(slot)))
  const int vb0=(int)(lds0+LDS_V)+((lane>>4)&1)*32+(lane&3)*8+(4*hi+((lane&15)>>2))*64;
  const char*Kbase=shm+LDS_K; bf16x8 kf[8];
  const lds_cptr shm3=(lds_cptr)shm; const lds_cptr kp0=shm3+LDS_K+hi*1024+r32*16; const lds_cptr vp0=shm3+LDS_V+((lane>>4)&1)*32+(lane&3)*8+(4*hi+((lane&15)>>2))*64;
  const int NT=(q0+QB)/KVBLK;
  DMA_K(0,0);DMA_V(0,0);DMA_K(1,SLOTB);
  bf16x8 qr[4];
  #pragma unroll
  for(int d0=0;d0<4;++d0)qr[d0]=*reinterpret_cast<const bf16x8*>(&Qw[(long)r32*PQ+d0*16+hi*8]);
  float mhat=0.f,l_reg=0.f;f32x16 o[2];o[0]=f32x16{};o[1]=f32x16{};f32x16 negm=f32x16{};asm volatile("":"+v"(negm));
  const int qrel=wid*QBLK+r32;
  #define CMASK(P0,P1,t) do{int jb_=(t)-(NT-4); if(jb_>=0)cmask(P0,P1,jb_,qrel,hi);}while(0)
  bool resc=false;
  #define START(P0,P1) do{ const float rm=rowmax(P0,P1); resc=false; \
    { const float dl=rm; mhat=fadd_s(mhat,dl); \
      _Pragma("unroll") for(int r=0;r<16;++r){P0[r]=fsub_s(P0[r],dl);P1[r]=fsub_s(P1[r],dl);} \
      _Pragma("unroll") for(int r=0;r<16;++r)negm[r]=-mhat; asm volatile("":"+v"(negm)); } \
    _Pragma("unroll") for(int r=0;r<16;++r)P0[r]=__builtin_amdgcn_exp2f(P0[r]); }while(0)
  #define RESC() do{ if(resc){ asm volatile("s_waitcnt lgkmcnt(0)":::"memory"); \
      _Pragma("unroll") for(int d_=0;d_<2;++d_) _Pragma("unroll") for(int r=0;r<16;++r)o[d_][r]*=wsf[crow(r,hi)]; } }while(0)
  f32x16 pA0,pA1,pB0,pB1;
  int sl_prev=0,sl_cur=0,sl_next=SLOTB;
  #define ROT() do{sl_prev=sl_cur;sl_cur=sl_next;sl_next=(sl_next==(NSLOT-1)*SLOTB)?0:sl_next+SLOTB;}while(0)
  DMA_K(2,2*SLOTB);
  WAIT_BAR(3);
  qkt(pA0,pA1,Kbase,qr,negm,r32,hi);asm volatile("s_nop 15\n\ts_nop 7":"+v"(pA0),"+v"(pA1));CMASK(pA0,pA1,0);
  START(pA0,pA1);
  _Pragma("unroll") for(int r=0;r<16;++r)pA1[r]=__builtin_amdgcn_exp2f(pA1[r]);
  WAIT_BAR(0);
  DMA_K(3,0);DMA_V(1,SLOTB);
  ROT();
  kload8(kf,kp0+sl_cur);
  WAIT_BAR(2);
  s16x4 vlo[8],vhi[8]; u32x4 pw0,pw1,pw2,pw3;
  #define PKW(P,B) cvtpk_s(P[B],P[B+1])
  #define PAF(k) __builtin_bit_cast(bf16x8,pw##k)
  #define VFR(i) (bf16x8){vlo[i][0],vlo[i][1],vlo[i][2],vlo[i][3],vhi[i][0],vhi[i][1],vhi[i][2],vhi[i][3]}
  #define PIN(x) asm volatile("":"+v"(x))
  #define MX3(a,b,c) __builtin_fmaxf(__builtin_fmaxf((a),(b)),(c))
  #define GAPA(MF,A0,A1,A2,A3,W0,W1,PW) do{ MF; sacc+=A0; sacc+=A1; sacc+=A2; sacc+=A3; PIN(sacc); W0; W1; PIN(PW); SBAR(); }while(0)
  #define EX(v) __builtin_amdgcn_exp2f(v)
  #define GAPB(MF,X,B) do{ MF; X[B]=EX(X[B]); X[B+1]=EX(X[B+1]); X[B+2]=EX(X[B+2]); X[B+3]=EX(X[B+3]); PIN(X); SBAR(); }while(0)
  #define VRD(i) do{ vlo[i]=vtr(vp_+(((i)>>2)*4096+((i)&3)*1024)); vhi[i]=vtr(vp_+(((i)>>2)*4096+((i)&3)*1024+512)); }while(0)
  #define KRD(G,j) do{ if(G){ kload2(kf,kp0+sl_next,j); SBAR(); } }while(0)
  #define STEP(C0,C1,P0,P1,t,GK,GV,GL) do{ SBAR(); \
    const lds_cptr vp_=vp0+sl_prev; \
    VRD(0); SBAR(); float sacc=(P0[0]+P0[1]); \
    GAPA(C0=__builtin_amdgcn_mfma_f32_32x32x16_bf16(kf[0],qr[0],negm,0,0,0), P0[2],P0[3],P0[4],P0[5],     pw0[0]=PKW(P0,0), pw0[1]=PKW(P0,2), pw0); \
    VRD(4); SBAR(); GAPA(C1=__builtin_amdgcn_mfma_f32_32x32x16_bf16(kf[1],qr[0],negm,0,0,0), P0[6],P0[7],P0[8],P0[9],     pw0[2]=PKW(P0,4), pw0[3]=PKW(P0,6), pw0); \
    VRD(1); SBAR(); GAPA(C0=__builtin_amdgcn_mfma_f32_32x32x16_bf16(kf[2],qr[1],C0,0,0,0),   P0[10],P0[11],P0[12],P0[13], pw1[0]=PKW(P0,8), pw1[1]=PKW(P0,10), pw1); \
    VRD(5); SBAR(); GAPA(C1=__builtin_amdgcn_mfma_f32_32x32x16_bf16(kf[3],qr[1],C1,0,0,0),   P0[14],P0[15],P1[0],P1[1],   pw1[2]=PKW(P0,12),pw1[3]=PKW(P0,14), pw1); \
    VRD(2); SBAR(); GAPA(C0=__builtin_amdgcn_mfma_f32_32x32x16_bf16(kf[4],qr[2],C0,0,0,0),   P1[2],P1[3],P1[4],P1[5],     pw2[0]=PKW(P1,0), pw2[1]=PKW(P1,2), pw2); \
    VRD(6); SBAR(); GAPA(C1=__builtin_amdgcn_mfma_f32_32x32x16_bf16(kf[5],qr[2],C1,0,0,0),   P1[6],P1[7],P1[8],P1[9],     pw2[2]=PKW(P1,4), pw2[3]=PKW(P1,6), pw2); \
    VRD(3); SBAR(); GAPA(C0=__builtin_amdgcn_mfma_f32_32x32x16_bf16(kf[6],qr[3],C0,0,0,0),   P1[10],P1[11],P1[12],P1[13], pw3[0]=PKW(P1,8), pw3[1]=PKW(P1,10), pw3); \
    VRD(7); SBAR(); GAPA(C1=__builtin_amdgcn_mfma_f32_32x32x16_bf16(kf[7],qr[3],C1,0,0,0),   P1[14],P1[15],0.f,0.f,       pw3[2]=PKW(P1,12),pw3[3]=PKW(P1,14), pw3); \
    l_reg+=sacc; \
    if(GK){DMA_K((t)+3,sl_cur);} if(GV){DMA_V((t)+1,sl_next);} \
    CMASK(C0,C1,t); \
    { float a=MX3(C0[0],C0[1],C1[0]),b=MX3(C0[2],C0[3],C1[1]); a=MX3(a,C1[2],C1[3]); \
      _Pragma("unroll") for(int r=4;r<16;r+=4){a=MX3(a,C0[r],C0[r+1]);b=MX3(b,C0[r+2],C0[r+3]);a=MX3(a,C1[r],C1[r+1]);b=MX3(b,C1[r+2],C1[r+3]);} \
      float rm=__builtin_fmaxf(a,b); { auto rr=__builtin_amdgcn_permlane32_swap(__float_as_uint(rm),__float_as_uint(rm),false,false); rm=__builtin_fmaxf(__uint_as_float(rr[0]),__uint_as_float(rr[1])); } \
      resc=false; \
      if(__builtin_expect(__any(rm>(float)THRL),0)){ const float dl=__builtin_fmaxf(rm,0.f); mhat+=dl; \
        _Pragma("unroll") for(int r=0;r<16;++r){C0[r]-=dl;C1[r]-=dl;} \
        _Pragma("unroll") for(int r=0;r<16;++r)negm[r]=-mhat; asm volatile("":"+v"(negm)); \
        const float f=__builtin_amdgcn_exp2f(-dl); l_reg*=f; if(hi==0)wsf[r32]=f; resc=true; } } \
    SBAR(); \
    GAPB(o[0]=__builtin_amdgcn_mfma_f32_32x32x16_bf16(PAF(0),VFR(0),o[0],0,0,0), C0,0); \
    GAPB(o[1]=__builtin_amdgcn_mfma_f32_32x32x16_bf16(PAF(0),VFR(4),o[1],0,0,0), C0,4); \
    KRD(GL,0); GAPB(o[0]=__builtin_amdgcn_mfma_f32_32x32x16_bf16(PAF(1),VFR(1),o[0],0,0,0), C0,8); \
    KRD(GL,1); GAPB(o[1]=__builtin_amdgcn_mfma_f32_32x32x16_bf16(PAF(1),VFR(5),o[1],0,0,0), C0,12); \
    KRD(GL,2); GAPB(o[0]=__builtin_amdgcn_mfma_f32_32x32x16_bf16(PAF(2),VFR(2),o[0],0,0,0), C1,0); \
    KRD(GL,3); GAPB(o[1]=__builtin_amdgcn_mfma_f32_32x32x16_bf16(PAF(2),VFR(6),o[1],0,0,0), C1,4); \
    GAPB(o[0]=__builtin_amdgcn_mfma_f32_32x32x16_bf16(PAF(3),VFR(3),o[0],0,0,0), C1,8); \
    GAPB(o[1]=__builtin_amdgcn_mfma_f32_32x32x16_bf16(PAF(3),VFR(7),o[1],0,0,0), C1,12); \
    }while(0)
  int t=1;
  #undef CMASK
  #define CMASK(P0,P1,t) do{}while(0)
  for(;t+5<NT;t+=2){
    STEP(pB0,pB1,pA0,pA1,t,true,true,true);     WAIT_BAR(2); RESC(); ROT();
    STEP(pA0,pA1,pB0,pB1,t+1,true,true,true);   WAIT_BAR(2); RESC(); ROT();
  }
  #undef CMASK
  #define CMASK(P0,P1,t) do{int jb_=(t)-(NT-4); if(jb_>=0)cmask(P0,P1,jb_,qrel,hi);}while(0)
  #define ENDW(tt) do{ if((tt)+3<NT){WAIT_BAR(2);} else if((tt)+2<NT){WAIT_BAR(1);} else {WAIT_BAR(0);} }while(0)
  for(;t+1<NT;t+=2){
    STEP(pB0,pB1,pA0,pA1,t,(t+3<NT),(t+1<NT),(t+1<NT));       ENDW(t);   RESC(); ROT();
    STEP(pA0,pA1,pB0,pB1,t+1,(t+4<NT),(t+2<NT),(t+2<NT));     ENDW(t+1); RESC(); ROT();
  }
  STEP(pB0,pB1,pA0,pA1,NT-1,false,false,false); RESC();
  { float sacc=pB0[0]+pB0[1]; _Pragma("unroll") for(int r=2;r<16;++r)sacc+=pB0[r]; _Pragma("unroll") for(int r=0;r<16;++r)sacc+=pB1[r]; l_reg+=sacc;
    pw0=(u32x4){PKW(pB0,0),PKW(pB0,2),PKW(pB0,4),PKW(pB0,6)};pw1=(u32x4){PKW(pB0,8),PKW(pB0,10),PKW(pB0,12),PKW(pB0,14)};pw2=(u32x4){PKW(pB1,0),PKW(pB1,2),PKW(pB1,4),PKW(pB1,6)};pw3=(u32x4){PKW(pB1,8),PKW(pB1,10),PKW(pB1,12),PKW(pB1,14)};
    SBAR(); pv(o,vb0+sl_cur,PAF(0),PAF(1),PAF(2),PAF(3)); }
  #undef PKW
  #undef PAF
  #undef VFR
  #undef PIN
  #undef MX3
  #undef GAPA
  #undef GAPB
  #undef EX
  #undef VRD
  #undef KRD
  #undef STEP
  #undef ENDW
  {auto rr=__builtin_amdgcn_permlane32_swap(__float_as_uint(l_reg),__float_as_uint(l_reg),false,false);l_reg=__uint_as_float(rr[0])+__uint_as_float(rr[1]);}
  if(hi==0)wsf[32+r32]=l_reg;asm volatile("s_waitcnt lgkmcnt(0)":::"memory");
  float rli[16];
  #pragma unroll
  for(int r=0;r<16;++r)rli[r]=__builtin_amdgcn_rcpf(wsf[32+crow(r,hi)]);
  bf16*Ow=O+(long)(q0+wid*QBLK)*PO;
  { bf16*stg=(bf16*)(shm+LDS_OST)+wid*2048;
    #pragma unroll
    for(int r=0;r<16;++r){const int orow=crow(r,hi);
      #pragma unroll
      for(int d0=0;d0<2;++d0)stg[orow*64+d0*32+r32]=__float2bfloat16(o[d0][r]*rli[r]);}
    asm volatile("s_waitcnt lgkmcnt(0)":::"memory");
    #pragma unroll
    for(int i=0;i<4;++i){const int row=i*8+(lane>>3),ch=lane&7; const u32x4 v=*(const u32x4*)(stg+row*64+ch*8); ATTN_STORE16(Ow+(long)row*PO+ch*8,v);} }
  asm volatile("s_waitcnt lgkmcnt(0)\n\ts_barrier":::"memory");
  #undef DMA_K
  #undef DMA_V
  #undef CMASK
  #undef START
  #undef RESC
  #undef ROT
}
constexpr int ATTN_LDS_BYTES=LDS_BYTES;
#undef SBAR
#undef WAIT_BAR
}
namespace cg = cooperative_groups;
#define GAS __attribute__((address_space(1)))
#define LAS __attribute__((address_space(3)))
typedef unsigned short bf16;
typedef unsigned v4u __attribute__((ext_vector_type(4)));
typedef unsigned v2u __attribute__((ext_vector_type(2)));
typedef float f32x4 __attribute__((ext_vector_type(4)));
typedef short bf16x8 __attribute__((ext_vector_type(8)));
typedef short s16x4 __attribute__((ext_vector_type(4)));

#ifndef MK_ONE_LAUNCH
#define MK_ONE_LAUNCH 1
#endif
constexpr int NWAVES = 8;
constexpr int SEQ = 16384, DM = 1024, NIN = 8704, NMAIN = 5632, NGATE = 3072, DEPTH = 2;
constexpr float EPS = 1e-6f;
constexpr float QSCALE = 0.125f * 1.4426950408889634f;
constexpr size_t MiB = 1u << 20;
constexpr size_t WS_ROPE = 0;
constexpr size_t WS_WIN = 1 * MiB;
constexpr size_t WS_WB = 18 * MiB;
constexpr size_t WS_WO = 21 * MiB;
constexpr size_t WS_HB = 23 * MiB;
constexpr size_t WS_O = 55 * MiB;
constexpr size_t WS_PJ = 87 * MiB;
constexpr size_t SLOT_ELEMS = (size_t)SEQ * 512;
constexpr size_t WS_END = WS_PJ + 11 * SLOT_ELEMS * 2;
enum { SL_AQ = 0, SL_AK = 1, SL_AV = 2, SL_BU = 3, SL_BV = 4, SL_CQ = 5, SL_CK = 6, SL_CV = 7, SL_AZ = 8, SL_BZ = 9, SL_CZ = 10 };

constexpr int LDS_BYTES = 147456;

__device__ __forceinline__ unsigned f2bf(float f) { unsigned u = __builtin_bit_cast(unsigned, f); return (u + 0x7fffu + ((u >> 16) & 1u)) >> 16; }
typedef float f32x2_t __attribute__((ext_vector_type(2))); typedef __bf16 bf16x2_t __attribute__((ext_vector_type(2)));
__device__ __forceinline__ unsigned pk2(float lo, float hi) { f32x2_t v = {lo, hi}; bf16x2_t b = __builtin_convertvector(v, bf16x2_t); return __builtin_bit_cast(unsigned, b); }
__device__ __forceinline__ float bflo(unsigned w) { return __uint_as_float(w << 16); }
__device__ __forceinline__ float bfhi(unsigned w) { return __uint_as_float(w & 0xffff0000u); }
__device__ __forceinline__ float fexp2(float x) { return __builtin_amdgcn_exp2f(x); }
__device__ __forceinline__ float frcp(float x) { return __builtin_amdgcn_rcpf(x); }
__device__ __forceinline__ float sigmoid_f(float x) { return frcp(1.f + fexp2(-1.4426950408889634f * x)); }
__device__ __forceinline__ float silu_f(float x) { return x * sigmoid_f(x); }
__device__ __forceinline__ float gelu_tanh_f(float x) { const float y = 0.7978845608028654f * (x + 0.044715f * x * x * x); return x * frcp(1.f + fexp2(-2.885390081777927f * y)); }
__device__ __forceinline__ float wave_sum(float v) {
#pragma unroll
    for (int o = 1; o < 64; o <<= 1) v += __shfl_xor(v, o);
    return v;
}

struct EpiProj {
    static constexpr bool PERM = true, AFTER_DRAIN = false;
    bf16* PJ; const float* rc; const float* rs;
    __device__ __forceinline__ void operator()(const f32x4 (&acc)[2][2][4][2], const pg8::Unit& u, int wr, int wc, int fr_, int fq_) const {
        int fr = fr_, fq = fq_; asm volatile("" : "+v"(fr), "+v"(fq));
        const int grp = u.pn >> 1;
        const int slot = (int)((0xA7659438210ull >> (4 * grp)) & 15ull);
        const int act = (int)((0x10341221034ull >> (4 * grp)) & 15ull);
        bf16* base = PJ + (size_t)slot * SLOT_ELEMS;
        const int row0 = u.pm * 256 + wr * 64 + fr, col0 = (u.pn & 1) * 256 + wc * 32 + 8 * fq;
        const bool ropew = (act >= 3) && ((wc & 1) == 0);
        const float sgn = (fq == 0) ? -1.f : 1.f; const bool ropel = fq < 2;
        const float qs = (act == 4) ? QSCALE : 1.f;
#pragma unroll
        for (int ai = 0; ai < 2; ++ai)
#pragma unroll
            for (int m = 0; m < 4; ++m) {
                const int row = row0 + ai * 128 + m * 16;
                f32x4 c0 = {1.f, 1.f, 1.f, 1.f}, c1 = c0, s0 = {0.f, 0.f, 0.f, 0.f}, s1 = s0;
                if (ropew) { c0 = *(const f32x4*)(rc + row * 8); c1 = *(const f32x4*)(rc + row * 8 + 4); s0 = *(const f32x4*)(rs + row * 8); s1 = *(const f32x4*)(rs + row * 8 + 4); }
#pragma unroll
                for (int bj = 0; bj < 2; ++bj) {
                    f32x4 v0 = acc[ai][bj][m][0], v1 = acc[ai][bj][m][1];
                    if (ropew) {
                        f32x4 o0, o1;
#pragma unroll
                        for (int e = 0; e < 4; ++e) { o0[e] = __shfl_xor(v0[e], 16); o1[e] = __shfl_xor(v1[e], 16); }
                        if (ropel) { v0 = v0 * c0 + sgn * (o0 * s0); v1 = v1 * c1 + sgn * (o1 * s1); }
                    }
                    if (act == 1) {
#pragma unroll
                        for (int e = 0; e < 4; ++e) { v0[e] = silu_f(v0[e]); v1[e] = silu_f(v1[e]); }
                    } else if (act == 2) {
#pragma unroll
                        for (int e = 0; e < 4; ++e) { v0[e] = gelu_tanh_f(v0[e]); v1[e] = gelu_tanh_f(v1[e]); }
                    }
                    v0 = v0 * qs; v1 = v1 * qs;
                    v4u w; w.x = pk2(v0[0], v0[1]); w.y = pk2(v0[2], v0[3]); w.z = pk2(v1[0], v1[1]); w.w = pk2(v1[2], v1[3]);
                    *(v4u*)(base + (size_t)row * 512 + col0 + bj * 128) = w; asm volatile("" ::: "memory");
                }
            }
    }
};
struct EpiGate {
    static constexpr bool PERM = true, AFTER_DRAIN = false;
    bf16* GL;
    __device__ __forceinline__ void operator()(const f32x4 (&acc)[2][2][4][2], const pg8::Unit& u, int wr, int wc, int fr_, int fq_) const {
        int fr = fr_, fq = fq_; asm volatile("" : "+v"(fr), "+v"(fq));
        const int row0 = u.pm * 256 + wr * 64 + fr, col0 = u.pn * 256 + wc * 32 + 8 * fq;
#pragma unroll
        for (int ai = 0; ai < 2; ++ai)
#pragma unroll
            for (int m = 0; m < 4; ++m) {
                const int row = row0 + ai * 128 + m * 16;
#pragma unroll
                for (int bj = 0; bj < 2; ++bj) {
                    f32x4 v0 = acc[ai][bj][m][0], v1 = acc[ai][bj][m][1];
#pragma unroll
                    for (int e = 0; e < 4; ++e) { v0[e] = sigmoid_f(v0[e]); v1[e] = sigmoid_f(v1[e]); }
                    v4u w; w.x = pk2(v0[0], v0[1]); w.y = pk2(v0[2], v0[3]); w.z = pk2(v1[0], v1[1]); w.w = pk2(v1[2], v1[3]);
                    *(v4u*)(GL + (size_t)row * NGATE + col0 + bj * 128) = w; asm volatile("" ::: "memory");
                }
            }
    }
};
struct EpiMerge {
    static constexpr bool PERM = true, AFTER_DRAIN = false;
    const bf16* GL; bf16* MG; int BR;
    __device__ __forceinline__ void operator()(const f32x4 (&acc)[2][2][4][2], const pg8::Unit& u, int wr, int wc, int fr_, int fq_) const {
        int fr = fr_, fq = fq_; asm volatile("" : "+v"(fr), "+v"(fq));
        const int row0 = u.pm * 256 + wr * 64 + fr, col0 = u.pn * 256 + wc * 32 + 8 * fq;
#pragma unroll
        for (int ai = 0; ai < 2; ++ai)
#pragma unroll
            for (int m = 0; m < 4; ++m) {
                const int row = row0 + ai * 128 + m * 16;
#pragma unroll
                for (int bj = 0; bj < 2; ++bj) {
                    const v4u g = *(const v4u*)(GL + (size_t)row * NGATE + BR * 1024 + col0 + bj * 128);
                    bf16* mp = MG + (size_t)row * DM + col0 + bj * 128;
                    f32x4 v0 = acc[ai][bj][m][0], v1 = acc[ai][bj][m][1];
                    v0[0] *= bflo(g.x); v0[1] *= bfhi(g.x); v0[2] *= bflo(g.y); v0[3] *= bfhi(g.y);
                    v1[0] *= bflo(g.z); v1[1] *= bfhi(g.z); v1[2] *= bflo(g.w); v1[3] *= bfhi(g.w);
                    if (BR > 0) { const v4u o = *(const v4u*)mp;
                        v0[0] += bflo(o.x); v0[1] += bfhi(o.x); v0[2] += bflo(o.y); v0[3] += bfhi(o.y);
                        v1[0] += bflo(o.z); v1[1] += bfhi(o.z); v1[2] += bflo(o.w); v1[3] += bfhi(o.w); }
                    v4u w; w.x = pk2(v0[0], v0[1]); w.y = pk2(v0[2], v0[3]); w.z = pk2(v1[0], v1[1]); w.w = pk2(v1[2], v1[3]);
                    *(v4u*)mp = w; asm volatile("" ::: "memory");
                }
            }
    }
};
struct EpiOut {
    static constexpr bool PERM = true, AFTER_DRAIN = false;
    const float* res; float* out;
    __device__ __forceinline__ void operator()(const f32x4 (&acc)[2][2][4][2], const pg8::Unit& u, int wr, int wc, int fr_, int fq_) const {
        int fr = fr_, fq = fq_; asm volatile("" : "+v"(fr), "+v"(fq));
        const int row0 = u.pm * 256 + wr * 64 + fr, col0 = u.pn * 256 + wc * 32 + 8 * fq;
#pragma unroll
        for (int ai = 0; ai < 2; ++ai)
#pragma unroll
            for (int m = 0; m < 4; ++m) {
                const int row = row0 + ai * 128 + m * 16;
#pragma unroll
                for (int bj = 0; bj < 2; ++bj) {
                    const size_t off = (size_t)row * DM + col0 + bj * 128;
                    const f32x4 r0 = *(const f32x4*)(res + off), r1 = *(const f32x4*)(res + off + 4);
                    *(f32x4*)(out + off) = r0 + acc[ai][bj][m][0]; *(f32x4*)(out + off + 4) = r1 + acc[ai][bj][m][1]; asm volatile("" ::: "memory");
                }
            }
    }
};

__device__ __forceinline__ void p0_transpose_item(const float* W, int K, int N, bf16* WT, int row_off, LAS float* scr, int item, int lane) {
    const int nblk = N / 32, kb = item / nblk, nb = item % nblk, k0 = 64 * kb, n0 = 32 * nb;
#pragma unroll 8
    for (int i = 0; i < 32; ++i) { const int kk = 2 * i + (lane >> 5); scr[kk * 33 + (lane & 31)] = W[(size_t)(k0 + kk) * N + n0 + (lane & 31)]; }
    asm volatile("s_waitcnt lgkmcnt(0)" ::: "memory");
    const int c = lane & 7;
#pragma unroll
    for (int j = 0; j < 4; ++j) { const int n = (lane >> 3) + 8 * j; const LAS float* s = scr + (8 * c) * 33 + n;
        v4u o; o.x = pk2(s[0 * 33], s[1 * 33]); o.y = pk2(s[2 * 33], s[3 * 33]); o.z = pk2(s[4 * 33], s[5 * 33]); o.w = pk2(s[6 * 33], s[7 * 33]);
        *(v4u*)(WT + (size_t)(row_off + n0 + n) * K + k0 + 8 * c) = o; }
    asm volatile("s_waitcnt lgkmcnt(0)" ::: "memory");
}
__device__ __forceinline__ void rms_row_to_bf16(const float* xrow, const float* g, bf16* orow, int lane) {
    const f32x4* xr = (const f32x4*)xrow + lane; const f32x4* gr = (const f32x4*)g + lane;
    f32x4 v[4]; float s = 0.f;
#pragma unroll
    for (int j = 0; j < 4; ++j) { v[j] = xr[64 * j]; s += (v[j].x * v[j].x + v[j].y * v[j].y) + (v[j].z * v[j].z + v[j].w * v[j].w); }
    const float r = 1.f / sqrtf(wave_sum(s) * (1.f / DM) + EPS);
    unsigned long long* o8 = (unsigned long long*)orow + lane;
#pragma unroll
    for (int j = 0; j < 4; ++j) { const f32x4 gg = gr[64 * j]; const f32x4 y = v[j] * r * gg; o8[64 * j] = (unsigned long long)pk2(y.x, y.y) | ((unsigned long long)pk2(y.z, y.w) << 32); }
}
__device__ __forceinline__ void rms_row_to_f32(const float* xrow, const float* g, float* orow, int lane) {
    const f32x4* xr = (const f32x4*)xrow + lane; const f32x4* gr = (const f32x4*)g + lane;
    f32x4 v[4]; float s = 0.f;
#pragma unroll
    for (int j = 0; j < 4; ++j) { v[j] = xr[64 * j]; s += (v[j].x * v[j].x + v[j].y * v[j].y) + (v[j].z * v[j].z + v[j].w * v[j].w); }
    const float r = 1.f / sqrtf(wave_sum(s) * (1.f / DM) + EPS);
    f32x4* o = (f32x4*)orow + lane;
#pragma unroll
    for (int j = 0; j < 4; ++j) o[64 * j] = v[j] * r * gr[64 * j];
}

constexpr int SGU_P = 136;
__device__ __forceinline__ void sgu_item(int item, const bf16* BU, const bf16* BV, bf16* BZ, const float* lng, const float* lnb, const float* sw, const float* sb,
                                         LAS unsigned char* lds, int tid, int wid, int lane) {
    const int n = item >> 2, g = item & 3, tok0 = n * 128;
    LAS bf16* Wl = (LAS bf16*)lds; LAS bf16* Vt = (LAS bf16*)(lds + 128 * SGU_P * 2); LAS float* st = (LAS float*)(lds + 2 * 128 * SGU_P * 2);
#pragma unroll 4
    for (int i = 0; i < 16; ++i) {
        const int s = wid * 16 + i;
        const v4u w = *(const v4u*)(BV + (size_t)(tok0 + s) * 512 + lane * 8);
        const float a0 = bflo(w.x), a1 = bfhi(w.x), a2 = bflo(w.y), a3 = bfhi(w.y), a4 = bflo(w.z), a5 = bfhi(w.z), a6 = bflo(w.w), a7 = bfhi(w.w);
        const float mu = wave_sum(((a0 + a1) + (a2 + a3)) + ((a4 + a5) + (a6 + a7))) * (1.f / 512.f);
        const float d0 = a0 - mu, d1 = a1 - mu, d2 = a2 - mu, d3 = a3 - mu, d4 = a4 - mu, d5 = a5 - mu, d6 = a6 - mu, d7 = a7 - mu;
        const float var = wave_sum(((d0 * d0 + d1 * d1) + (d2 * d2 + d3 * d3)) + ((d4 * d4 + d5 * d5) + (d6 * d6 + d7 * d7))) * (1.f / 512.f);
        if (lane == 0) { st[s] = mu; st[128 + s] = 1.f / sqrtf(var + EPS); }
    }
    __syncthreads();
#pragma unroll
    for (int k = 0; k < 4; ++k) {
        const int idx = tid + 512 * k, s = idx >> 4, cch = idx & 15;
        const v4u w = *(const v4u*)(BV + (size_t)(tok0 + s) * 512 + g * 128 + cch * 8);
        const float mu = st[s], rstd = st[128 + s];
        const f32x4 g0 = *(const f32x4*)(lng + g * 128 + cch * 8), g1 = *(const f32x4*)(lng + g * 128 + cch * 8 + 4);
        const f32x4 b0 = *(const f32x4*)(lnb + g * 128 + cch * 8), b1 = *(const f32x4*)(lnb + g * 128 + cch * 8 + 4);
        float a[8] = {bflo(w.x), bfhi(w.x), bflo(w.y), bfhi(w.y), bflo(w.z), bfhi(w.z), bflo(w.w), bfhi(w.w)};
#pragma unroll
        for (int e = 0; e < 8; ++e) { const float gg = e < 4 ? g0[e & 3] : g1[e & 3], bb = e < 4 ? b0[e & 3] : b1[e & 3];
            Vt[(cch * 8 + e) * SGU_P + s] = (bf16)f2bf((a[e] - mu) * rstd * gg + bb); }
    }
#pragma unroll
    for (int k = 0; k < 8; ++k) {
        const int idx = tid + 512 * k, t = idx >> 5, s4 = (idx & 31) * 4;
        const f32x4 w = *(const f32x4*)(sw + ((size_t)g * 128 + t) * 128 + s4);
        v2u o; o.x = pk2(s4 + 0 <= t ? w.x : 0.f, s4 + 1 <= t ? w.y : 0.f); o.y = pk2(s4 + 2 <= t ? w.z : 0.f, s4 + 3 <= t ? w.w : 0.f);
        *(LAS v2u*)(Wl + t * SGU_P + s4) = o;
    }
    __syncthreads();
    const int r = lane & 15, q = lane >> 4;
    f32x4 acc[8];
#pragma unroll
    for (int ct = 0; ct < 8; ++ct) acc[ct] = (f32x4){0.f, 0.f, 0.f, 0.f};
#pragma unroll
    for (int ks = 0; ks < 4; ++ks) {
        const bf16x8 wf = *(const LAS bf16x8*)(Wl + (wid * 16 + r) * SGU_P + ks * 32 + q * 8);
#pragma unroll
        for (int ct = 0; ct < 8; ++ct) {
            const bf16x8 vf = *(const LAS bf16x8*)(Vt + (ct * 16 + r) * SGU_P + ks * 32 + q * 8);
            acc[ct] = __builtin_amdgcn_mfma_f32_16x16x32_bf16(vf, wf, acc[ct], 0, 0, 0);
        }
    }
    const int t = wid * 16 + r; const float bias = sb[g * 128 + t];
#pragma unroll
    for (int ct = 0; ct < 8; ++ct) {
        const size_t off = (size_t)(tok0 + t) * 512 + g * 128 + ct * 16 + q * 4;
        const v2u uu = *(const v2u*)(BU + off), zz = *(const v2u*)(BZ + off);
        v2u o; o.x = pk2((acc[ct][0] + bias) * bflo(uu.x) * bflo(zz.x), (acc[ct][1] + bias) * bfhi(uu.x) * bfhi(zz.x));
        o.y = pk2((acc[ct][2] + bias) * bflo(uu.y) * bflo(zz.y), (acc[ct][3] + bias) * bfhi(uu.y) * bfhi(zz.y));
        *(v2u*)(BZ + off) = o;
    }
    __syncthreads();
}

constexpr int CM_P = 36;
__device__ __forceinline__ void cmix_item(int tb, int h, const bf16* CQ, const bf16* CK, const bf16* CV, bf16* CZ, LAS unsigned char* ldsw, int wid, int lane) {
    const int r = lane & 15, q = lane >> 4, T0 = tb * 128, tq = T0 + wid + 8 * r;
    LAS bf16* Vt = (LAS bf16*)ldsw;
    bf16x8 qf[2];
#pragma unroll
    for (int ks = 0; ks < 2; ++ks) qf[ks] = *(const bf16x8*)(CQ + (size_t)tq * 512 + h * 64 + ks * 32 + q * 8);
    float mrun = -1e30f, lpart = 0.f;
    f32x4 o[4];
#pragma unroll
    for (int dt = 0; dt < 4; ++dt) o[dt] = (f32x4){0.f, 0.f, 0.f, 0.f};
    const int vkey = lane >> 3, vch = lane & 7;
    for (int seg = 0; seg < 3; ++seg) {
        const int sl = seg == 0 ? 0 : (seg == 1 ? 2 : 3);
        const int kbase = seg == 0 ? T0 - 128 : (seg == 1 ? T0 + wid - 512 : T0 + wid - 2048);
        const int nsteps = seg == 0 ? 8 : (seg == 1 ? 5 : 9);
        const int window = seg == 0 ? 128 : (seg == 1 ? 512 : 2048);
        const int dmask = seg == 2 ? 15 : 0;
        for (int stp = 0; stp < nsteps; ++stp) {
            const int kk0 = stp * 32;
            if (kbase + ((kk0 + 31) << sl) < 0) continue;
            int tA = kbase + ((kk0 + r) << sl), tB = kbase + ((kk0 + 16 + r) << sl);
            tA = min(max(tA, 0), SEQ - 1); tB = min(max(tB, 0), SEQ - 1);
            bf16x8 ka[2], kb[2], vv[4];
#pragma unroll
            for (int ks = 0; ks < 2; ++ks) { ka[ks] = *(const bf16x8*)(CK + (size_t)tA * 512 + h * 64 + ks * 32 + q * 8); kb[ks] = *(const bf16x8*)(CK + (size_t)tB * 512 + h * 64 + ks * 32 + q * 8); }
#pragma unroll
            for (int c = 0; c < 4; ++c) { int tv = kbase + ((kk0 + vkey + 8 * c) << sl); tv = min(max(tv, 0), SEQ - 1); vv[c] = *(const bf16x8*)(CV + (size_t)tv * 512 + h * 64 + vch * 8); }
            f32x4 sA = (f32x4){0.f, 0.f, 0.f, 0.f}, sB = sA;
            sA = __builtin_amdgcn_mfma_f32_16x16x32_bf16(ka[0], qf[0], sA, 0, 0, 0); sA = __builtin_amdgcn_mfma_f32_16x16x32_bf16(ka[1], qf[1], sA, 0, 0, 0);
            sB = __builtin_amdgcn_mfma_f32_16x16x32_bf16(kb[0], qf[0], sB, 0, 0, 0); sB = __builtin_amdgcn_mfma_f32_16x16x32_bf16(kb[1], qf[1], sB, 0, 0, 0);
#pragma unroll
            for (int c = 0; c < 4; ++c)
#pragma unroll
                for (int e = 0; e < 8; ++e) Vt[(vch * 8 + e) * CM_P + vkey + 8 * c] = (bf16)vv[c][e];
            float sv[8]; bool ok[8]; float mx = -1e30f;
#pragma unroll
            for (int j = 0; j < 8; ++j) {
                const int kk = kk0 + (j < 4 ? 0 : 16) + 4 * q + (j & 3), tk = kbase + (kk << sl), rel = tq - tk;
                ok[j] = (rel >= 0) && (rel <= window) && (tk >= 0) && ((rel & dmask) == 0);
                sv[j] = ok[j] ? (j < 4 ? sA[j & 3] : sB[j & 3]) : -1e30f; mx = fmaxf(mx, sv[j]);
            }
            mx = fmaxf(mx, __shfl_xor(mx, 16)); mx = fmaxf(mx, __shfl_xor(mx, 32));
            const float mnew = fmaxf(mrun, mx), alpha = fexp2(mrun - mnew); mrun = mnew;
            float p[8], ps = 0.f;
#pragma unroll
            for (int j = 0; j < 8; ++j) { p[j] = ok[j] ? fexp2(sv[j] - mnew) : 0.f; ps += p[j]; }
            lpart = lpart * alpha + ps;
            v4u pw; pw.x = pk2(p[0], p[1]); pw.y = pk2(p[2], p[3]); pw.z = pk2(p[4], p[5]); pw.w = pk2(p[6], p[7]);
            const bf16x8 pf = __builtin_bit_cast(bf16x8, pw);
            asm volatile("s_waitcnt lgkmcnt(0)" ::: "memory");
#pragma unroll
            for (int dt = 0; dt < 4; ++dt) {
                const s16x4 lo = *(const LAS s16x4*)(Vt + (dt * 16 + r) * CM_P + 4 * q), hi = *(const LAS s16x4*)(Vt + (dt * 16 + r) * CM_P + 16 + 4 * q);
                const bf16x8 vf = (bf16x8){lo[0], lo[1], lo[2], lo[3], hi[0], hi[1], hi[2], hi[3]};
                o[dt] = o[dt] * alpha;
                o[dt] = __builtin_amdgcn_mfma_f32_16x16x32_bf16(vf, pf, o[dt], 0, 0, 0);
            }
            asm volatile("s_waitcnt lgkmcnt(0)" ::: "memory");
        }
    }
    float l = lpart; l += __shfl_xor(l, 16); l += __shfl_xor(l, 32);
    const float inv = 1.f / l;
#pragma unroll
    for (int dt = 0; dt < 4; ++dt) {
        const size_t off = (size_t)tq * 512 + h * 64 + dt * 16 + 4 * q;
        const v2u zz = *(const v2u*)(CZ + off);
        v2u w; w.x = pk2(o[dt][0] * inv * bflo(zz.x), o[dt][1] * inv * bfhi(zz.x)); w.y = pk2(o[dt][2] * inv * bflo(zz.y), o[dt][3] * inv * bfhi(zz.y));
        *(v2u*)(CZ + off) = w;
    }
}

struct Args { const void* in[16]; float* out; unsigned char* ws; float inv[8]; int ph_lo, ph_hi; };
constexpr int N_PHASES = 6 * DEPTH + 1;

__global__ void __launch_bounds__(NWAVES * 64, 2) trunk_fwd(Args args) {
    extern __shared__ __attribute__((aligned(16))) unsigned char lds[];
    LAS unsigned char* L = (LAS unsigned char*)lds;
#define FRESH_TID() int tid_ = threadIdx.x; asm volatile("" : "+v"(tid_)); const int tid = tid_, lane = tid & 63, wid = __builtin_amdgcn_readfirstlane(tid >> 6); const int gw = vcu * NWAVES + wid; (void)tid; (void)lane; (void)gw
    const int G = gridDim.x, bx = blockIdx.x;
    const int vcu = (G % 8 == 0) ? (bx % 8) * (G / 8) + bx / 8 : bx;
    const int NGW = G * NWAVES;
    unsigned char* ws = args.ws;
    const float* x_in = (const float*)args.in[0]; const int* pos = (const int*)args.in[1];
    float* out = args.out;
    float* ropec = (float*)(ws + WS_ROPE); float* ropes = ropec + SEQ * 8;
    bf16* WinT = (bf16*)(ws + WS_WIN); bf16* WbT = (bf16*)(ws + WS_WB); bf16* WoT = (bf16*)(ws + WS_WO);
    bf16* HB = (bf16*)(ws + WS_HB); bf16* OB = (bf16*)(ws + WS_O); bf16* PJ = (bf16*)(ws + WS_PJ);
    bf16* GL = PJ;
    const int lo = args.ph_lo, hi = args.ph_hi;
#define IN(k) (lo <= (k) && (k) < hi)
#define SEAM(k) do { if (IN(k) && IN((k) + 1)) { cg::this_grid().sync(); } } while (0)

    for (int layer = 0; layer < DEPTH; ++layer) {
        const int pb = 6 * layer;
        const float* xsrc = layer == 0 ? x_in : out;
#ifndef SKIP_P0
        if (IN(pb + 0)) {
            FRESH_TID();
            const float* w_in = (const float*)args.in[3] + (size_t)layer * DM * NIN;
            const float* w_br = (const float*)args.in[13] + (size_t)layer * 3 * 512 * DM;
            const float* w_out = (const float*)args.in[14] + (size_t)layer * DM * DM;
            const float* ng = (const float*)args.in[2] + layer * DM;
            LAS float* scr = (LAS float*)(L + wid * 16384);
            constexpr int I_IN = (DM / 64) * (NIN / 32), I_B = (512 / 64) * (DM / 32), I_O = (DM / 64) * (DM / 32);
            constexpr int NITEMS = I_IN + 3 * I_B + I_O;
            for (int it = gw; it < NITEMS; it += NGW) {
                int r = it;
                if (r < I_IN) { p0_transpose_item(w_in, DM, NIN, WinT, 0, scr, r, lane); continue; } r -= I_IN;
                if (r < 3 * I_B) { const int br = r / I_B; p0_transpose_item(w_br + (size_t)br * 512 * DM, 512, DM, WbT + (size_t)br * DM * 512, 0, scr, r % I_B, lane); continue; } r -= 3 * I_B;
                p0_transpose_item(w_out, DM, DM, WoT, 0, scr, r, lane);
            }
            for (int m = gw; m < SEQ; m += NGW) rms_row_to_bf16(xsrc + (size_t)m * DM, ng, HB + (size_t)m * DM, lane);
            if (layer == 0) {
                for (int idx = (vcu * NWAVES * 64) + tid; idx < SEQ * 8; idx += G * NWAVES * 64) {
                    const int tok = idx >> 3, i = idx & 7;
                    const float ang = (float)pos[tok] * args.inv[i];
                    const double rev = (double)ang * 0.15915494309189535; const double fr_ = rev - __builtin_rint(rev);
                    ropec[idx] = __builtin_amdgcn_cosf((float)fr_); ropes[idx] = __builtin_amdgcn_sinf((float)fr_);
                }
            }
        }
#endif
        SEAM(pb + 0);
#ifndef SKIP_P1
        if (IN(pb + 1)) {
            pg8::Gemm g{HB, WinT, SEQ, NMAIN, DM}; pg8::StaticOrder S; S.init(SEQ, NMAIN, G, bx);
            EpiProj E{PJ, ropec, ropes};
            pg8::gemm_phase<EpiProj, pg8::StaticOrder, true, true>(L, g, S, E);
        }
#endif
        SEAM(pb + 1);
        if (IN(pb + 2)) {
#ifndef SKIP_ATT
            {
                const int vh = vcu >> 4, s = vcu & 15;
                const attn_body::bf16* Qh = (const attn_body::bf16*)(PJ + SL_AQ * SLOT_ELEMS) + (vh >> 1) * 64;
                const attn_body::bf16* Kh = (const attn_body::bf16*)(PJ + SL_AK * SLOT_ELEMS) + (vh >> 1) * 64;
                const attn_body::bf16* Vh = (const attn_body::bf16*)(PJ + SL_AV * SLOT_ELEMS) + (vh >> 2) * 128 + (vh & 1) * 64;
                attn_body::bf16* Oh = (attn_body::bf16*)OB + vh * 64;
                if (G == 256) {
                    for (int i = 0; i < 4; ++i) { const int qb = (i == 0) ? s : (i == 1) ? 31 - s : (i == 2) ? 32 + s : 63 - s; attn_body::attn_unit<8>(qb, Qh, Kh, Vh, Oh, (char*)lds); }
                }
            }
#endif
#ifndef SKIP_SGU
            {
                FRESH_TID();
                const float* lng = (const float*)args.in[9] + layer * 512; const float* lnb = (const float*)args.in[10] + layer * 512;
                const float* sw = (const float*)args.in[11] + (size_t)layer * 4 * 128 * 128; const float* sb = (const float*)args.in[12] + layer * 4 * 128;
                for (int it = vcu; it < 512; it += G) sgu_item(it, PJ + SL_BU * SLOT_ELEMS, PJ + SL_BV * SLOT_ELEMS, PJ + SL_BZ * SLOT_ELEMS, lng, lnb, sw, sb, L, tid, wid, lane);
            }
#endif
#ifndef SKIP_CMIX
            {
                FRESH_TID();
                for (int it = vcu; it < 1024; it += G) cmix_item(it >> 3, it & 7, PJ + SL_CQ * SLOT_ELEMS, PJ + SL_CK * SLOT_ELEMS, PJ + SL_CV * SLOT_ELEMS, PJ + SL_CZ * SLOT_ELEMS, L + wid * 8192, wid, lane);
                __syncthreads();
            }
#endif
        }
        SEAM(pb + 2);
#ifndef SKIP_P3
        if (IN(pb + 3)) {
            { FRESH_TID();
            const float lam_init = 0.8f - 0.6f * __expf(-0.3f * (float)layer);
            const float* lq1 = (const float*)args.in[4] + layer * 64; const float* lk1 = (const float*)args.in[5] + layer * 64;
            const float* lq2 = (const float*)args.in[6] + layer * 64; const float* lk2 = (const float*)args.in[7] + layer * 64;
            const float lam = __expf(wave_sum(lq1[lane] * lk1[lane])) - __expf(wave_sum(lq2[lane] * lk2[lane])) + lam_init;
            const float* sg = (const float*)args.in[8] + layer * 128;
            const int e0 = (lane & 15) * 8, hh = lane >> 4;
            const f32x4 g0 = *(const f32x4*)(sg + e0), g1 = *(const f32x4*)(sg + e0 + 4);
            bf16* AZ = PJ + SL_AZ * SLOT_ELEMS;
            for (int m = gw; m < SEQ; m += NGW) {
                const v4u a = *(const v4u*)(OB + (size_t)m * DM + hh * 256 + e0), b = *(const v4u*)(OB + (size_t)m * DM + hh * 256 + 128 + e0);
                const v4u z = *(const v4u*)(AZ + (size_t)m * 512 + hh * 128 + e0);
                float d[8] = {bflo(a.x) - lam * bflo(b.x), bfhi(a.x) - lam * bfhi(b.x), bflo(a.y) - lam * bflo(b.y), bfhi(a.y) - lam * bfhi(b.y),
                              bflo(a.z) - lam * bflo(b.z), bfhi(a.z) - lam * bfhi(b.z), bflo(a.w) - lam * bflo(b.w), bfhi(a.w) - lam * bfhi(b.w)};
                float ss = 0.f;
#pragma unroll
                for (int e = 0; e < 8; ++e) ss += d[e] * d[e];
                ss += __shfl_xor(ss, 1); ss += __shfl_xor(ss, 2); ss += __shfl_xor(ss, 4); ss += __shfl_xor(ss, 8);
                const float rr = (1.f / sqrtf(ss * (1.f / 128.f) + EPS)) * (1.f - lam_init);
                v4u w; w.x = pk2(d[0] * rr * g0[0] * bflo(z.x), d[1] * rr * g0[1] * bfhi(z.x)); w.y = pk2(d[2] * rr * g0[2] * bflo(z.y), d[3] * rr * g0[3] * bfhi(z.y));
                w.z = pk2(d[4] * rr * g1[0] * bflo(z.z), d[5] * rr * g1[1] * bfhi(z.z)); w.w = pk2(d[6] * rr * g1[2] * bflo(z.w), d[7] * rr * g1[3] * bfhi(z.w));
                *(v4u*)(AZ + (size_t)m * 512 + hh * 128 + e0) = w;
            } }
            asm volatile("s_waitcnt vmcnt(0) lgkmcnt(0)" ::: "memory"); __syncthreads();
            pg8::Gemm g{HB, WinT + (size_t)NMAIN * DM, SEQ, NGATE, DM}; pg8::StaticOrder S; S.init(SEQ, NGATE, G, bx);
            EpiGate E{GL};
            pg8::gemm_phase<EpiGate, pg8::StaticOrder, true, true>(L, g, S, E);
        }
#endif
        SEAM(pb + 3);
#ifndef SKIP_P4
        if (IN(pb + 4)) {
            pg8::StaticOrder S; S.init(SEQ, DM, G, bx);
#pragma unroll 1
            for (int br = 0; br < 3; ++br) {
                pg8::Gemm g{PJ + (size_t)(SL_AZ + br) * SLOT_ELEMS, WbT + (size_t)br * DM * 512, SEQ, DM, 512}; EpiMerge E{GL, OB, br};
                pg8::gemm_phase<EpiMerge, pg8::StaticOrder, false, true>(L, g, S, E);
            }
        }
#endif
        SEAM(pb + 4);
#ifndef SKIP_P5
        if (IN(pb + 5)) {
            pg8::Gemm g{OB, WoT, SEQ, DM, DM}; pg8::StaticOrder S; S.init(SEQ, DM, G, bx);
            EpiOut E{xsrc, out};
            pg8::gemm_phase<EpiOut, pg8::StaticOrder, false, true>(L, g, S, E);
        }
#endif
        SEAM(pb + 5);
    }
    if (IN(6 * DEPTH)) {
        FRESH_TID();
        const float* fg = (const float*)args.in[15];
        for (int m = gw; m < SEQ; m += NGW) rms_row_to_f32(out + (size_t)m * DM, fg, out + (size_t)m * DM, lane);
    }
#undef IN
#undef SEAM
}

extern "C" void kernel_launch(void* const* d_in, const int* in_sizes, int n_in, void* d_out, int out_size, void* d_ws, size_t ws_size, hipStream_t stream) {
    static int grid = 0;
    if (grid == 0) {
        if (n_in != 16 || out_size != SEQ * DM || ws_size < WS_END) { fprintf(stderr, "kernel_launch: unexpected shapes (n_in %d out %d ws %zu need %zu)\n", n_in, out_size, ws_size, (size_t)WS_END); grid = -1; return; }
        int dev = 0, cus = 0, per_cu = 0;
        hipGetDevice(&dev); hipDeviceGetAttribute(&cus, hipDeviceAttributeMultiprocessorCount, dev);
        if (hipFuncSetAttribute((const void*)trunk_fwd, hipFuncAttributeMaxDynamicSharedMemorySize, LDS_BYTES) != hipSuccess) { fprintf(stderr, "kernel_launch: hipFuncSetAttribute failed\n"); grid = -1; return; }
        hipOccupancyMaxActiveBlocksPerMultiprocessor(&per_cu, (const void*)trunk_fwd, NWAVES * 64, LDS_BYTES);
        (void)hipGetLastError();
        if (per_cu < 1) per_cu = 1;
        grid = cus * (per_cu > 1 ? 1 : per_cu);
        fprintf(stderr, "kernel_launch: grid %d (cus %d per_cu %d)\n", grid, cus, per_cu);
    }
    if (grid < 0) return;
    Args a{};
    for (int i = 0; i < 16; ++i) a.in[i] = d_in[i];
    a.out = (float*)d_out; a.ws = (unsigned char*)d_ws;
    for (int i = 0; i < 8; ++i) a.inv[i] = powf(500000.0f, -(float)i * 2.0f / 16.0f);
#if MK_ONE_LAUNCH
    a.ph_lo = 0; a.ph_hi = N_PHASES;
    void* kargs[] = {&a};
    hipError_t e = hipLaunchCooperativeKernel((const void*)trunk_fwd, dim3(grid), dim3(NWAVES * 64), kargs, LDS_BYTES, stream);
    if (e != hipSuccess) fprintf(stderr, "cooperative launch failed: %s (grid %d)\n", hipGetErrorString(e), grid);
#else
    for (int p = 0; p < N_PHASES; ++p) { a.ph_lo = p; a.ph_hi = p + 1; hipLaunchKernelGGL(trunk_fwd, dim3(grid), dim3(NWAVES * 64), LDS_BYTES, stream, a);
    }
#endif
}
```

```cpp
#include <hip/hip_runtime.h>
#include <hip/hip_cooperative_groups.h>
#include <cstdio>
#include <cstdint>
#include <cmath>
#define MK_ONE_LAUNCH 1
namespace pg8 {
#define PG8_LAS __attribute__((address_space(3)))
typedef unsigned short bf16_t;
typedef short bf16x8 __attribute__((ext_vector_type(8)));
typedef float f32x4 __attribute__((ext_vector_type(4)));
typedef unsigned u32x4 __attribute__((ext_vector_type(4)));
constexpr int BM = 256, BK = 64, HALF = 128, HTB = HALF * BK * 2  , STAGE_BYTES = 8 * HTB, NXCD = 8, WGM = 8;

__host__ __device__ __forceinline__ int lds_byte(int r, int c) { const int st = (r >> 4) * 2 + (c >> 5), rr = r & 15, cc = c & 31, ob = rr * 64 + cc * 2; return st * 1024 + (ob ^ (((ob >> 9) & 1) << 5)); }
__host__ __device__ __forceinline__ void stage_rc(int b, int& R, int& C) { const int st = b / 1024, sb = b % 1024, swz = sb ^ (((sb >> 9) & 1) << 5); R = (st >> 1) * 16 + swz / 64; C = (st & 1) * 32 + (swz % 64) / 2; }
__host__ __device__ __forceinline__ int perm32(int rho) { const int n = rho >> 4, i = rho & 15; return 8 * (i >> 2) + 4 * n + (i & 3); }

struct Unit { int pm, pn; };
struct Gemm { const bf16_t* A; const bf16_t* Bt; int M, N, K; };

struct StaticOrder {
    int nM, nN, nwg, G, c;
    __host__ __device__ void init(int M, int N, int G_, int c_) { nM = M / BM; nN = N / BM; nwg = nM * nN; G = G_; c = c_; }
    __host__ __device__ bool next(int i, Unit& u) const {
        const long L = (long)i * G + c; if (L >= nwg) return false;
        int wgid = (int)L; { const int q = nwg / NXCD, r = nwg % NXCD, xcd = wgid % NXCD, off = wgid / NXCD; wgid = (xcd < r ? xcd * (q + 1) : r * (q + 1) + (xcd - r) * q) + off; }
        const int nig = WGM * nN, gid = wgid / nig, fm = gid * WGM, gsz = (nM - fm) < WGM ? (nM - fm) : WGM;
        u.pm = fm + ((wgid % nig) % gsz); u.pn = (wgid % nig) / gsz; return true;
    }
    __device__ __forceinline__ void a_ready(const Unit&) const {}
    __device__ __forceinline__ void done(const Unit&) const {}
};

__device__ __forceinline__ unsigned cvt_pk_bf16(float lo, float hi) { unsigned r; asm volatile("v_cvt_pk_bf16_f32 %0, %1, %2" : "=v"(r) : "v"(lo), "v"(hi)); return r; }
typedef float f32x2 __attribute__((ext_vector_type(2)));
template <class Epi, class Sched, bool ALIGN_EPI = false, bool SP2 = false>
__device__ __forceinline__ void gemm_phase(PG8_LAS unsigned char* lds, const Gemm g, const Sched& S, const Epi& E) {
    int tid_ = threadIdx.x; asm volatile("" : "+v"(tid_));
    const int tid = tid_, wid = __builtin_amdgcn_readfirstlane(tid >> 6), lane = tid & 63, wr = wid >> 2, wc = wid & 3, fr = lane & 15, fq = lane >> 4;
    const int K = g.K, nt = K / BK;
    unsigned voffA[2], voffB[2];
#pragma unroll
    for (int i = 0; i < 2; ++i) { int R, C; stage_rc(tid * 16 + i * 8192, R, C); const int Rb = Epi::PERM ? ((R & ~31) + perm32(R & 31)) : R;
        voffA[i] = (unsigned)(R * K + C) * 2u; voffB[i] = (unsigned)(Rb * K + C) * 2u; }
    const size_t kstep = (size_t)(BK * 2);
    const size_t hstep = (size_t)HALF * K * 2;
    const size_t tstep = 2 * hstep;
    const unsigned ldsw = (unsigned)wid * 1024u;
    const int aoff = lds_byte(wr * 64 + fr, fq * 8), boff = lds_byte(wc * 32 + fr, fq * 8);
#define PG8_SA(b, h) (((b) * 2 + (h)) * HTB)
#define PG8_SB(b, h) ((4 + (b) * 2 + (h)) * HTB)
#define PG8_STAGE(bufoff, gbase, voff) do { _Pragma("unroll") for (int _i = 0; _i < 2; ++_i) \
        __builtin_amdgcn_global_load_lds((const unsigned*)((const char*)(gbase) + (voff)[_i]), (PG8_LAS unsigned*)(lds + (bufoff) + ldsw + _i * 8192), 16, 0, 0); } while (0)
#define PG8_LDA(dst, b, h) do { _Pragma("unroll") for (int m = 0; m < 4; ++m) _Pragma("unroll") for (int k = 0; k < 2; ++k) dst[m][k] = *(const PG8_LAS bf16x8*)(lds + PG8_SA(b, h) + aoff + m * 2048 + k * 1024); } while (0)
#define PG8_LDB(dst, b, h) do { _Pragma("unroll") for (int n = 0; n < 2; ++n) _Pragma("unroll") for (int k = 0; k < 2; ++k) dst[n][k] = *(const PG8_LAS bf16x8*)(lds + PG8_SB(b, h) + boff + n * 2048 + k * 1024); } while (0)
#define PG8_MMA(ai, bj, At, Bt) do { __builtin_amdgcn_s_setprio(1); _Pragma("unroll") for (int m = 0; m < 4; ++m) _Pragma("unroll") for (int n = 0; n < 2; ++n) _Pragma("unroll") for (int k = 0; k < 2; ++k) \
        acc[ai][bj][m][n] = __builtin_amdgcn_mfma_f32_16x16x32_bf16(Bt[n][k], At[m][k], acc[ai][bj][m][n], 0, 0, 0); __builtin_amdgcn_s_setprio(0); } while (0)
#define PG8_WAIT_V(n) asm volatile("s_waitcnt vmcnt(" #n ")" ::: "memory")
#define PG8_WAIT_L(n) asm volatile("s_waitcnt lgkmcnt(" #n ")" ::: "memory")
#define PG8_BAR __builtin_amdgcn_s_barrier()
#define PG8_SCHED __builtin_amdgcn_sched_barrier(0)
    Unit cur, nxt; int ui = 0;
    if (!S.next(0, cur)) return;
    f32x4 acc[2][2][4][2];
#pragma unroll
    for (int a = 0; a < 2; ++a)
#pragma unroll
        for (int b = 0; b < 2; ++b)
#pragma unroll
            for (int m = 0; m < 4; ++m)
#pragma unroll
                for (int n = 0; n < 2; ++n) acc[a][b][m][n] = (f32x4){0.f, 0.f, 0.f, 0.f};
    bf16x8 At[4][2], B0[2][2], B1[2][2];
    const char* cA = (const char*)g.A + (size_t)cur.pm * tstep; const char* cB = (const char*)g.Bt + (size_t)cur.pn * tstep;
    S.a_ready(cur);
    if constexpr (SP2) {
        PG8_STAGE(PG8_SB(0, 0), cB, voffB); PG8_STAGE(PG8_SB(0, 1), cB + hstep, voffB); PG8_STAGE(PG8_SA(0, 0), cA, voffA); PG8_STAGE(PG8_SA(0, 1), cA + hstep, voffA);
        if (wr == 1) PG8_BAR;
        PG8_WAIT_V(2); PG8_BAR;
        PG8_STAGE(PG8_SB(1, 0), cB + kstep, voffB); PG8_STAGE(PG8_SA(1, 0), cA + kstep, voffA); PG8_STAGE(PG8_SB(1, 1), cB + hstep + kstep, voffB);
        PG8_WAIT_V(6); PG8_BAR;
    } else {
        PG8_STAGE(PG8_SB(0, 0), cB, voffB); PG8_STAGE(PG8_SA(0, 0), cA, voffA); PG8_STAGE(PG8_SB(0, 1), cB + hstep, voffB); PG8_STAGE(PG8_SA(0, 1), cA + hstep, voffA);
        if (wr == 1) PG8_BAR;
        PG8_WAIT_V(4); PG8_BAR;
        PG8_STAGE(PG8_SB(1, 0), cB + kstep, voffB); PG8_STAGE(PG8_SA(1, 0), cA + kstep, voffA); PG8_STAGE(PG8_SB(1, 1), cB + hstep + kstep, voffB);
        PG8_WAIT_V(6); PG8_BAR;
    }
    for (;;) {
        const bool has_next = S.next(ui + 1, nxt);
        const char* nA = has_next ? (const char*)g.A + (size_t)nxt.pm * tstep : cA; const char* nB = has_next ? (const char*)g.Bt + (size_t)nxt.pn * tstep : cB;
        for (int t = 0; t < nt; t += 2) {
            const bool last = (t == nt - 2);
            const char* a1 = cA + (size_t)(t + 1) * kstep;
            const char* a2 = last ? nA : cA + (size_t)(t + 2) * kstep; const char* b2 = last ? nB : cB + (size_t)(t + 2) * kstep;
            const char* a3 = a2 + kstep; const char* b3 = b2 + kstep;
            if (last && has_next) S.a_ready(nxt);
            if constexpr (SP2) {
            PG8_LDB(B0, 0, 0); PG8_LDB(B1, 0, 1); PG8_SCHED; PG8_LDA(At, 0, 0); PG8_STAGE(PG8_SA(1, 1), a1 + hstep, voffA);
            PG8_WAIT_V(8); PG8_WAIT_L(0); PG8_BAR; PG8_MMA(0, 0, At, B0); PG8_MMA(0, 1, At, B1); PG8_BAR; PG8_SCHED;
            PG8_LDA(At, 0, 1); PG8_STAGE(PG8_SB(0, 0), b2, voffB); PG8_STAGE(PG8_SB(0, 1), b2 + hstep, voffB); PG8_STAGE(PG8_SA(0, 0), a2, voffA);
            PG8_WAIT_V(8); PG8_WAIT_L(0); PG8_BAR; PG8_MMA(1, 0, At, B0); PG8_MMA(1, 1, At, B1); PG8_BAR; PG8_SCHED;
            PG8_LDB(B0, 1, 0); PG8_LDB(B1, 1, 1); PG8_SCHED; PG8_LDA(At, 1, 0); PG8_STAGE(PG8_SA(0, 1), a2 + hstep, voffA);
            PG8_WAIT_V(8); PG8_WAIT_L(0); PG8_BAR; PG8_MMA(0, 0, At, B0); PG8_MMA(0, 1, At, B1); PG8_BAR; PG8_SCHED;
            PG8_LDA(At, 1, 1); PG8_STAGE(PG8_SB(1, 0), b3, voffB); PG8_STAGE(PG8_SB(1, 1), b3 + hstep, voffB); PG8_STAGE(PG8_SA(1, 0), a3, voffA);
            PG8_WAIT_V(8); PG8_WAIT_L(0); PG8_BAR; PG8_MMA(1, 0, At, B0); PG8_MMA(1, 1, At, B1); PG8_BAR; PG8_SCHED;
            } else {
            PG8_LDB(B0, 0, 0); PG8_SCHED; PG8_LDA(At, 0, 0); PG8_STAGE(PG8_SA(1, 1), a1 + hstep, voffA);
            PG8_WAIT_L(8); PG8_BAR; PG8_WAIT_L(0); PG8_MMA(0, 0, At, B0); PG8_BAR; PG8_SCHED;
            PG8_LDB(B1, 0, 1); PG8_STAGE(PG8_SB(0, 0), b2, voffB);
            PG8_BAR; PG8_WAIT_L(0); PG8_MMA(0, 1, At, B1); PG8_BAR;
            PG8_LDA(At, 0, 1); PG8_STAGE(PG8_SA(0, 0), a2, voffA);
            PG8_BAR; PG8_WAIT_L(0); PG8_MMA(1, 0, At, B0); PG8_BAR; PG8_SCHED;
            PG8_STAGE(PG8_SB(0, 1), b2 + hstep, voffB);
            PG8_WAIT_V(6); PG8_BAR; PG8_MMA(1, 1, At, B1); PG8_BAR;
            PG8_LDB(B0, 1, 0); PG8_SCHED; PG8_LDA(At, 1, 0); PG8_STAGE(PG8_SA(0, 1), a2 + hstep, voffA);
            PG8_WAIT_L(8); PG8_BAR; PG8_WAIT_L(0); PG8_MMA(0, 0, At, B0); PG8_BAR; PG8_SCHED;
            PG8_LDB(B1, 1, 1); PG8_STAGE(PG8_SB(1, 0), b3, voffB);
            PG8_BAR; PG8_WAIT_L(0); PG8_MMA(0, 1, At, B1); PG8_BAR;
            PG8_LDA(At, 1, 1); PG8_STAGE(PG8_SA(1, 0), a3, voffA);
            PG8_BAR; PG8_WAIT_L(0); PG8_MMA(1, 0, At, B0); PG8_BAR; PG8_SCHED;
            PG8_STAGE(PG8_SB(1, 1), b3 + hstep, voffB);
            PG8_WAIT_V(6); PG8_BAR; PG8_MMA(1, 1, At, B1); PG8_BAR;
            }
        }
        if constexpr (ALIGN_EPI) { if (wr == 0) PG8_BAR; }
        if constexpr (!Epi::AFTER_DRAIN) { E(acc, cur, wr, wc, fr, fq); S.done(cur); }
        if (!has_next) break;
#pragma unroll
        for (int a = 0; a < 2; ++a)
#pragma unroll
            for (int b = 0; b < 2; ++b)
#pragma unroll
                for (int m = 0; m < 4; ++m)
#pragma unroll
                    for (int n = 0; n < 2; ++n) acc[a][b][m][n] = (f32x4){0.f, 0.f, 0.f, 0.f};
        cur = nxt; cA = nA; cB = nB; ++ui;
        if constexpr (ALIGN_EPI) { if (wr == 1) PG8_BAR; }
    }
    PG8_WAIT_V(0);
    if constexpr (!ALIGN_EPI) { if (wr == 0) PG8_BAR; }
    PG8_BAR;
    if constexpr (Epi::AFTER_DRAIN) { E.fused(acc, cur, wr, wc, fr, fq, lds, wid, lane); S.done(cur); }
#undef PG8_SA
#undef PG8_SB
#undef PG8_STAGE
#undef PG8_LDA
#undef PG8_LDB
#undef PG8_MMA
#undef PG8_WAIT_V
#undef PG8_WAIT_L
#undef PG8_BAR
#undef PG8_SCHED
}
}
#include <hip/hip_bf16.h>
namespace attn_body {
using bf16=__hip_bfloat16;
using bf16x8=__attribute__((ext_vector_type(8)))short;
using s16x4=__attribute__((ext_vector_type(4)))short;
using f32x16=__attribute__((ext_vector_type(16)))float;
using u32x4=__attribute__((ext_vector_type(4)))unsigned;
constexpr int SEQ=16384,D=64,PQ=512,PK=512,PV=512,PO=1024;
constexpr int NW=8,QBLK=32,QB=QBLK*NW,KVBLK=64,NQB=SEQ/QB;
constexpr int ATTN_UNIT_ROWS=QB;
__device__ __forceinline__ int crow(int r,int hi){return (r&3)+8*(r>>2)+4*hi;}
#define SBAR() __builtin_amdgcn_sched_barrier(0)
__device__ __forceinline__ void cmask(f32x16&p0,f32x16&p1,int jb,int qrel,int hi){
  const float NEG=-INFINITY; int kb=64*jb+4*hi;
  #pragma unroll
  for(int r=0;r<16;++r){int kv=kb+(r&3)+8*(r>>2); if(kv>qrel)p0[r]=NEG; if(kv+32>qrel)p1[r]=NEG;}
}

constexpr int NSLOT=3, SLOTB=8192;
constexpr int LDS_K=0, LDS_V=NSLOT*SLOTB, LDS_WS=2*NSLOT*SLOTB, LDS_OST=LDS_WS+NW*64*4, LDS_BYTES=LDS_OST+NW*4096;
constexpr float C2=0.125f*1.4426950408889634f;
__device__ __forceinline__ void glds16(const void*gsrc,unsigned lds_dst){unsigned keep;
  asm volatile("s_mov_b32 %0, m0\n\ts_mov_b32 m0, %2\n\ts_nop 0\n\tglobal_load_lds_dwordx4 %1, off\n\ts_mov_b32 m0, %0":"=&s"(keep):"v"(gsrc),"s"(lds_dst):"memory");}
__device__ __forceinline__ float max3f(float a,float b,float c){float r;asm("v_max3_f32 %0, %1, %2, %3":"=v"(r):"v"(a),"v"(b),"v"(c));return r;}
__device__ __forceinline__ float max2f(float a,float b){float r;asm("v_max_f32_e32 %0, %1, %2":"=v"(r):"v"(a),"v"(b));return r;}
__device__ __forceinline__ float fadd_s(float a,float b){float r;asm("v_add_f32_e32 %0, %1, %2":"=v"(r):"v"(a),"v"(b));return r;}
__device__ __forceinline__ float fsub_s(float a,float b){float r;asm("v_sub_f32_e32 %0, %1, %2":"=v"(r):"v"(a),"v"(b));return r;}
typedef float f32x2_t __attribute__((ext_vector_type(2))); typedef __bf16 bf16x2_t __attribute__((ext_vector_type(2)));
__device__ __forceinline__ unsigned cvtpk_s(float lo,float hi){f32x2_t v={lo,hi};bf16x2_t b=__builtin_convertvector(v,bf16x2_t);return __builtin_bit_cast(unsigned,b);}
#define WAIT_BAR(N) asm volatile("s_waitcnt vmcnt(" #N ") lgkmcnt(0)\n\ts_barrier":::"memory")

__device__ __forceinline__ void qkt(f32x16&p0,f32x16&p1,const char*Kslot,const bf16x8*qr,const f32x16&negm,int r32,int hi){
  const char*kb=Kslot+hi*1024+r32*16;
  #pragma unroll
  for(int d0=0;d0<4;++d0){
    const bf16x8 b0=*reinterpret_cast<const bf16x8*>(kb+d0*2048);
    const bf16x8 b1=*reinterpret_cast<const bf16x8*>(kb+d0*2048+512);
    if(d0==0){p0=__builtin_amdgcn_mfma_f32_32x32x16_bf16(b0,qr[0],negm,0,0,0);p1=__builtin_amdgcn_mfma_f32_32x32x16_bf16(b1,qr[0],negm,0,0,0);}
    else{p0=__builtin_amdgcn_mfma_f32_32x32x16_bf16(b0,qr[d0],p0,0,0,0);p1=__builtin_amdgcn_mfma_f32_32x32x16_bf16(b1,qr[d0],p1,0,0,0);}}
}
typedef __attribute__((address_space(3))) const char* lds_cptr;
typedef short v4i16_t __attribute__((ext_vector_type(4)));
__device__ __forceinline__ void kload8(bf16x8*kf,lds_cptr kp){
  kf[0]=*(const __attribute__((address_space(3))) bf16x8*)(kp);      kf[1]=*(const __attribute__((address_space(3))) bf16x8*)(kp+512);
  kf[2]=*(const __attribute__((address_space(3))) bf16x8*)(kp+2048); kf[3]=*(const __attribute__((address_space(3))) bf16x8*)(kp+2560);
  kf[4]=*(const __attribute__((address_space(3))) bf16x8*)(kp+4096); kf[5]=*(const __attribute__((address_space(3))) bf16x8*)(kp+4608);
  kf[6]=*(const __attribute__((address_space(3))) bf16x8*)(kp+6144); kf[7]=*(const __attribute__((address_space(3))) bf16x8*)(kp+6656);
}
__device__ __forceinline__ void kload2(bf16x8*kf,lds_cptr kp,int j){ kf[2*j]=*(const __attribute__((address_space(3))) bf16x8*)(kp+j*2048); kf[2*j+1]=*(const __attribute__((address_space(3))) bf16x8*)(kp+j*2048+512); }
__device__ __forceinline__ s16x4 vtr(lds_cptr p){ return __builtin_bit_cast(s16x4,__builtin_amdgcn_ds_read_tr16_b64_v4i16((__attribute__((address_space(3))) v4i16_t*)p)); }
__device__ __forceinline__ float rowmax(const f32x16&p0,const f32x16&p1){
  float a=max3f(p0[0],p0[1],p1[0]),b=max3f(p0[2],p0[3],p1[1]);a=max3f(a,p1[2],p1[3]);
  #pragma unroll
  for(int r=4;r<16;r+=4){a=max3f(a,p0[r],p0[r+1]);b=max3f(b,p0[r+2],p0[r+3]);a=max3f(a,p1[r],p1[r+1]);b=max3f(b,p1[r+2],p1[r+3]);}
  const float m=max2f(a,b);
  auto rr=__builtin_amdgcn_permlane32_swap(__float_as_uint(m),__float_as_uint(m),false,false);
  return max2f(__uint_as_float(rr[0]),__uint_as_float(rr[1]));
}
__device__ __forceinline__ void pv(f32x16*o,int vb,bf16x8 pa0,bf16x8 pa1,bf16x8 pa2,bf16x8 pa3){
  #pragma unroll
  for(int d0=0;d0<2;++d0){s16x4 lo[4],hi[4];
    #pragma unroll
    for(int ks=0;ks<4;++ks){
      asm volatile("ds_read_b64_tr_b16 %0,%1 offset:%c2":"=&v"(lo[ks]):"v"(vb),"i"(d0*4096+ks*1024):"memory");
      asm volatile("ds_read_b64_tr_b16 %0,%1 offset:%c2":"=&v"(hi[ks]):"v"(vb),"i"(d0*4096+ks*1024+512):"memory");}
    asm volatile("s_waitcnt lgkmcnt(0)":::"memory");SBAR();
    #define PK(k) (bf16x8){lo[k][0],lo[k][1],lo[k][2],lo[k][3],hi[k][0],hi[k][1],hi[k][2],hi[k][3]}
    o[d0]=__builtin_amdgcn_mfma_f32_32x32x16_bf16(pa0,PK(0),o[d0],0,0,0);
    o[d0]=__builtin_amdgcn_mfma_f32_32x32x16_bf16(pa1,PK(1),o[d0],0,0,0);
    o[d0]=__builtin_amdgcn_mfma_f32_32x32x16_bf16(pa2,PK(2),o[d0],0,0,0);
    o[d0]=__builtin_amdgcn_mfma_f32_32x32x16_bf16(pa3,PK(3),o[d0],0,0,0);
    #undef PK
  }
}

#ifndef ATTN_STORE16
#define ATTN_STORE16(p,v) (*(u32x4*)(p)=(v))
#endif
template<int THRL> __device__ __forceinline__ void attn_unit(int qb,const bf16*Q,const bf16*__restrict__ Kh,const bf16*__restrict__ Vh,bf16*O,char*shm){
  int tid_=threadIdx.x; asm volatile("":"+v"(tid_)); const int tid=tid_,lane=tid&63,r32=lane&31,hi=lane>>5; const int wid=__builtin_amdgcn_readfirstlane(tid>>6);
  const int q0=qb*QB;
  const bf16*Qw=Q+(long)(q0+wid*QBLK)*PQ;
  const unsigned lds0=(unsigned)(uintptr_t)shm;
  float*wsf=(float*)(shm+LDS_WS)+wid*64;
  const bf16*ksrc=Kh+(long)lane*PK+wid*8;
  const bf16*vsrc=Vh+(long)(16*(wid&3)+(lane>>2))*PV+(wid>>2)*32+(lane&3)*8;
  const unsigned kdst=lds0+LDS_K+wid*1024, vdst=lds0+LDS_V+wid*1024;
  #define DMA_K(t,slot) glds16(ksrc+(long)(t)*KVBLK*PK,(unsigned)__builtin_amdgcn_readfirstlane(kdst+(slot)))
  #define DMA_V(t,slot) glds16(vsrc+(long)(t)*KVBLK*PV,(unsigned)__builtin_amdgcn_readfirstlane(vdst+(slot)))
  const int vb0=(int)(lds0+LDS_V)+((lane>>4)&1)*32+(lane&3)*8+(4*hi+((lane&15)>>2))*64;
  const char*Kbase=shm+LDS_K; bf16x8 kf[8];
  const lds_cptr shm3=(lds_cptr)shm; const lds_cptr kp0=shm3+LDS_K+hi*1024+r32*16; const lds_cptr vp0=shm3+LDS_V+((lane>>4)&1)*32+(lane&3)*8+(4*hi+((lane&15)>>2))*64;
  const int NT=(q0+QB)/KVBLK;
  DMA_K(0,0);DMA_V(0,0);DMA_K(1,SLOTB);
  bf16x8 qr[4];
  #pragma unroll
  for(int d0=0;d0<4;++d0)qr[d0]=*reinterpret_cast<const bf16x8*>(&Qw[(long)r32*PQ+d0*16+hi*8]);
  float mhat=0.f,l_reg=0.f;f32x16 o[2];o[0]=f32x16{};o[1]=f32x16{};f32x16 negm=f32x16{};asm volatile("":"+v"(negm));
  const int qrel=wid*QBLK+r32;
  #define CMASK(P0,P1,t) do{int jb_=(t)-(NT-4); if(jb_>=0)cmask(P0,P1,jb_,qrel,hi);}while(0)
  bool resc=false;
  #define START(P0,P1) do{ const float rm=rowmax(P0,P1); resc=false; \
    { const float dl=rm; mhat=fadd_s(mhat,dl); \
      _Pragma("unroll") for(int r=0;r<16;++r){P0[r]=fsub_s(P0[r],dl);P1[r]=fsub_s(P1[r],dl);} \
      _Pragma("unroll") for(int r=0;r<16;++r)negm[r]=-mhat; asm volatile("":"+v"(negm)); } \
    _Pragma("unroll") for(int r=0;r<16;++r)P0[r]=__builtin_amdgcn_exp2f(P0[r]); }while(0)
  #define RESC() do{ if(resc){ asm volatile("s_waitcnt lgkmcnt(0)":::"memory"); \
      _Pragma("unroll") for(int d_=0;d_<2;++d_) _Pragma("unroll") for(int r=0;r<16;++r)o[d_][r]*=wsf[crow(r,hi)]; } }while(0)
  f32x16 pA0,pA1,pB0,pB1;
  int sl_prev=0,sl_cur=0,sl_next=SLOTB;
  #define ROT() do{sl_prev=sl_cur;sl_cur=sl_next;sl_next=(sl_next==(NSLOT-1)*SLOTB)?0:sl_next+SLOTB;}while(0)
  DMA_K(2,2*SLOTB);
  WAIT_BAR(3);
  qkt(pA0,pA1,Kbase,qr,negm,r32,hi);asm volatile("s_nop 15\n\ts_nop 7":"+v"(pA0),"+v"(pA1));CMASK(pA0,pA1,0);
  START(pA0,pA1);
  _Pragma("unroll") for(int r=0;r<16;++r)pA1[r]=__builtin_amdgcn_exp2f(pA1[r]);
  WAIT_BAR(0);
  DMA_K(3,0);DMA_V(1,SLOTB);
  ROT();
  kload8(kf,kp0+sl_cur);
  WAIT_BAR(2);
  s16x4 vlo[8],vhi[8]; u32x4 pw0,pw1,pw2,pw3;
  #define PKW(P,B) cvtpk_s(P[B],P[B+1])
  #define PAF(k) __builtin_bit_cast(bf16x8,pw##k)
  #define VFR(i) (bf16x8){vlo[i][0],vlo[i][1],vlo[i][2],vlo[i][3],vhi[i][0],vhi[i][1],vhi[i][2],vhi[i][3]}
  #define PIN(x) asm volatile("":"+v"(x))
  #define MX3(a,b,c) __builtin_fmaxf(__builtin_fmaxf((a),(b)),(c))
  #define GAPA(MF,A0,A1,A2,A3,W0,W1,PW) do{ MF; sacc+=A0; sacc+=A1; sacc+=A2; sacc+=A3; PIN(sacc); W0; W1; PIN(PW); SBAR(); }while(0)
  #define EX(v) __builtin_amdgcn_exp2f(v)
  #define GAPB(MF,X,B) do{ MF; X[B]=EX(X[B]); X[B+1]=EX(X[B+1]); X[B+2]=EX(X[B+2]); X[B+3]=EX(X[B+3]); PIN(X); SBAR(); }while(0)
  #define VRD(i) do{ vlo[i]=vtr(vp_+(((i)>>2)*4096+((i)&3)*1024)); vhi[i]=vtr(vp_+(((i)>>2)*4096+((i)&3)*1024+512)); }while(0)
  #define KRD(G,j) do{ if(G){ kload2(kf,kp0+sl_next,j); SBAR(); } }while(0)
  #define STEP(C0,C1,P0,P1,t,GK,GV,GL) do{ SBAR(); \
    const lds_cptr vp_=vp0+sl_prev; \
    VRD(0); SBAR(); float sacc=(P0[0]+P0[1]); \
    GAPA(C0=__builtin_amdgcn_mfma_f32_32x32x16_bf16(kf[0],qr[0],negm,0,0,0), P0[2],P0[3],P0[4],P0[5],     pw0[0]=PKW(P0,0), pw0[1]=PKW(P0,2), pw0); \
    VRD(4); SBAR(); GAPA(C1=__builtin_amdgcn_mfma_f32_32x32x16_bf16(kf[1],qr[0],negm,0,0,0), P0[6],P0[7],P0[8],P0[9],     pw0[2]=PKW(P0,4), pw0[3]=PKW(P0,6), pw0); \
    VRD(1); SBAR(); GAPA(C0=__builtin_amdgcn_mfma_f32_32x32x16_bf16(kf[2],qr[1],C0,0,0,0),   P0[10],P0[11],P0[12],P0[13], pw1[0]=PKW(P0,8), pw1[1]=PKW(P0,10), pw1); \
    VRD(5); SBAR(); GAPA(C1=__builtin_amdgcn_mfma_f32_32x32x16_bf16(kf[3],qr[1],C1,0,0,0),   P0[14],P0[15],P1[0],P1[1],   pw1[2]=PKW(P0,12),pw1[3]=PKW(P0,14), pw1); \
    VRD(2); SBAR(); GAPA(C0=__builtin_amdgcn_mfma_f32_32x32x16_bf16(kf[4],qr[2],C0,0,0,0),   P1[2],P1[3],P1[4],P1[5],     pw2[0]=PKW(P1,0), pw2[1]=PKW(P1,2), pw2); \
    VRD(6); SBAR(); GAPA(C1=__builtin_amdgcn_mfma_f32_32x32x16_bf16(kf[5],qr[2],C1,0,0,0),   P1[6],P1[7],P1[8],P1[9],     pw2[2]=PKW(P1,4), pw2[3]=PKW(P1,6), pw2); \
    VRD(3); SBAR(); GAPA(C0=__builtin_amdgcn_mfma_f32_32x32x16_bf16(kf[6],qr[3],C0,0,0,0),   P1[10],P1[11],P1[12],P1[13], pw3[0]=PKW(P1,8), pw3[1]=PKW(P1,10), pw3); \
    VRD(7); SBAR(); GAPA(C1=__builtin_amdgcn_mfma_f32_32x32x16_bf16(kf[7],qr[3],C1,0,0,0),   P1[14],P1[15],0.f,0.f,       pw3[2]=PKW(P1,12),pw3[3]=PKW(P1,14), pw3); \
    l_reg+=sacc; \
    if(GK){DMA_K((t)+3,sl_cur);} if(GV){DMA_V((t)+1,sl_next);} \
    CMASK(C0,C1,t); \
    { float a=MX3(C0[0],C0[1],C1[0]),b=MX3(C0[2],C0[3],C1[1]); a=MX3(a,C1[2],C1[3]); \
      _Pragma("unroll") for(int r=4;r<16;r+=4){a=MX3(a,C0[r],C0[r+1]);b=MX3(b,C0[r+2],C0[r+3]);a=MX3(a,C1[r],C1[r+1]);b=MX3(b,C1[r+2],C1[r+3]);} \
      float rm=__builtin_fmaxf(a,b); { auto rr=__builtin_amdgcn_permlane32_swap(__float_as_uint(rm),__float_as_uint(rm),false,false); rm=__builtin_fmaxf(__uint_as_float(rr[0]),__uint_as_float(rr[1])); } \
      resc=false; \
      if(__builtin_expect(__any(rm>(float)THRL),0)){ const float dl=__builtin_fmaxf(rm,0.f); mhat+=dl; \
        _Pragma("unroll") for(int r=0;r<16;++r){C0[r]-=dl;C1[r]-=dl;} \
        _Pragma("unroll") for(int r=0;r<16;++r)negm[r]=-mhat; asm volatile("":"+v"(negm)); \
        const float f=__builtin_amdgcn_exp2f(-dl); l_reg*=f; if(hi==0)wsf[r32]=f; resc=true; } } \
    SBAR(); \
    GAPB(o[0]=__builtin_amdgcn_mfma_f32_32x32x16_bf16(PAF(0),VFR(0),o[0],0,0,0), C0,0); \
    GAPB(o[1]=__builtin_amdgcn_mfma_f32_32x32x16_bf16(PAF(0),VFR(4),o[1],0,0,0), C0,4); \
    KRD(GL,0); GAPB(o[0]=__builtin_amdgcn_mfma_f32_32x32x16_bf16(PAF(1),VFR(1),o[0],0,0,0), C0,8); \
    KRD(GL,1); GAPB(o[1]=__builtin_amdgcn_mfma_f32_32x32x16_bf16(PAF(1),VFR(5),o[1],0,0,0), C0,12); \
    KRD(GL,2); GAPB(o[0]=__builtin_amdgcn_mfma_f32_32x32x16_bf16(PAF(2),VFR(2),o[0],0,0,0), C1,0); \
    KRD(GL,3); GAPB(o[1]=__builtin_amdgcn_mfma_f32_32x32x16_bf16(PAF(2),VFR(6),o[1],0,0,0), C1,4); \
    GAPB(o[0]=__builtin_amdgcn_mfma_f32_32x32x16_bf16(PAF(3),VFR(3),o[0],0,0,0), C1,8); \
    GAPB(o[1]=__builtin_amdgcn_mfma_f32_32x32x16_bf16(PAF(3),VFR(7),o[1],0,0,0), C1,12); \
    }while(0)
  int t=1;
  #undef CMASK
  #define CMASK(P0,P1,t) do{}while(0)
  for(;t+5<NT;t+=2){
    STEP(pB0,pB1,pA0,pA1,t,true,true,true);     WAIT_BAR(2); RESC(); ROT();
    STEP(pA0,pA1,pB0,pB1,t+1,true,true,true);   WAIT_BAR(2); RESC(); ROT();
  }
  #undef CMASK
  #define CMASK(P0,P1,t) do{int jb_=(t)-(NT-4); if(jb_>=0)cmask(P0,P1,jb_,qrel,hi);}while(0)
  #define ENDW(tt) do{ if((tt)+3<NT){WAIT_BAR(2);} else if((tt)+2<NT){WAIT_BAR(1);} else {WAIT_BAR(0);} }while(0)
  for(;t+1<NT;t+=2){
    STEP(pB0,pB1,pA0,pA1,t,(t+3<NT),(t+1<NT),(t+1<NT));       ENDW(t);   RESC(); ROT();
    STEP(pA0,pA1,pB0,pB1,t+1,(t+4<NT),(t+2<NT),(t+2<NT));     ENDW(t+1); RESC(); ROT();
  }
  STEP(pB0,pB1,pA0,pA1,NT-1,false,false,false); RESC();
  { float sacc=pB0[0]+pB0[1]; _Pragma("unroll") for(int r=2;r<16;++r)sacc+=pB0[r]; _Pragma("unroll") for(int r=0;r<16;++r)sacc+=pB1[r]; l_reg+=sacc;
    pw0=(u32x4){PKW(pB0,0),PKW(pB0,2),PKW(pB0,4),PKW(pB0,6)};pw1=(u32x4){PKW(pB0,8),PKW(pB0,10),PKW(pB0,12),PKW(pB0,14)};pw2=(u32x4){PKW(pB1,0),PKW(pB1,2),PKW(pB1,4),PKW(pB1,6)};pw3=(u32x4){PKW(pB1,8),PKW(pB1,10),PKW(pB1,12),PKW(pB1,14)};
    SBAR(); pv(o,vb0+sl_cur,PAF(0),PAF(1),PAF(2),PAF(3)); }
  #undef PKW
  #undef PAF
  #undef VFR
  #undef PIN
  #undef MX3
  #undef GAPA
  #undef GAPB
  #undef EX
  #undef VRD
  #undef KRD
  #undef STEP
  #undef ENDW
  {auto rr=__builtin_amdgcn_permlane32_swap(__float_as_uint(l_reg),__float_as_uint(l_reg),false,false);l_reg=__uint_as_float(rr[0])+__uint_as_float(rr[1]);}
  if(hi==0)wsf[32+r32]=l_reg;asm volatile("s_waitcnt lgkmcnt(0)":::"memory");
  float rli[16];
  #pragma unroll
  for(int r=0;r<16;++r)rli[r]=__builtin_amdgcn_rcpf(wsf[32+crow(r,hi)]);
  bf16*Ow=O+(long)(q0+wid*QBLK)*PO;
  { bf16*stg=(bf16*)(shm+LDS_OST)+wid*2048;
    #pragma unroll
    for(int r=0;r<16;++r){const int orow=crow(r,hi);
      #pragma unroll
      for(int d0=0;d0<2;++d0)stg[orow*64+d0*32+r32]=__float2bfloat16(o[d0][r]*rli[r]);}
    asm volatile("s_waitcnt lgkmcnt(0)":::"memory");
    #pragma unroll
    for(int i=0;i<4;++i){const int row=i*8+(lane>>3),ch=lane&7; const u32x4 v=*(const u32x4*)(stg+row*64+ch*8); ATTN_STORE16(Ow+(long)row*PO+ch*8,v);} }
  asm volatile("s_waitcnt lgkmcnt(0)\n\ts_barrier":::"memory");
  #undef DMA_K
  #undef DMA_V
  #undef CMASK
  #undef START
  #undef RESC
  #undef ROT
}
constexpr int ATTN_LDS_BYTES=LDS_BYTES;
#undef SBAR
#undef WAIT_BAR
}
namespace cg = cooperative_groups;
#define GAS __attribute__((address_space(1)))
#define LAS __attribute__((address_space(3)))
typedef unsigned short bf16;
typedef unsigned v4u __attribute__((ext_vector_type(4)));
typedef unsigned v2u __attribute__((ext_vector_type(2)));
typedef float f32x4 __attribute__((ext_vector_type(4)));
typedef short bf16x8 __attribute__((ext_vector_type(8)));
typedef short s16x4 __attribute__((ext_vector_type(4)));

#ifndef MK_ONE_LAUNCH
#define MK_ONE_LAUNCH 1
#endif
constexpr int NWAVES = 8;
constexpr int SEQ = 16384, DM = 1024, NIN = 8704, NMAIN = 5632, NGATE = 3072, DEPTH = 2;
constexpr float EPS = 1e-6f;
constexpr float QSCALE = 0.125f * 1.4426950408889634f;
constexpr size_t MiB = 1u << 20;
constexpr size_t WS_ROPE = 0;
constexpr size_t WS_WIN = 1 * MiB;
constexpr size_t WS_WB = 18 * MiB;
constexpr size_t WS_WO = 21 * MiB;
constexpr size_t WS_HB = 23 * MiB;
constexpr size_t WS_O = 55 * MiB;
constexpr size_t WS_PJ = 87 * MiB;
constexpr size_t SLOT_ELEMS = (size_t)SEQ * 512;
constexpr size_t WS_END = WS_PJ + 11 * SLOT_ELEMS * 2;
enum { SL_AQ = 0, SL_AK = 1, SL_AV = 2, SL_BU = 3, SL_BV = 4, SL_CQ = 5, SL_CK = 6, SL_CV = 7, SL_AZ = 8, SL_BZ = 9, SL_CZ = 10 };

constexpr int LDS_BYTES = 147456;

__device__ __forceinline__ unsigned f2bf(float f) { unsigned u = __builtin_bit_cast(unsigned, f); return (u + 0x7fffu + ((u >> 16) & 1u)) >> 16; }
typedef float f32x2_t __attribute__((ext_vector_type(2))); typedef __bf16 bf16x2_t __attribute__((ext_vector_type(2)));
__device__ __forceinline__ unsigned pk2(float lo, float hi) { f32x2_t v = {lo, hi}; bf16x2_t b = __builtin_convertvector(v, bf16x2_t); return __builtin_bit_cast(unsigned, b); }
__device__ __forceinline__ float bflo(unsigned w) { return __uint_as_float(w << 16); }
__device__ __forceinline__ float bfhi(unsigned w) { return __uint_as_float(w & 0xffff0000u); }
__device__ __forceinline__ float fexp2(float x) { return __builtin_amdgcn_exp2f(x); }
__device__ __forceinline__ float frcp(float x) { return __builtin_amdgcn_rcpf(x); }
__device__ __forceinline__ float sigmoid_f(float x) { return frcp(1.f + fexp2(-1.4426950408889634f * x)); }
__device__ __forceinline__ float silu_f(float x) { return x * sigmoid_f(x); }
__device__ __forceinline__ float gelu_tanh_f(float x) { const float y = 0.7978845608028654f * (x + 0.044715f * x * x * x); return x * frcp(1.f + fexp2(-2.885390081777927f * y)); }
__device__ __forceinline__ float wave_sum(float v) {
#pragma unroll
    for (int o = 1; o < 64; o <<= 1) v += __shfl_xor(v, o);
    return v;
}

struct EpiProj {
    static constexpr bool PERM = true, AFTER_DRAIN = false;
    bf16* PJ; const float* rc; const float* rs;
    __device__ __forceinline__ void operator()(const f32x4 (&acc)[2][2][4][2], const pg8::Unit& u, int wr, int wc, int fr_, int fq_) const {
        int fr = fr_, fq = fq_; asm volatile("" : "+v"(fr), "+v"(fq));
        const int grp = u.pn >> 1;
        const int slot = (int)((0xA7659438210ull >> (4 * grp)) & 15ull);
        const int act = (int)((0x10341221034ull >> (4 * grp)) & 15ull);
        bf16* base = PJ + (size_t)slot * SLOT_ELEMS;
        const int row0 = u.pm * 256 + wr * 64 + fr, col0 = (u.pn & 1) * 256 + wc * 32 + 8 * fq;
        const bool ropew = (act >= 3) && ((wc & 1) == 0);
        const float sgn = (fq == 0) ? -1.f : 1.f; const bool ropel = fq < 2;
        const float qs = (act == 4) ? QSCALE : 1.f;
#pragma unroll
        for (int ai = 0; ai < 2; ++ai)
#pragma unroll
            for (int m = 0; m < 4; ++m) {
                const int row = row0 + ai * 128 + m * 16;
                f32x4 c0 = {1.f, 1.f, 1.f, 1.f}, c1 = c0, s0 = {0.f, 0.f, 0.f, 0.f}, s1 = s0;
                if (ropew) { c0 = *(const f32x4*)(rc + row * 8); c1 = *(const f32x4*)(rc + row * 8 + 4); s0 = *(const f32x4*)(rs + row * 8); s1 = *(const f32x4*)(rs + row * 8 + 4); }
#pragma unroll
                for (int bj = 0; bj < 2; ++bj) {
                    f32x4 v0 = acc[ai][bj][m][0], v1 = acc[ai][bj][m][1];
                    if (ropew) {
                        f32x4 o0, o1;
#pragma unroll
                        for (int e = 0; e < 4; ++e) { o0[e] = __shfl_xor(v0[e], 16); o1[e] = __shfl_xor(v1[e], 16); }
                        if (ropel) { v0 = v0 * c0 + sgn * (o0 * s0); v1 = v1 * c1 + sgn * (o1 * s1); }
                    }
                    if (act == 1) {
#pragma unroll
                        for (int e = 0; e < 4; ++e) { v0[e] = silu_f(v0[e]); v1[e] = silu_f(v1[e]); }
                    } else if (act == 2) {
#pragma unroll
                        for (int e = 0; e < 4; ++e) { v0[e] = gelu_tanh_f(v0[e]); v1[e] = gelu_tanh_f(v1[e]); }
                    }
                    v0 = v0 * qs; v1 = v1 * qs;
                    v4u w; w.x = pk2(v0[0], v0[1]); w.y = pk2(v0[2], v0[3]); w.z = pk2(v1[0], v1[1]); w.w = pk2(v1[2], v1[3]);
                    *(v4u*)(base + (size_t)row * 512 + col0 + bj * 128) = w; asm volatile("" ::: "memory");
                }
            }
    }
};
struct EpiGate {
    static constexpr bool PERM = true, AFTER_DRAIN = false;
    bf16* GL;
    __device__ __forceinline__ void operator()(const f32x4 (&acc)[2][2][4][2], const pg8::Unit& u, int wr, int wc, int fr_, int fq_) const {
        int fr = fr_, fq = fq_; asm volatile("" : "+v"(fr), "+v"(fq));
        const int row0 = u.pm * 256 + wr * 64 + fr, col0 = u.pn * 256 + wc * 32 + 8 * fq;
#pragma unroll
        for (int ai = 0; ai < 2; ++ai)
#pragma unroll
            for (int m = 0; m < 4; ++m) {
                const int row = row0 + ai * 128 + m * 16;
#pragma unroll
                for (int bj = 0; bj < 2; ++bj) {
                    f32x4 v0 = acc[ai][bj][m][0], v1 = acc[ai][bj][m][1];
#pragma unroll
                    for (int e = 0; e < 4; ++e) { v0[e] = sigmoid_f(v0[e]); v1[e] = sigmoid_f(v1[e]); }
                    v4u w; w.x = pk2(v0[0], v0[1]); w.y = pk2(v0[2], v0[3]); w.z = pk2(v1[0], v1[1]); w.w = pk2(v1[2], v1[3]);
                    *(v4u*)(GL + (size_t)row * NGATE + col0 + bj * 128) = w; asm volatile("" ::: "memory");
                }
            }
    }
};
struct EpiMerge {
    static constexpr bool PERM = true, AFTER_DRAIN = false;
    const bf16* GL; bf16* MG; int BR;
    __device__ __forceinline__ void operator()(const f32x4 (&acc)[2][2][4][2], const pg8::Unit& u, int wr, int wc, int fr_, int fq_) const {
        int fr = fr_, fq = fq_; asm volatile("" : "+v"(fr), "+v"(fq));
        const int row0 = u.pm * 256 + wr * 64 + fr, col0 = u.pn * 256 + wc * 32 + 8 * fq;
#pragma unroll
        for (int ai = 0; ai < 2; ++ai)
#pragma unroll
            for (int m = 0; m < 4; ++m) {
                const int row = row0 + ai * 128 + m * 16;
#pragma unroll
                for (int bj = 0; bj < 2; ++bj) {
                    const v4u g = *(const v4u*)(GL + (size_t)row * NGATE + BR * 1024 + col0 + bj * 128);
                    bf16* mp = MG + (size_t)row * DM + col0 + bj * 128;
                    f32x4 v0 = acc[ai][bj][m][0], v1 = acc[ai][bj][m][1];
                    v0[0] *= bflo(g.x); v0[1] *= bfhi(g.x); v0[2] *= bflo(g.y); v0[3] *= bfhi(g.y);
                    v1[0] *= bflo(g.z); v1[1] *= bfhi(g.z); v1[2] *= bflo(g.w); v1[3] *= bfhi(g.w);
                    if (BR > 0) { const v4u o = *(const v4u*)mp;
                        v0[0] += bflo(o.x); v0[1] += bfhi(o.x); v0[2] += bflo(o.y); v0[3] += bfhi(o.y);
                        v1[0] += bflo(o.z); v1[1] += bfhi(o.z); v1[2] += bflo(o.w); v1[3] += bfhi(o.w); }
                    v4u w; w.x = pk2(v0[0], v0[1]); w.y = pk2(v0[2], v0[3]); w.z = pk2(v1[0], v1[1]); w.w = pk2(v1[2], v1[3]);
                    *(v4u*)mp = w; asm volatile("" ::: "memory");
                }
            }
    }
};
struct EpiOut {
    static constexpr bool PERM = true, AFTER_DRAIN = false;
    const float* res; float* out;
    __device__ __forceinline__ void operator()(const f32x4 (&acc)[2][2][4][2], const pg8::Unit& u, int wr, int wc, int fr_, int fq_) const {
        int fr = fr_, fq = fq_; asm volatile("" : "+v"(fr), "+v"(fq));
        const int row0 = u.pm * 256 + wr * 64 + fr, col0 = u.pn * 256 + wc * 32 + 8 * fq;
#pragma unroll
        for (int ai = 0; ai < 2; ++ai)
#pragma unroll
            for (int m = 0; m < 4; ++m) {
                const int row = row0 + ai * 128 + m * 16;
#pragma unroll
                for (int bj = 0; bj < 2; ++bj) {
                    const size_t off = (size_t)row * DM + col0 + bj * 128;
                    const f32x4 r0 = *(const f32x4*)(res + off), r1 = *(const f32x4*)(res + off + 4);
                    *(f32x4*)(out + off) = r0 + acc[ai][bj][m][0]; *(f32x4*)(out + off + 4) = r1 + acc[ai][bj][m][1]; asm volatile("" ::: "memory");
                }
            }
    }
};

__device__ __forceinline__ void p0_transpose_item(const float* W, int K, int N, bf16* WT, int row_off, LAS float* scr, int item, int lane) {
    const int nblk = N / 32, kb = item / nblk, nb = item % nblk, k0 = 64 * kb, n0 = 32 * nb;
#pragma unroll 8
    for (int i = 0; i < 32; ++i) { const int kk = 2 * i + (lane >> 5); scr[kk * 33 + (lane & 31)] = W[(size_t)(k0 + kk) * N + n0 + (lane & 31)]; }
    asm volatile("s_waitcnt lgkmcnt(0)" ::: "memory");
    const int c = lane & 7;
#pragma unroll
    for (int j = 0; j < 4; ++j) { const int n = (lane >> 3) + 8 * j; const LAS float* s = scr + (8 * c) * 33 + n;
        v4u o; o.x = pk2(s[0 * 33], s[1 * 33]); o.y = pk2(s[2 * 33], s[3 * 33]); o.z = pk2(s[4 * 33], s[5 * 33]); o.w = pk2(s[6 * 33], s[7 * 33]);
        *(v4u*)(WT + (size_t)(row_off + n0 + n) * K + k0 + 8 * c) = o; }
    asm volatile("s_waitcnt lgkmcnt(0)" ::: "memory");
}
__device__ __forceinline__ void rms_row_to_bf16(const float* xrow, const float* g, bf16* orow, int lane) {
    const f32x4* xr = (const f32x4*)xrow + lane; const f32x4* gr = (const f32x4*)g + lane;
    f32x4 v[4]; float s = 0.f;
#pragma unroll
    for (int j = 0; j < 4; ++j) { v[j] = xr[64 * j]; s += (v[j].x * v[j].x + v[j].y * v[j].y) + (v[j].z * v[j].z + v[j].w * v[j].w); }
    const float r = 1.f / sqrtf(wave_sum(s) * (1.f / DM) + EPS);
    unsigned long long* o8 = (unsigned long long*)orow + lane;
#pragma unroll
    for (int j = 0; j < 4; ++j) { const f32x4 gg = gr[64 * j]; const f32x4 y = v[j] * r * gg; o8[64 * j] = (unsigned long long)pk2(y.x, y.y) | ((unsigned long long)pk2(y.z, y.w) << 32); }
}
__device__ __forceinline__ void rms_row_to_f32(const float* xrow, const float* g, float* orow, int lane) {
    const f32x4* xr = (const f32x4*)xrow + lane; const f32x4* gr = (const f32x4*)g + lane;
    f32x4 v[4]; float s = 0.f;
#pragma unroll
    for (int j = 0; j < 4; ++j) { v[j] = xr[64 * j]; s += (v[j].x * v[j].x + v[j].y * v[j].y) + (v[j].z * v[j].z + v[j].w * v[j].w); }
    const float r = 1.f / sqrtf(wave_sum(s) * (1.f / DM) + EPS);
    f32x4* o = (f32x4*)orow + lane;
#pragma unroll
    for (int j = 0; j < 4; ++j) o[64 * j] = v[j] * r * gr[64 * j];
}

constexpr int SGU_P = 136;
__device__ __forceinline__ void sgu_item(int item, const bf16* BU, const bf16* BV, bf16* BZ, const float* lng, const float* lnb, const float* sw, const float* sb,
                                         LAS unsigned char* lds, int tid, int wid, int lane) {
    const int n = item >> 2, g = item & 3, tok0 = n * 128;
    LAS bf16* Wl = (LAS bf16*)lds; LAS bf16* Vt = (LAS bf16*)(lds + 128 * SGU_P * 2); LAS float* st = (LAS float*)(lds + 2 * 128 * SGU_P * 2);
#pragma unroll 4
    for (int i = 0; i < 16; ++i) {
        const int s = wid * 16 + i;
        const v4u w = *(const v4u*)(BV + (size_t)(tok0 + s) * 512 + lane * 8);
        const float a0 = bflo(w.x), a1 = bfhi(w.x), a2 = bflo(w.y), a3 = bfhi(w.y), a4 = bflo(w.z), a5 = bfhi(w.z), a6 = bflo(w.w), a7 = bfhi(w.w);
        const float mu = wave_sum(((a0 + a1) + (a2 + a3)) + ((a4 + a5) + (a6 + a7))) * (1.f / 512.f);
        const float d0 = a0 - mu, d1 = a1 - mu, d2 = a2 - mu, d3 = a3 - mu, d4 = a4 - mu, d5 = a5 - mu, d6 = a6 - mu, d7 = a7 - mu;
        const float var = wave_sum(((d0 * d0 + d1 * d1) + (d2 * d2 + d3 * d3)) + ((d4 * d4 + d5 * d5) + (d6 * d6 + d7 * d7))) * (1.f / 512.f);
        if (lane == 0) { st[s] = mu; st[128 + s] = 1.f / sqrtf(var + EPS); }
    }
    __syncthreads();
#pragma unroll
    for (int k = 0; k < 4; ++k) {
        const int idx = tid + 512 * k, s = idx >> 4, cch = idx & 15;
        const v4u w = *(const v4u*)(BV + (size_t)(tok0 + s) * 512 + g * 128 + cch * 8);
        const float mu = st[s], rstd = st[128 + s];
        const f32x4 g0 = *(const f32x4*)(lng + g * 128 + cch * 8), g1 = *(const f32x4*)(lng + g * 128 + cch * 8 + 4);
        const f32x4 b0 = *(const f32x4*)(lnb + g * 128 + cch * 8), b1 = *(const f32x4*)(lnb + g * 128 + cch * 8 + 4);
        float a[8] = {bflo(w.x), bfhi(w.x), bflo(w.y), bfhi(w.y), bflo(w.z), bfhi(w.z), bflo(w.w), bfhi(w.w)};
#pragma unroll
        for (int e = 0; e < 8; ++e) { const float gg = e < 4 ? g0[e & 3] : g1[e & 3], bb = e < 4 ? b0[e & 3] : b1[e & 3];
            Vt[(cch * 8 + e) * SGU_P + s] = (bf16)f2bf((a[e] - mu) * rstd * gg + bb); }
    }
#pragma unroll
    for (int k = 0; k < 8; ++k) {
        const int idx = tid + 512 * k, t = idx >> 5, s4 = (idx & 31) * 4;
        const f32x4 w = *(const f32x4*)(sw + ((size_t)g * 128 + t) * 128 + s4);
        v2u o; o.x = pk2(s4 + 0 <= t ? w.x : 0.f, s4 + 1 <= t ? w.y : 0.f); o.y = pk2(s4 + 2 <= t ? w.z : 0.f, s4 + 3 <= t ? w.w : 0.f);
        *(LAS v2u*)(Wl + t * SGU_P + s4) = o;
    }
    __syncthreads();
    const int r = lane & 15, q = lane >> 4;
    f32x4 acc[8];
#pragma unroll
    for (int ct = 0; ct < 8; ++ct) acc[ct] = (f32x4){0.f, 0.f, 0.f, 0.f};
#pragma unroll
    for (int ks = 0; ks < 4; ++ks) {
        const bf16x8 wf = *(const LAS bf16x8*)(Wl + (wid * 16 + r) * SGU_P + ks * 32 + q * 8);
#pragma unroll
        for (int ct = 0; ct < 8; ++ct) {
            const bf16x8 vf = *(const LAS bf16x8*)(Vt + (ct * 16 + r) * SGU_P + ks * 32 + q * 8);
            acc[ct] = __builtin_amdgcn_mfma_f32_16x16x32_bf16(vf, wf, acc[ct], 0, 0, 0);
        }
    }
    const int t = wid * 16 + r; const float bias = sb[g * 128 + t];
#pragma unroll
    for (int ct = 0; ct < 8; ++ct) {
        const size_t off = (size_t)(tok0 + t) * 512 + g * 128 + ct * 16 + q * 4;
        const v2u uu = *(const v2u*)(BU + off), zz = *(const v2u*)(BZ + off);
        v2u o; o.x = pk2((acc[ct][0] + bias) * bflo(uu.x) * bflo(zz.x), (acc[ct][1] + bias) * bfhi(uu.x) * bfhi(zz.x));
        o.y = pk2((acc[ct][2] + bias) * bflo(uu.y) * bflo(zz.y), (acc[ct][3] + bias) * bfhi(uu.y) * bfhi(zz.y));
        *(v2u*)(BZ + off) = o;
    }
    __syncthreads();
}

constexpr int CM_P = 36;
__device__ __forceinline__ void cmix_item(int tb, int h, const bf16* CQ, const bf16* CK, const bf16* CV, bf16* CZ, LAS unsigned char* ldsw, int wid, int lane) {
    const int r = lane & 15, q = lane >> 4, T0 = tb * 128, tq = T0 + wid + 8 * r;
    LAS bf16* Vt = (LAS bf16*)ldsw;
    bf16x8 qf[2];
#pragma unroll
    for (int ks = 0; ks < 2; ++ks) qf[ks] = *(const bf16x8*)(CQ + (size_t)tq * 512 + h * 64 + ks * 32 + q * 8);
    float mrun = -1e30f, lpart = 0.f;
    f32x4 o[4];
#pragma unroll
    for (int dt = 0; dt < 4; ++dt) o[dt] = (f32x4){0.f, 0.f, 0.f, 0.f};
    const int vkey = lane >> 3, vch = lane & 7;
    for (int seg = 0; seg < 3; ++seg) {
        const int sl = seg == 0 ? 0 : (seg == 1 ? 2 : 3);
        const int kbase = seg == 0 ? T0 - 128 : (seg == 1 ? T0 + wid - 512 : T0 + wid - 2048);
        const int nsteps = seg == 0 ? 8 : (seg == 1 ? 5 : 9);
        const int window = seg == 0 ? 128 : (seg == 1 ? 512 : 2048);
        const int dmask = seg == 2 ? 15 : 0;
        for (int stp = 0; stp < nsteps; ++stp) {
            const int kk0 = stp * 32;
            if (kbase + ((kk0 + 31) << sl) < 0) continue;
            int tA = kbase + ((kk0 + r) << sl), tB = kbase + ((kk0 + 16 + r) << sl);
            tA = min(max(tA, 0), SEQ - 1); tB = min(max(tB, 0), SEQ - 1);
            bf16x8 ka[2], kb[2], vv[4];
#pragma unroll
            for (int ks = 0; ks < 2; ++ks) { ka[ks] = *(const bf16x8*)(CK + (size_t)tA * 512 + h * 64 + ks * 32 + q * 8); kb[ks] = *(const bf16x8*)(CK + (size_t)tB * 512 + h * 64 + ks * 32 + q * 8); }
#pragma unroll
            for (int c = 0; c < 4; ++c) { int tv = kbase + ((kk0 + vkey + 8 * c) << sl); tv = min(max(tv, 0), SEQ - 1); vv[c] = *(const bf16x8*)(CV + (size_t)tv * 512 + h * 64 + vch * 8); }
            f32x4 sA = (f32x4){0.f, 0.f, 0.f, 0.f}, sB = sA;
            sA = __builtin_amdgcn_mfma_f32_16x16x32_bf16(ka[0], qf[0], sA, 0, 0, 0); sA = __builtin_amdgcn_mfma_f32_16x16x32_bf16(ka[1], qf[1], sA, 0, 0, 0);
            sB = __builtin_amdgcn_mfma_f32_16x16x32_bf16(kb[0], qf[0], sB, 0, 0, 0); sB = __builtin_amdgcn_mfma_f32_16x16x32_bf16(kb[1], qf[1], sB, 0, 0, 0);
#pragma unroll
            for (int c = 0; c < 4; ++c)
#pragma unroll
                for (int e = 0; e < 8; ++e) Vt[(vch * 8 + e) * CM_P + vkey + 8 * c] = (bf16)vv[c][e];
            float sv[8]; bool ok[8]; float mx = -1e30f;
#pragma unroll
            for (int j = 0; j < 8; ++j) {
                const int kk = kk0 + (j < 4 ? 0 : 16) + 4 * q + (j & 3), tk = kbase + (kk << sl), rel = tq - tk;
                ok[j] = (rel >= 0) && (rel <= window) && (tk >= 0) && ((rel & dmask) == 0);
                sv[j] = ok[j] ? (j < 4 ? sA[j & 3] : sB[j & 3]) : -1e30f; mx = fmaxf(mx, sv[j]);
            }
            mx = fmaxf(mx, __shfl_xor(mx, 16)); mx = fmaxf(mx, __shfl_xor(mx, 32));
            const float mnew = fmaxf(mrun, mx), alpha = fexp2(mrun - mnew); mrun = mnew;
            float p[8], ps = 0.f;
#pragma unroll
            for (int j = 0; j < 8; ++j) { p[j] = ok[j] ? fexp2(sv[j] - mnew) : 0.f; ps += p[j]; }
            lpart = lpart * alpha + ps;
            v4u pw; pw.x = pk2(p[0], p[1]); pw.y = pk2(p[2], p[3]); pw.z = pk2(p[4], p[5]); pw.w = pk2(p[6], p[7]);
            const bf16x8 pf = __builtin_bit_cast(bf16x8, pw);
            asm volatile("s_waitcnt lgkmcnt(0)" ::: "memory");
#pragma unroll
            for (int dt = 0; dt < 4; ++dt) {
                const s16x4 lo = *(const LAS s16x4*)(Vt + (dt * 16 + r) * CM_P + 4 * q), hi = *(const LAS s16x4*)(Vt + (dt * 16 + r) * CM_P + 16 + 4 * q);
                const bf16x8 vf = (bf16x8){lo[0], lo[1], lo[2], lo[3], hi[0], hi[1], hi[2], hi[3]};
                o[dt] = o[dt] * alpha;
                o[dt] = __builtin_amdgcn_mfma_f32_16x16x32_bf16(vf, pf, o[dt], 0, 0, 0);
            }
            asm volatile("s_waitcnt lgkmcnt(0)" ::: "memory");
        }
    }
    float l = lpart; l += __shfl_xor(l, 16); l += __shfl_xor(l, 32);
    const float inv = 1.f / l;
#pragma unroll
    for (int dt = 0; dt < 4; ++dt) {
        const size_t off = (size_t)tq * 512 + h * 64 + dt * 16 + 4 * q;
        const v2u zz = *(const v2u*)(CZ + off);
        v2u w; w.x = pk2(o[dt][0] * inv * bflo(zz.x), o[dt][1] * inv * bfhi(zz.x)); w.y = pk2(o[dt][2] * inv * bflo(zz.y), o[dt][3] * inv * bfhi(zz.y));
        *(v2u*)(CZ + off) = w;
    }
}

struct Args { const void* in[16]; float* out; unsigned char* ws; float inv[8]; int ph_lo, ph_hi; };
constexpr int N_PHASES = 6 * DEPTH + 1;

__global__ void __launch_bounds__(NWAVES * 64, 2) trunk_fwd(Args args) {
    extern __shared__ __attribute__((aligned(16))) unsigned char lds[];
    LAS unsigned char* L = (LAS unsigned char*)lds;
#define FRESH_TID() int tid_ = threadIdx.x; asm volatile("" : "+v"(tid_)); const int tid = tid_, lane = tid & 63, wid = __builtin_amdgcn_readfirstlane(tid >> 6); const int gw = vcu * NWAVES + wid; (void)tid; (void)lane; (void)gw
    const int G = gridDim.x, bx = blockIdx.x;
    const int vcu = (G % 8 == 0) ? (bx % 8) * (G / 8) + bx / 8 : bx;
    const int NGW = G * NWAVES;
    unsigned char* ws = args.ws;
    const float* x_in = (const float*)args.in[0]; const int* pos = (const int*)args.in[1];
    float* out = args.out;
    float* ropec = (float*)(ws + WS_ROPE); float* ropes = ropec + SEQ * 8;
    bf16* WinT = (bf16*)(ws + WS_WIN); bf16* WbT = (bf16*)(ws + WS_WB); bf16* WoT = (bf16*)(ws + WS_WO);
    bf16* HB = (bf16*)(ws + WS_HB); bf16* OB = (bf16*)(ws + WS_O); bf16* PJ = (bf16*)(ws + WS_PJ);
    bf16* GL = PJ;
    const int lo = args.ph_lo, hi = args.ph_hi;
#define IN(k) (lo <= (k) && (k) < hi)
#define SEAM(k) do { if (IN(k) && IN((k) + 1)) { cg::this_grid().sync(); } } while (0)

    for (int layer = 0; layer < DEPTH; ++layer) {
        const int pb = 6 * layer;
        const float* xsrc = layer == 0 ? x_in : out;
#ifndef SKIP_P0
        if (IN(pb + 0)) {
            FRESH_TID();
            const float* w_in = (const float*)args.in[3] + (size_t)layer * DM * NIN;
            const float* w_br = (const float*)args.in[13] + (size_t)layer * 3 * 512 * DM;
            const float* w_out = (const float*)args.in[14] + (size_t)layer * DM * DM;
            const float* ng = (const float*)args.in[2] + layer * DM;
            LAS float* scr = (LAS float*)(L + wid * 16384);
            constexpr int I_IN = (DM / 64) * (NIN / 32), I_B = (512 / 64) * (DM / 32), I_O = (DM / 64) * (DM / 32);
            constexpr int NITEMS = I_IN + 3 * I_B + I_O;
            for (int it = gw; it < NITEMS; it += NGW) {
                int r = it;
                if (r < I_IN) { p0_transpose_item(w_in, DM, NIN, WinT, 0, scr, r, lane); continue; } r -= I_IN;
                if (r < 3 * I_B) { const int br = r / I_B; p0_transpose_item(w_br + (size_t)br * 512 * DM, 512, DM, WbT + (size_t)br * DM * 512, 0, scr, r % I_B, lane); continue; } r -= 3 * I_B;
                p0_transpose_item(w_out, DM, DM, WoT, 0, scr, r, lane);
            }
            for (int m = gw; m < SEQ; m += NGW) rms_row_to_bf16(xsrc + (size_t)m * DM, ng, HB + (size_t)m * DM, lane);
            if (layer == 0) {
                for (int idx = (vcu * NWAVES * 64) + tid; idx < SEQ * 8; idx += G * NWAVES * 64) {
                    const int tok = idx >> 3, i = idx & 7;
                    const float ang = (float)pos[tok] * args.inv[i];
                    const double rev = (double)ang * 0.15915494309189535; const double fr_ = rev - __builtin_rint(rev);
                    ropec[idx] = __builtin_amdgcn_cosf((float)fr_); ropes[idx] = __builtin_amdgcn_sinf((float)fr_);
                }
            }
        }
#endif
        SEAM(pb + 0);
#ifndef SKIP_P1
        if (IN(pb + 1)) {
            pg8::Gemm g{HB, WinT, SEQ, NMAIN, DM}; pg8::StaticOrder S; S.init(SEQ, NMAIN, G, bx);
            EpiProj E{PJ, ropec, ropes};
            pg8::gemm_phase<EpiProj, pg8::StaticOrder, true, true>(L, g, S, E);
        }
#endif
        SEAM(pb + 1);
        if (IN(pb + 2)) {
#ifndef SKIP_ATT
            {
                const int vh = vcu >> 4, s = vcu & 15;
                const attn_body::bf16* Qh = (const attn_body::bf16*)(PJ + SL_AQ * SLOT_ELEMS) + (vh >> 1) * 64;
                const attn_body::bf16* Kh = (const attn_body::bf16*)(PJ + SL_AK * SLOT_ELEMS) + (vh >> 1) * 64;
                const attn_body::bf16* Vh = (const attn_body::bf16*)(PJ + SL_AV * SLOT_ELEMS) + (vh >> 2) * 128 + (vh & 1) * 64;
                attn_body::bf16* Oh = (attn_body::bf16*)OB + vh * 64;
                if (G == 256) {
                    for (int i = 0; i < 4; ++i) { const int qb = (i == 0) ? s : (i == 1) ? 31 - s : (i == 2) ? 32 + s : 63 - s; attn_body::attn_unit<8>(qb, Qh, Kh, Vh, Oh, (char*)lds); }
                }
            }
#endif
#ifndef SKIP_SGU
            {
                FRESH_TID();
                const float* lng = (const float*)args.in[9] + layer * 512; const float* lnb = (const float*)args.in[10] + layer * 512;
                const float* sw = (const float*)args.in[11] + (size_t)layer * 4 * 128 * 128; const float* sb = (const float*)args.in[12] + layer * 4 * 128;
                for (int it = vcu; it < 512; it += G) sgu_item(it, PJ + SL_BU * SLOT_ELEMS, PJ + SL_BV * SLOT_ELEMS, PJ + SL_BZ * SLOT_ELEMS, lng, lnb, sw, sb, L, tid, wid, lane);
            }
#endif
#ifndef SKIP_CMIX
            {
                FRESH_TID();
                for (int it = vcu; it < 1024; it += G) cmix_item(it >> 3, it & 7, PJ + SL_CQ * SLOT_ELEMS, PJ + SL_CK * SLOT_ELEMS, PJ + SL_CV * SLOT_ELEMS, PJ + SL_CZ * SLOT_ELEMS, L + wid * 8192, wid, lane);
                __syncthreads();
            }
#endif
        }
        SEAM(pb + 2);
#ifndef SKIP_P3
        if (IN(pb + 3)) {
            { FRESH_TID();
            const float lam_init = 0.8f - 0.6f * __expf(-0.3f * (float)layer);
            const float* lq1 = (const float*)args.in[4] + layer * 64; const float* lk1 = (const float*)args.in[5] + layer * 64;
            const float* lq2 = (const float*)args.in[6] + layer * 64; const float* lk2 = (const float*)args.in[7] + layer * 64;
            const float lam = __expf(wave_sum(lq1[lane] * lk1[lane])) - __expf(wave_sum(lq2[lane] * lk2[lane])) + lam_init;
            const float* sg = (const float*)args.in[8] + layer * 128;
            const int e0 = (lane & 15) * 8, hh = lane >> 4;
            const f32x4 g0 = *(const f32x4*)(sg + e0), g1 = *(const f32x4*)(sg + e0 + 4);
            bf16* AZ = PJ + SL_AZ * SLOT_ELEMS;
            for (int m = gw; m < SEQ; m += NGW) {
                const v4u a = *(const v4u*)(OB + (size_t)m * DM + hh * 256 + e0), b = *(const v4u*)(OB + (size_t)m * DM + hh * 256 + 128 + e0);
                const v4u z = *(const v4u*)(AZ + (size_t)m * 512 + hh * 128 + e0);
                float d[8] = {bflo(a.x) - lam * bflo(b.x), bfhi(a.x) - lam * bfhi(b.x), bflo(a.y) - lam * bflo(b.y), bfhi(a.y) - lam * bfhi(b.y),
                              bflo(a.z) - lam * bflo(b.z), bfhi(a.z) - lam * bfhi(b.z), bflo(a.w) - lam * bflo(b.w), bfhi(a.w) - lam * bfhi(b.w)};
                float ss = 0.f;
#pragma unroll
                for (int e = 0; e < 8; ++e) ss += d[e] * d[e];
                ss += __shfl_xor(ss, 1); ss += __shfl_xor(ss, 2); ss += __shfl_xor(ss, 4); ss += __shfl_xor(ss, 8);
                const float rr = (1.f / sqrtf(ss * (1.f / 128.f) + EPS)) * (1.f - lam_init);
                v4u w; w.x = pk2(d[0] * rr * g0[0] * bflo(z.x), d[1] * rr * g0[1] * bfhi(z.x)); w.y = pk2(d[2] * rr * g0[2] * bflo(z.y), d[3] * rr * g0[3] * bfhi(z.y));
                w.z = pk2(d[4] * rr * g1[0] * bflo(z.z), d[5] * rr * g1[1] * bfhi(z.z)); w.w = pk2(d[6] * rr * g1[2] * bflo(z.w), d[7] * rr * g1[3] * bfhi(z.w));
                *(v4u*)(AZ + (size_t)m * 512 + hh * 128 + e0) = w;
            } }
            asm volatile("s_waitcnt vmcnt(0) lgkmcnt(0)" ::: "memory"); __syncthreads();
            pg8::Gemm g{HB, WinT + (size_t)NMAIN * DM, SEQ, NGATE, DM}; pg8::StaticOrder S; S.init(SEQ, NGATE, G, bx);
            EpiGate E{GL};
            pg8::gemm_phase<EpiGate, pg8::StaticOrder, true, true>(L, g, S, E);
        }
#endif
        SEAM(pb + 3);
#ifndef SKIP_P4
        if (IN(pb + 4)) {
            pg8::StaticOrder S; S.init(SEQ, DM, G, bx);
#pragma unroll 1
            for (int br = 0; br < 3; ++br) {
                pg8::Gemm g{PJ + (size_t)(SL_AZ + br) * SLOT_ELEMS, WbT + (size_t)br * DM * 512, SEQ, DM, 512}; EpiMerge E{GL, OB, br};
                pg8::gemm_phase<EpiMerge, pg8::StaticOrder, false, true>(L, g, S, E);
            }
        }
#endif
        SEAM(pb + 4);
#ifndef SKIP_P5
        if (IN(pb + 5)) {
            pg8::Gemm g{OB, WoT, SEQ, DM, DM}; pg8::StaticOrder S; S.init(SEQ, DM, G, bx);
            EpiOut E{xsrc, out};
            pg8::gemm_phase<EpiOut, pg8::StaticOrder, false, true>(L, g, S, E);
        }
#endif
        SEAM(pb + 5);
    }
    if (IN(6 * DEPTH)) {
        FRESH_TID();
        const float* fg = (const float*)args.in[15];
        for (int m = gw; m < SEQ; m += NGW) rms_row_to_f32(out + (size_t)m * DM, fg, out + (size_t)m * DM, lane);
    }
#undef IN
#undef SEAM
}

extern "C" void kernel_launch(void* const* d_in, const int* in_sizes, int n_in, void* d_out, int out_size, void* d_ws, size_t ws_size, hipStream_t stream) {
    static int grid = 0;
    if (grid == 0) {
        if (n_in != 16 || out_size != SEQ * DM || ws_size < WS_END) { fprintf(stderr, "kernel_launch: unexpected shapes (n_in %d out %d ws %zu need %zu)\n", n_in, out_size, ws_size, (size_t)WS_END); grid = -1; return; }
        int dev = 0, cus = 0, per_cu = 0;
        hipGetDevice(&dev); hipDeviceGetAttribute(&cus, hipDeviceAttributeMultiprocessorCount, dev);
        if (hipFuncSetAttribute((const void*)trunk_fwd, hipFuncAttributeMaxDynamicSharedMemorySize, LDS_BYTES) != hipSuccess) { fprintf(stderr, "kernel_launch: hipFuncSetAttribute failed\n"); grid = -1; return; }
        hipOccupancyMaxActiveBlocksPerMultiprocessor(&per_cu, (const void*)trunk_fwd, NWAVES * 64, LDS_BYTES);
        (void)hipGetLastError();
        if (per_cu < 1) per_cu = 1;
        grid = cus * (per_cu > 1 ? 1 : per_cu);
        fprintf(stderr, "kernel_launch: grid %d (cus %d per_cu %d)\n", grid, cus, per_cu);
    }
    if (grid < 0) return;
    Args a{};
    for (int i = 0; i < 16; ++i) a.in[i] = d_in[i];
    a.out = (float*)d_out; a.ws = (unsigned char*)d_ws;
    for (int i = 0; i < 8; ++i) a.inv[i] = powf(500000.0f, -(float)i * 2.0f / 16.0f);
#if MK_ONE_LAUNCH
    a.ph_lo = 0; a.ph_hi = N_PHASES;
    void* kargs[] = {&a};
    hipError_t e = hipLaunchCooperativeKernel((const void*)trunk_fwd, dim3(grid), dim3(NWAVES * 64), kargs, LDS_BYTES, stream);
    if (e != hipSuccess) fprintf(stderr, "cooperative launch failed: %s (grid %d)\n", hipGetErrorString(e), grid);
#else
    for (int p = 0; p < N_PHASES; ++p) { a.ph_lo = p; a.ph_hi = p + 1; hipLaunchKernelGGL(trunk_fwd, dim3(grid), dim3(NWAVES * 64), LDS_BYTES, stream, a);
    }
#endif
}
```

```cpp
#include <hip/hip_runtime.h>
#include <hip/hip_cooperative_groups.h>
#include <cstdio>
#include <cstdint>
#include <cmath>
__device__ __forceinline__ int mk_lane() { return (int)__builtin_amdgcn_mbcnt_hi(~0u, __builtin_amdgcn_mbcnt_lo(~0u, 0u)); }
__device__ __forceinline__ int mk_tid(int wave) { int l; asm volatile("v_mbcnt_lo_u32_b32 %0, -1, 0\n\tv_mbcnt_hi_u32_b32 %0, -1, %0" : "=&v"(l)); return wave * 64 + l; }
#define MK_ONE_LAUNCH 1
namespace pg8 {
#define PG8_LAS __attribute__((address_space(3)))
typedef unsigned short bf16_t;
typedef short bf16x8 __attribute__((ext_vector_type(8)));
typedef float f32x4 __attribute__((ext_vector_type(4)));
typedef unsigned u32x4 __attribute__((ext_vector_type(4)));
constexpr int BM = 256, BK = 64, HALF = 128, HTB = HALF * BK * 2  , STAGE_BYTES = 8 * HTB, NXCD = 8, WGM = 8;

__host__ __device__ __forceinline__ int lds_byte(int r, int c) { const int st = (r >> 4) * 2 + (c >> 5), rr = r & 15, cc = c & 31, ob = rr * 64 + cc * 2; return st * 1024 + (ob ^ (((ob >> 9) & 1) << 5)); }
__host__ __device__ __forceinline__ void stage_rc(int b, int& R, int& C) { const int st = b / 1024, sb = b % 1024, swz = sb ^ (((sb >> 9) & 1) << 5); R = (st >> 1) * 16 + swz / 64; C = (st & 1) * 32 + (swz % 64) / 2; }
__host__ __device__ __forceinline__ int perm32(int rho) { const int n = rho >> 4, i = rho & 15; return 8 * (i >> 2) + 4 * n + (i & 3); }

struct Unit { int pm, pn; };
struct Gemm { const bf16_t* A; const bf16_t* Bt; int M, N, K; };

struct StaticOrder {
    int nM, nN, nwg, G, c;
    __host__ __device__ void init(int M, int N, int G_, int c_) { nM = M / BM; nN = N / BM; nwg = nM * nN; G = G_; c = c_; }
    __host__ __device__ bool next(int i, Unit& u) const {
        const long L = (long)i * G + c; if (L >= nwg) return false;
        int wgid = (int)L; { const int q = nwg / NXCD, r = nwg % NXCD, xcd = wgid % NXCD, off = wgid / NXCD; wgid = (xcd < r ? xcd * (q + 1) : r * (q + 1) + (xcd - r) * q) + off; }
        const int nig = WGM * nN, gid = wgid / nig, fm = gid * WGM, gsz = (nM - fm) < WGM ? (nM - fm) : WGM;
        u.pm = fm + ((wgid % nig) % gsz); u.pn = (wgid % nig) / gsz; return true;
    }
    __device__ __forceinline__ void a_ready(const Unit&) const {}
    __device__ __forceinline__ void done(const Unit&) const {}
};

__device__ __forceinline__ unsigned cvt_pk_bf16(float lo, float hi) { unsigned r; asm volatile("v_cvt_pk_bf16_f32 %0, %1, %2" : "=v"(r) : "v"(lo), "v"(hi)); return r; }
typedef float f32x2 __attribute__((ext_vector_type(2)));
struct NoHook { static constexpr int PERIOD = 0; __device__ __forceinline__ void operator()(f32x4 (&)[2][2][4][2], const Unit&, int, int, int, int, int) const {} };
template <class Epi, class Sched, bool ALIGN_EPI = false, bool SP2 = false, class Hook = NoHook>
__device__ __forceinline__ void gemm_phase(PG8_LAS unsigned char* lds, const Gemm g, const Sched& S, const Epi& E, const Hook& H, int wave_id) {
    int tid_ = mk_tid(wave_id);
    const int tid = tid_, wid = __builtin_amdgcn_readfirstlane(tid >> 6), lane = tid & 63, wr = wid >> 2, wc = wid & 3, fr = lane & 15, fq = lane >> 4;
    const int K = g.K, nt = K / BK;
    unsigned voffA[2], voffB[2];
#pragma unroll
    for (int i = 0; i < 2; ++i) { int R, C; stage_rc(tid * 16 + i * 8192, R, C); const int Rb = Epi::PERM ? ((R & ~31) + perm32(R & 31)) : R;
        voffA[i] = (unsigned)(R * K + C) * 2u; voffB[i] = (unsigned)(Rb * K + C) * 2u; }
    const size_t kstep = (size_t)(BK * 2);
    const size_t hstep = (size_t)HALF * K * 2;
    const size_t tstep = 2 * hstep;
    const unsigned ldsw = (unsigned)wid * 1024u;
    const int aoff = lds_byte(wr * 64 + fr, fq * 8), boff = lds_byte(wc * 32 + fr, fq * 8);
#define PG8_SA(b, h) (((b) * 2 + (h)) * HTB)
#define PG8_SB(b, h) ((4 + (b) * 2 + (h)) * HTB)
#define PG8_STAGE(bufoff, gbase, voff) do { _Pragma("unroll") for (int _i = 0; _i < 2; ++_i) \
        __builtin_amdgcn_global_load_lds((const unsigned*)((const char*)(gbase) + (voff)[_i]), (PG8_LAS unsigned*)(lds + (bufoff) + ldsw + _i * 8192), 16, 0, 0); } while (0)
#define PG8_LDA(dst, b, h) do { _Pragma("unroll") for (int m = 0; m < 4; ++m) _Pragma("unroll") for (int k = 0; k < 2; ++k) dst[m][k] = *(const PG8_LAS bf16x8*)(lds + PG8_SA(b, h) + aoff + m * 2048 + k * 1024); } while (0)
#define PG8_LDB(dst, b, h) do { _Pragma("unroll") for (int n = 0; n < 2; ++n) _Pragma("unroll") for (int k = 0; k < 2; ++k) dst[n][k] = *(const PG8_LAS bf16x8*)(lds + PG8_SB(b, h) + boff + n * 2048 + k * 1024); } while (0)
#define PG8_MMA(ai, bj, At, Bt) do { __builtin_amdgcn_s_setprio(1); _Pragma("unroll") for (int m = 0; m < 4; ++m) _Pragma("unroll") for (int n = 0; n < 2; ++n) _Pragma("unroll") for (int k = 0; k < 2; ++k) \
        acc[ai][bj][m][n] = __builtin_amdgcn_mfma_f32_16x16x32_bf16(Bt[n][k], At[m][k], acc[ai][bj][m][n], 0, 0, 0); __builtin_amdgcn_s_setprio(0); } while (0)
#define PG8_WAIT_V(n) asm volatile("s_waitcnt vmcnt(" #n ")" ::: "memory")
#define PG8_WAIT_L(n) asm volatile("s_waitcnt lgkmcnt(" #n ")" ::: "memory")
#define PG8_BAR __builtin_amdgcn_s_barrier()
#define PG8_SCHED __builtin_amdgcn_sched_barrier(0)
    Unit cur, nxt; int ui = 0;
    if (!S.next(0, cur)) return;
    f32x4 acc[2][2][4][2];
#pragma unroll
    for (int a = 0; a < 2; ++a)
#pragma unroll
        for (int b = 0; b < 2; ++b)
#pragma unroll
            for (int m = 0; m < 4; ++m)
#pragma unroll
                for (int n = 0; n < 2; ++n) acc[a][b][m][n] = (f32x4){0.f, 0.f, 0.f, 0.f};
    bf16x8 At[4][2], B0[2][2], B1[2][2];
    const char* cA = (const char*)g.A + (size_t)cur.pm * tstep; const char* cB = (const char*)g.Bt + (size_t)cur.pn * tstep;
    S.a_ready(cur);
    if constexpr (SP2) {
        PG8_STAGE(PG8_SB(0, 0), cB, voffB); PG8_STAGE(PG8_SB(0, 1), cB + hstep, voffB); PG8_STAGE(PG8_SA(0, 0), cA, voffA); PG8_STAGE(PG8_SA(0, 1), cA + hstep, voffA);
        if (wr == 1) PG8_BAR;
        PG8_WAIT_V(2); PG8_BAR;
        PG8_STAGE(PG8_SB(1, 0), cB + kstep, voffB); PG8_STAGE(PG8_SA(1, 0), cA + kstep, voffA); PG8_STAGE(PG8_SB(1, 1), cB + hstep + kstep, voffB);
        PG8_WAIT_V(6); PG8_BAR;
    } else {
        PG8_STAGE(PG8_SB(0, 0), cB, voffB); PG8_STAGE(PG8_SA(0, 0), cA, voffA); PG8_STAGE(PG8_SB(0, 1), cB + hstep, voffB); PG8_STAGE(PG8_SA(0, 1), cA + hstep, voffA);
        if (wr == 1) PG8_BAR;
        PG8_WAIT_V(4); PG8_BAR;
        PG8_STAGE(PG8_SB(1, 0), cB + kstep, voffB); PG8_STAGE(PG8_SA(1, 0), cA + kstep, voffA); PG8_STAGE(PG8_SB(1, 1), cB + hstep + kstep, voffB);
        PG8_WAIT_V(6); PG8_BAR;
    }
    for (;;) {
        const bool has_next = S.next(ui + 1, nxt);
        const char* nA = has_next ? (const char*)g.A + (size_t)nxt.pm * tstep : cA; const char* nB = has_next ? (const char*)g.Bt + (size_t)nxt.pn * tstep : cB;
        for (int t = 0; t < nt; t += 2) {
            if constexpr (Hook::PERIOD > 0) { if (t > 0 && (t % Hook::PERIOD) == 0) { H(acc, cur, t / Hook::PERIOD, wr, wc, fr, fq); PG8_SCHED; } }
            const bool last = (t == nt - 2);
            const char* a1 = cA + (size_t)(t + 1) * kstep;
            const char* a2 = last ? nA : cA + (size_t)(t + 2) * kstep; const char* b2 = last ? nB : cB + (size_t)(t + 2) * kstep;
            const char* a3 = a2 + kstep; const char* b3 = b2 + kstep;
            if (last && has_next) S.a_ready(nxt);
            if constexpr (SP2) {
            PG8_LDB(B0, 0, 0); PG8_LDB(B1, 0, 1); PG8_SCHED; PG8_LDA(At, 0, 0); PG8_STAGE(PG8_SA(1, 1), a1 + hstep, voffA);
            PG8_WAIT_V(8); PG8_WAIT_L(0); PG8_BAR; PG8_MMA(0, 0, At, B0); PG8_MMA(0, 1, At, B1); PG8_BAR; PG8_SCHED;
            PG8_LDA(At, 0, 1); PG8_STAGE(PG8_SB(0, 0), b2, voffB); PG8_STAGE(PG8_SB(0, 1), b2 + hstep, voffB); PG8_STAGE(PG8_SA(0, 0), a2, voffA);
            PG8_WAIT_V(8); PG8_WAIT_L(0); PG8_BAR; PG8_MMA(1, 0, At, B0); PG8_MMA(1, 1, At, B1); PG8_BAR; PG8_SCHED;
            PG8_LDB(B0, 1, 0); PG8_LDB(B1, 1, 1); PG8_SCHED; PG8_LDA(At, 1, 0); PG8_STAGE(PG8_SA(0, 1), a2 + hstep, voffA);
            PG8_WAIT_V(8); PG8_WAIT_L(0); PG8_BAR; PG8_MMA(0, 0, At, B0); PG8_MMA(0, 1, At, B1); PG8_BAR; PG8_SCHED;
            PG8_LDA(At, 1, 1); PG8_STAGE(PG8_SB(1, 0), b3, voffB); PG8_STAGE(PG8_SB(1, 1), b3 + hstep, voffB); PG8_STAGE(PG8_SA(1, 0), a3, voffA);
            PG8_WAIT_V(8); PG8_WAIT_L(0); PG8_BAR; PG8_MMA(1, 0, At, B0); PG8_MMA(1, 1, At, B1); PG8_BAR; PG8_SCHED;
            } else {
            PG8_LDB(B0, 0, 0); PG8_SCHED; PG8_LDA(At, 0, 0); PG8_STAGE(PG8_SA(1, 1), a1 + hstep, voffA);
            PG8_WAIT_L(8); PG8_BAR; PG8_WAIT_L(0); PG8_MMA(0, 0, At, B0); PG8_BAR; PG8_SCHED;
            PG8_LDB(B1, 0, 1); PG8_STAGE(PG8_SB(0, 0), b2, voffB);
            PG8_BAR; PG8_WAIT_L(0); PG8_MMA(0, 1, At, B1); PG8_BAR;
            PG8_LDA(At, 0, 1); PG8_STAGE(PG8_SA(0, 0), a2, voffA);
            PG8_BAR; PG8_WAIT_L(0); PG8_MMA(1, 0, At, B0); PG8_BAR; PG8_SCHED;
            PG8_STAGE(PG8_SB(0, 1), b2 + hstep, voffB);
            PG8_WAIT_V(6); PG8_BAR; PG8_MMA(1, 1, At, B1); PG8_BAR;
            PG8_LDB(B0, 1, 0); PG8_SCHED; PG8_LDA(At, 1, 0); PG8_STAGE(PG8_SA(0, 1), a2 + hstep, voffA);
            PG8_WAIT_L(8); PG8_BAR; PG8_WAIT_L(0); PG8_MMA(0, 0, At, B0); PG8_BAR; PG8_SCHED;
            PG8_LDB(B1, 1, 1); PG8_STAGE(PG8_SB(1, 0), b3, voffB);
            PG8_BAR; PG8_WAIT_L(0); PG8_MMA(0, 1, At, B1); PG8_BAR;
            PG8_LDA(At, 1, 1); PG8_STAGE(PG8_SA(1, 0), a3, voffA);
            PG8_BAR; PG8_WAIT_L(0); PG8_MMA(1, 0, At, B0); PG8_BAR; PG8_SCHED;
            PG8_STAGE(PG8_SB(1, 1), b3 + hstep, voffB);
            PG8_WAIT_V(6); PG8_BAR; PG8_MMA(1, 1, At, B1); PG8_BAR;
            }
        }
        if constexpr (ALIGN_EPI) { if (wr == 0) PG8_BAR; }
        if constexpr (!Epi::AFTER_DRAIN) { E(acc, cur, wr, wc, fr, fq); S.done(cur); }
        if (!has_next) break;
#pragma unroll
        for (int a = 0; a < 2; ++a)
#pragma unroll
            for (int b = 0; b < 2; ++b)
#pragma unroll
                for (int m = 0; m < 4; ++m)
#pragma unroll
                    for (int n = 0; n < 2; ++n) acc[a][b][m][n] = (f32x4){0.f, 0.f, 0.f, 0.f};
        cur = nxt; cA = nA; cB = nB; ++ui;
        if constexpr (ALIGN_EPI) { if (wr == 1) PG8_BAR; }
    }
    PG8_WAIT_V(0);
    if constexpr (!ALIGN_EPI) { if (wr == 0) PG8_BAR; }
    PG8_BAR;
    if constexpr (Epi::AFTER_DRAIN) { E.fused(acc, cur, wr, wc, fr, fq, lds, wid, lane); S.done(cur); }
#undef PG8_SA
#undef PG8_SB
#undef PG8_STAGE
#undef PG8_LDA
#undef PG8_LDB
#undef PG8_MMA
#undef PG8_WAIT_V
#undef PG8_WAIT_L
#undef PG8_BAR
#undef PG8_SCHED
}
}
#include <hip/hip_bf16.h>
namespace attn_body {
using bf16=__hip_bfloat16;
using bf16x8=__attribute__((ext_vector_type(8)))short;
using s16x4=__attribute__((ext_vector_type(4)))short;
using f32x16=__attribute__((ext_vector_type(16)))float;
using u32x4=__attribute__((ext_vector_type(4)))unsigned;
constexpr int SEQ=16384,D=64,PQ=512,PK=512,PV=512,PO=1024;
constexpr int NW=8,QBLK=32,QB=QBLK*NW,KVBLK=64,NQB=SEQ/QB;
constexpr int ATTN_UNIT_ROWS=QB;
__device__ __forceinline__ int crow(int r,int hi){return (r&3)+8*(r>>2)+4*hi;}
#define SBAR() __builtin_amdgcn_sched_barrier(0)
__device__ __forceinline__ void cmask(f32x16&p0,f32x16&p1,int jb,int qrel,int hi){
  const float NEG=-INFINITY; int kb=64*jb+4*hi;
  #pragma unroll
  for(int r=0;r<16;++r){int kv=kb+(r&3)+8*(r>>2); if(kv>qrel)p0[r]=NEG; if(kv+32>qrel)p1[r]=NEG;}
}

constexpr int NSLOT=3, SLOTB=8192;
constexpr int VSLOTB=2*SLOTB;
constexpr int LDS_K=0, LDS_V=NSLOT*SLOTB, LDS_WS=LDS_V+NSLOT*VSLOTB, LDS_OST=LDS_WS+NW*64*4, LDS_BYTES=LDS_OST+NW*8192;
constexpr float C2=0.125f*1.4426950408889634f;
__device__ __forceinline__ void glds16(const void*gsrc,unsigned lds_dst){unsigned keep;
  asm volatile("s_mov_b32 %0, m0\n\ts_mov_b32 m0, %2\n\ts_nop 0\n\tglobal_load_lds_dwordx4 %1, off\n\ts_mov_b32 m0, %0":"=&s"(keep):"v"(gsrc),"s"(lds_dst):"memory");}
__device__ __forceinline__ float max3f(float a,float b,float c){float r;asm("v_max3_f32 %0, %1, %2, %3":"=v"(r):"v"(a),"v"(b),"v"(c));return r;}
__device__ __forceinline__ float max2f(float a,float b){float r;asm("v_max_f32_e32 %0, %1, %2":"=v"(r):"v"(a),"v"(b));return r;}
__device__ __forceinline__ float fadd_s(float a,float b){float r;asm("v_add_f32_e32 %0, %1, %2":"=v"(r):"v"(a),"v"(b));return r;}
__device__ __forceinline__ float fsub_s(float a,float b){float r;asm("v_sub_f32_e32 %0, %1, %2":"=v"(r):"v"(a),"v"(b));return r;}
typedef float f32x2_t __attribute__((ext_vector_type(2))); typedef __bf16 bf16x2_t __attribute__((ext_vector_type(2)));
__device__ __forceinline__ unsigned cvtpk_s(float lo,float hi){f32x2_t v={lo,hi};bf16x2_t b=__builtin_convertvector(v,bf16x2_t);return __builtin_bit_cast(unsigned,b);}
#define WAIT_BAR(N) asm volatile("s_waitcnt vmcnt(" #N ") lgkmcnt(0)\n\ts_barrier":::"memory")

__device__ __forceinline__ void qkt(f32x16&p0,f32x16&p1,const char*Kslot,const bf16x8*qr,const f32x16&negm,int r32,int hi){
  const char*kb=Kslot+hi*1024+r32*16;
  #pragma unroll
  for(int d0=0;d0<4;++d0){
    const bf16x8 b0=*reinterpret_cast<const bf16x8*>(kb+d0*2048);
    const bf16x8 b1=*reinterpret_cast<const bf16x8*>(kb+d0*2048+512);
    if(d0==0){p0=__builtin_amdgcn_mfma_f32_32x32x16_bf16(b0,qr[0],negm,0,0,0);p1=__builtin_amdgcn_mfma_f32_32x32x16_bf16(b1,qr[0],negm,0,0,0);}
    else{p0=__builtin_amdgcn_mfma_f32_32x32x16_bf16(b0,qr[d0],p0,0,0,0);p1=__builtin_amdgcn_mfma_f32_32x32x16_bf16(b1,qr[d0],p1,0,0,0);}}
}
typedef __attribute__((address_space(3))) const char* lds_cptr;
typedef short v4i16_t __attribute__((ext_vector_type(4)));
__device__ __forceinline__ void kload8(bf16x8*kf,lds_cptr kp){
  kf[0]=*(const __attribute__((address_space(3))) bf16x8*)(kp);      kf[1]=*(const __attribute__((address_space(3))) bf16x8*)(kp+512);
  kf[2]=*(const __attribute__((address_space(3))) bf16x8*)(kp+2048); kf[3]=*(const __attribute__((address_space(3))) bf16x8*)(kp+2560);
  kf[4]=*(const __attribute__((address_space(3))) bf16x8*)(kp+4096); kf[5]=*(const __attribute__((address_space(3))) bf16x8*)(kp+4608);
  kf[6]=*(const __attribute__((address_space(3))) bf16x8*)(kp+6144); kf[7]=*(const __attribute__((address_space(3))) bf16x8*)(kp+6656);
}
__device__ __forceinline__ void kload2(bf16x8*kf,lds_cptr kp,int j){ kf[2*j]=*(const __attribute__((address_space(3))) bf16x8*)(kp+j*2048); kf[2*j+1]=*(const __attribute__((address_space(3))) bf16x8*)(kp+j*2048+512); }
__device__ __forceinline__ s16x4 vtr(lds_cptr p){ return __builtin_bit_cast(s16x4,__builtin_amdgcn_ds_read_tr16_b64_v4i16((__attribute__((address_space(3))) v4i16_t*)p)); }
__device__ __forceinline__ float rowmax(const f32x16&p0,const f32x16&p1){
  float a=max3f(p0[0],p0[1],p1[0]),b=max3f(p0[2],p0[3],p1[1]);a=max3f(a,p1[2],p1[3]);
  #pragma unroll
  for(int r=4;r<16;r+=4){a=max3f(a,p0[r],p0[r+1]);b=max3f(b,p0[r+2],p0[r+3]);a=max3f(a,p1[r],p1[r+1]);b=max3f(b,p1[r+2],p1[r+3]);}
  const float m=max2f(a,b);
  auto rr=__builtin_amdgcn_permlane32_swap(__float_as_uint(m),__float_as_uint(m),false,false);
  return max2f(__uint_as_float(rr[0]),__uint_as_float(rr[1]));
}
__device__ __forceinline__ void pv(f32x16*o,int vb,bf16x8 pa0,bf16x8 pa1,bf16x8 pa2,bf16x8 pa3){
  #pragma unroll
  for(int d0=0;d0<4;++d0){s16x4 lo[4],hi[4];
    #pragma unroll
    for(int ks=0;ks<4;++ks){
      asm volatile("ds_read_b64_tr_b16 %0,%1 offset:%c2":"=&v"(lo[ks]):"v"(vb),"i"((d0>>1)*8192+(d0&1)*4096+ks*1024):"memory");
      asm volatile("ds_read_b64_tr_b16 %0,%1 offset:%c2":"=&v"(hi[ks]):"v"(vb),"i"((d0>>1)*8192+(d0&1)*4096+ks*1024+512):"memory");}
    asm volatile("s_waitcnt lgkmcnt(0)":::"memory");SBAR();
    #define PK(k) (bf16x8){lo[k][0],lo[k][1],lo[k][2],lo[k][3],hi[k][0],hi[k][1],hi[k][2],hi[k][3]}
    o[d0]=__builtin_amdgcn_mfma_f32_32x32x16_bf16(pa0,PK(0),o[d0],0,0,0);
    o[d0]=__builtin_amdgcn_mfma_f32_32x32x16_bf16(pa1,PK(1),o[d0],0,0,0);
    o[d0]=__builtin_amdgcn_mfma_f32_32x32x16_bf16(pa2,PK(2),o[d0],0,0,0);
    o[d0]=__builtin_amdgcn_mfma_f32_32x32x16_bf16(pa3,PK(3),o[d0],0,0,0);
    #undef PK
  }
}

#ifndef ATTN_STORE16
#define ATTN_STORE16(p,v) (*(u32x4*)(p)=(v))
#endif
template<int THRL> __device__ __forceinline__ void attn_unit(int qb,const bf16*Q,const bf16*__restrict__ Kh,const bf16*__restrict__ Vh,bf16*O,char*shm,int wave_id){
  int tid_=mk_tid(wave_id); const int tid=tid_,lane=tid&63,r32=lane&31,hi=lane>>5; const int wid=__builtin_amdgcn_readfirstlane(tid>>6);
  const int q0=qb*QB;
  const bf16*Qw=Q+(long)(q0+wid*QBLK)*PQ;
  const unsigned lds0=(unsigned)(uintptr_t)shm;
  float*wsf=(float*)(shm+LDS_WS)+wid*64;
  const bf16*ksrc=Kh+(long)lane*PK+wid*8;
  const bf16*vsrc=Vh+(long)(16*(wid&3)+(lane>>2))*PV+(wid>>2)*32+(lane&3)*8;
  const unsigned kdst=lds0+LDS_K+wid*1024, vdst=lds0+LDS_V+wid*1024;
  #define DMA_K(t,slot) glds16(ksrc+(long)(t)*KVBLK*PK,(unsigned)__builtin_amdgcn_readfirstlane(kdst+(slot)))
  #define DMA_V(t,slot) do{ glds16(vsrc+(long)(t)*KVBLK*PV,(unsigned)__builtin_amdgcn_readfirstlane(vdst+2*(slot))); glds16(vsrc+(long)(t)*KVBLK*PV+64,(unsigned)__builtin_amdgcn_readfirstlane(vdst+2*(slot)+SLOTB)); }while(0)
  const int vb0=(int)(lds0+LDS_V)+((lane>>4)&1)*32+(lane&3)*8+(4*hi+((lane&15)>>2))*64;
  const char*Kbase=shm+LDS_K; bf16x8 kf[8];
  const lds_cptr shm3=(lds_cptr)shm; const lds_cptr kp0=shm3+LDS_K+hi*1024+r32*16; const lds_cptr vp0=shm3+LDS_V+((lane>>4)&1)*32+(lane&3)*8+(4*hi+((lane&15)>>2))*64;
  const int NT=(q0+QB)/KVBLK;
  DMA_K(0,0);DMA_V(0,0);DMA_K(1,SLOTB);
  bf16x8 qr[4];
  #pragma unroll
  for(int d0=0;d0<4;++d0)qr[d0]=*reinterpret_cast<const bf16x8*>(&Qw[(long)r32*PQ+d0*16+hi*8]);
  float l_reg=0.f;f32x16 o[4];     o[0]=f32x16{};o[1]=f32x16{};o[2]=f32x16{};o[3]=f32x16{};f32x16 negm=f32x16{};asm volatile("":"+v"(negm));
  const int qrel=wid*QBLK+r32;
  #define CMASK(P0,P1,t) do{int jb_=(t)-(NT-4); if(jb_>=0)cmask(P0,P1,jb_,qrel,hi);}while(0)
  bool resc=false;
  #define START(P0,P1) do{ const float rm=rowmax(P0,P1); resc=false; \
    { const float dl=rm; const float nm_=-dl; \
      _Pragma("unroll") for(int r=0;r<16;++r){P0[r]=fsub_s(P0[r],dl);P1[r]=fsub_s(P1[r],dl);} \
      _Pragma("unroll") for(int r=0;r<16;++r)negm[r]=nm_; asm volatile("":"+v"(negm)); } \
    _Pragma("unroll") for(int r=0;r<16;++r)P0[r]=__builtin_amdgcn_exp2f(P0[r]); }while(0)
  #define RESC() do{ if(resc){ asm volatile("s_waitcnt lgkmcnt(0)":::"memory"); \
      _Pragma("unroll") for(int d_=0;d_<4;++d_) _Pragma("unroll") for(int r=0;r<16;++r)o[d_][r]*=wsf[crow(r,hi)]; } }while(0)
  f32x16 pA0,pA1,pB0,pB1;
  int sl_prev=0,sl_cur=0,sl_next=SLOTB;
  #define ROT() do{sl_prev=sl_cur;sl_cur=sl_next;sl_next=(sl_next==(NSLOT-1)*SLOTB)?0:sl_next+SLOTB;}while(0)
  DMA_K(2,2*SLOTB);
  WAIT_BAR(3);
  qkt(pA0,pA1,Kbase,qr,negm,r32,hi);asm volatile("s_nop 15\n\ts_nop 7":"+v"(pA0),"+v"(pA1));CMASK(pA0,pA1,0);
  START(pA0,pA1);
  _Pragma("unroll") for(int r=0;r<16;++r)pA1[r]=__builtin_amdgcn_exp2f(pA1[r]);
  WAIT_BAR(0);
  DMA_K(3,0);DMA_V(1,SLOTB);
  ROT();
  kload8(kf,kp0+sl_cur);
  WAIT_BAR(3);
  s16x4 vlo[8],vhi[8]; u32x4 pw0,pw1,pw2,pw3;
  #define PKW(P,B) cvtpk_s(P[B],P[B+1])
  #define PAF(k) __builtin_bit_cast(bf16x8,pw##k)
  #define VFR(i) (bf16x8){vlo[i][0],vlo[i][1],vlo[i][2],vlo[i][3],vhi[i][0],vhi[i][1],vhi[i][2],vhi[i][3]}
  #define PIN(x) asm volatile("":"+v"(x))
  #define MX3(a,b,c) __builtin_fmaxf(__builtin_fmaxf((a),(b)),(c))
  #define GAPA(MF,A0,A1,A2,A3,W0,W1,PW) do{ MF; sacc+=A0; sacc+=A1; sacc+=A2; sacc+=A3; PIN(sacc); W0; W1; PIN(PW); SBAR(); }while(0)
  #define EX(v) __builtin_amdgcn_exp2f(v)
  #define GAPB(MF,X,B) do{ MF; X[B]=EX(X[B]); X[B+1]=EX(X[B+1]); X[B+2]=EX(X[B+2]); X[B+3]=EX(X[B+3]); PIN(X); SBAR(); }while(0)
  #define VRD(i) do{ vlo[i]=vtr(vp_+(((i)>>2)*4096+((i)&3)*1024)); vhi[i]=vtr(vp_+(((i)>>2)*4096+((i)&3)*1024+512)); }while(0)
  #define VRD2(i) do{ wlo[i]=vtr(vp_+(8192+((i)>>2)*4096+((i)&3)*1024)); whi[i]=vtr(vp_+(8192+((i)>>2)*4096+((i)&3)*1024+512)); }while(0)
  #define WFR(i) (bf16x8){wlo[i][0],wlo[i][1],wlo[i][2],wlo[i][3],whi[i][0],whi[i][1],whi[i][2],whi[i][3]}
  #define KRD(G,j) do{ if(G){ kload2(kf,kp0+sl_next,j); SBAR(); } }while(0)
  #define STEP(C0,C1,P0,P1,t,GK,GV,GL) do{ SBAR(); \
    const lds_cptr vp_=vp0+2*sl_prev; \
    float sacc=(P0[0]+P0[1]); \
    GAPA(C0=__builtin_amdgcn_mfma_f32_32x32x16_bf16(kf[0],qr[0],negm,0,0,0), P0[2],P0[3],P0[4],P0[5],     pw0[0]=PKW(P0,0), pw0[1]=PKW(P0,2), pw0); \
    GAPA(C1=__builtin_amdgcn_mfma_f32_32x32x16_bf16(kf[1],qr[0],negm,0,0,0), P0[6],P0[7],P0[8],P0[9],     pw0[2]=PKW(P0,4), pw0[3]=PKW(P0,6), pw0); \
    GAPA(C0=__builtin_amdgcn_mfma_f32_32x32x16_bf16(kf[2],qr[1],C0,0,0,0),   P0[10],P0[11],P0[12],P0[13], pw1[0]=PKW(P0,8), pw1[1]=PKW(P0,10), pw1); \
    GAPA(C1=__builtin_amdgcn_mfma_f32_32x32x16_bf16(kf[3],qr[1],C1,0,0,0),   P0[14],P0[15],P1[0],P1[1],   pw1[2]=PKW(P0,12),pw1[3]=PKW(P0,14), pw1); \
    GAPA(C0=__builtin_amdgcn_mfma_f32_32x32x16_bf16(kf[4],qr[2],C0,0,0,0),   P1[2],P1[3],P1[4],P1[5],     pw2[0]=PKW(P1,0), pw2[1]=PKW(P1,2), pw2); \
    GAPA(C1=__builtin_amdgcn_mfma_f32_32x32x16_bf16(kf[5],qr[2],C1,0,0,0),   P1[6],P1[7],P1[8],P1[9],     pw2[2]=PKW(P1,4), pw2[3]=PKW(P1,6), pw2); \
    GAPA(C0=__builtin_amdgcn_mfma_f32_32x32x16_bf16(kf[6],qr[3],C0,0,0,0),   P1[10],P1[11],P1[12],P1[13], pw3[0]=PKW(P1,8), pw3[1]=PKW(P1,10), pw3); \
    GAPA(C1=__builtin_amdgcn_mfma_f32_32x32x16_bf16(kf[7],qr[3],C1,0,0,0),   P1[14],P1[15],0.f,0.f,       pw3[2]=PKW(P1,12),pw3[3]=PKW(P1,14), pw3); \
    l_reg+=sacc; \
    if(GK){DMA_K((t)+3,sl_cur);} if(GV){DMA_V((t)+1,sl_next);} \
    SBAR(); VRD(0); VRD(4); VRD(1); VRD(5); SBAR(); \
    CMASK(C0,C1,t); \
    { float a=MX3(C0[0],C0[1],C1[0]),b=MX3(C0[2],C0[3],C1[1]); a=MX3(a,C1[2],C1[3]); \
      _Pragma("unroll") for(int r=4;r<16;r+=4){a=MX3(a,C0[r],C0[r+1]);b=MX3(b,C0[r+2],C0[r+3]);a=MX3(a,C1[r],C1[r+1]);b=MX3(b,C1[r+2],C1[r+3]);} \
      float rm=__builtin_fmaxf(a,b); { auto rr=__builtin_amdgcn_permlane32_swap(__float_as_uint(rm),__float_as_uint(rm),false,false); rm=__builtin_fmaxf(__uint_as_float(rr[0]),__uint_as_float(rr[1])); } \
      resc=false; \
      if(__builtin_expect(__any(rm>(float)THRL),0)){ const float dl=__builtin_fmaxf(rm,0.f); const float nm_=negm[0]-dl; \
        _Pragma("unroll") for(int r=0;r<16;++r){C0[r]-=dl;C1[r]-=dl;} \
        _Pragma("unroll") for(int r=0;r<16;++r)negm[r]=nm_; asm volatile("":"+v"(negm)); \
        const float f=__builtin_amdgcn_exp2f(-dl); l_reg*=f; { int r32_=lane; asm volatile("":"+v"(r32_)); if(r32_<32)wsf[r32_]=f; } resc=true; } } \
    SBAR(); \
    VRD(2); SBAR(); GAPB(o[0]=__builtin_amdgcn_mfma_f32_32x32x16_bf16(PAF(0),VFR(0),o[0],0,0,0), C0,0); \
    VRD(6); SBAR(); GAPB(o[1]=__builtin_amdgcn_mfma_f32_32x32x16_bf16(PAF(0),VFR(4),o[1],0,0,0), C0,4); \
    VRD(3); SBAR(); KRD(GL,0); GAPB(o[0]=__builtin_amdgcn_mfma_f32_32x32x16_bf16(PAF(1),VFR(1),o[0],0,0,0), C0,8); \
    VRD(7); SBAR(); KRD(GL,1); GAPB(o[1]=__builtin_amdgcn_mfma_f32_32x32x16_bf16(PAF(1),VFR(5),o[1],0,0,0), C0,12); \
    KRD(GL,2); GAPB(o[0]=__builtin_amdgcn_mfma_f32_32x32x16_bf16(PAF(2),VFR(2),o[0],0,0,0), C1,0); \
    KRD(GL,3); GAPB(o[1]=__builtin_amdgcn_mfma_f32_32x32x16_bf16(PAF(2),VFR(6),o[1],0,0,0), C1,4); \
    s16x4 wlo[8],whi[8]; \
    GAPB(o[0]=__builtin_amdgcn_mfma_f32_32x32x16_bf16(PAF(3),VFR(3),o[0],0,0,0), C1,8); \
    GAPB(o[1]=__builtin_amdgcn_mfma_f32_32x32x16_bf16(PAF(3),VFR(7),o[1],0,0,0), C1,12); \
    VRD2(0); VRD2(4); VRD2(1); SBAR(); o[2]=__builtin_amdgcn_mfma_f32_32x32x16_bf16(PAF(0),WFR(0),o[2],0,0,0); SBAR(); \
    VRD2(5); SBAR(); o[3]=__builtin_amdgcn_mfma_f32_32x32x16_bf16(PAF(0),WFR(4),o[3],0,0,0); SBAR(); \
    VRD2(2); SBAR(); o[2]=__builtin_amdgcn_mfma_f32_32x32x16_bf16(PAF(1),WFR(1),o[2],0,0,0); SBAR(); \
    VRD2(6); SBAR(); o[3]=__builtin_amdgcn_mfma_f32_32x32x16_bf16(PAF(1),WFR(5),o[3],0,0,0); SBAR(); \
    VRD2(3); SBAR(); o[2]=__builtin_amdgcn_mfma_f32_32x32x16_bf16(PAF(2),WFR(2),o[2],0,0,0); SBAR(); \
    VRD2(7); SBAR(); o[3]=__builtin_amdgcn_mfma_f32_32x32x16_bf16(PAF(2),WFR(6),o[3],0,0,0); SBAR(); \
    o[2]=__builtin_amdgcn_mfma_f32_32x32x16_bf16(PAF(3),WFR(3),o[2],0,0,0); SBAR(); \
    o[3]=__builtin_amdgcn_mfma_f32_32x32x16_bf16(PAF(3),WFR(7),o[3],0,0,0); SBAR(); \
    }while(0)
  int t=1;
  #undef CMASK
  #define CMASK(P0,P1,t) do{}while(0)
  for(;t+5<NT;t+=2){
    STEP(pB0,pB1,pA0,pA1,t,true,true,true);     WAIT_BAR(3); RESC(); ROT();
    STEP(pA0,pA1,pB0,pB1,t+1,true,true,true);   WAIT_BAR(3); RESC(); ROT();
  }
  #undef CMASK
  #define CMASK(P0,P1,t) do{int jb_=(t)-(NT-4); if(jb_>=0)cmask(P0,P1,jb_,qrel,hi);}while(0)
  #define ENDW(tt) do{ if((tt)+3<NT){WAIT_BAR(3);} else if((tt)+2<NT){WAIT_BAR(2);} else {WAIT_BAR(0);} }while(0)
  for(;t+1<NT;t+=2){
    STEP(pB0,pB1,pA0,pA1,t,(t+3<NT),(t+1<NT),(t+1<NT));       ENDW(t);   RESC(); ROT();
    STEP(pA0,pA1,pB0,pB1,t+1,(t+4<NT),(t+2<NT),(t+2<NT));     ENDW(t+1); RESC(); ROT();
  }
  STEP(pB0,pB1,pA0,pA1,NT-1,false,false,false); RESC();
  { float sacc=pB0[0]+pB0[1]; _Pragma("unroll") for(int r=2;r<16;++r)sacc+=pB0[r]; _Pragma("unroll") for(int r=0;r<16;++r)sacc+=pB1[r]; l_reg+=sacc;
    pw0=(u32x4){PKW(pB0,0),PKW(pB0,2),PKW(pB0,4),PKW(pB0,6)};pw1=(u32x4){PKW(pB0,8),PKW(pB0,10),PKW(pB0,12),PKW(pB0,14)};pw2=(u32x4){PKW(pB1,0),PKW(pB1,2),PKW(pB1,4),PKW(pB1,6)};pw3=(u32x4){PKW(pB1,8),PKW(pB1,10),PKW(pB1,12),PKW(pB1,14)};
    SBAR(); pv(o,vb0+2*sl_cur,PAF(0),PAF(1),PAF(2),PAF(3)); }
  #undef PKW
  #undef PAF
  #undef VFR
  #undef PIN
  #undef MX3
  #undef GAPA
  #undef GAPB
  #undef EX
  #undef VRD
  #undef VRD2
  #undef WFR
  #undef KRD
  #undef STEP
  #undef ENDW
  {auto rr=__builtin_amdgcn_permlane32_swap(__float_as_uint(l_reg),__float_as_uint(l_reg),false,false);l_reg=__uint_as_float(rr[0])+__uint_as_float(rr[1]);}
  if(hi==0)wsf[32+r32]=l_reg;asm volatile("s_waitcnt lgkmcnt(0)":::"memory");
  float rli[16];
  #pragma unroll
  for(int r=0;r<16;++r)rli[r]=__builtin_amdgcn_rcpf(wsf[32+crow(r,hi)]);
  bf16*Ow=O+(long)(q0+wid*QBLK)*PO;
  { bf16*stg=(bf16*)(shm+LDS_OST)+wid*4096;
    #pragma unroll
    for(int r=0;r<16;++r){const int orow=crow(r,hi);
      #pragma unroll
      for(int d0=0;d0<4;++d0)stg[orow*128+d0*32+r32]=__float2bfloat16(o[d0][r]*rli[r]);}
    asm volatile("s_waitcnt lgkmcnt(0)":::"memory");
    #pragma unroll
    for(int i=0;i<8;++i){const int row=i*4+(lane>>4),ch=lane&15; const u32x4 v=*(const u32x4*)(stg+row*128+ch*8); ATTN_STORE16(Ow+(long)row*PO+ch*8,v);} }
  asm volatile("s_waitcnt lgkmcnt(0)\n\ts_barrier":::"memory");
  #undef DMA_K
  #undef DMA_V
  #undef CMASK
  #undef START
  #undef RESC
  #undef ROT
}
constexpr int ATTN_LDS_BYTES=LDS_BYTES;
#undef SBAR
#undef WAIT_BAR
}
namespace cg = cooperative_groups;
#define GAS __attribute__((address_space(1)))
#define LAS __attribute__((address_space(3)))
typedef unsigned short bf16;
typedef unsigned v4u __attribute__((ext_vector_type(4)));
typedef unsigned v2u __attribute__((ext_vector_type(2)));
typedef float f32x4 __attribute__((ext_vector_type(4)));
typedef short bf16x8 __attribute__((ext_vector_type(8)));
typedef short s16x4 __attribute__((ext_vector_type(4)));

#ifndef MK_ONE_LAUNCH
#define MK_ONE_LAUNCH 1
#endif
constexpr int NWAVES = 8;
constexpr int SEQ = 16384, DM = 1024, NIN = 8704, NMAIN = 5632, NGATE = 3072, DEPTH = 2;
constexpr float EPS = 1e-6f;
constexpr float QSCALE = 0.125f * 1.4426950408889634f;
constexpr size_t MiB = 1u << 20;
constexpr size_t WS_ROPE = 0;
constexpr size_t WS_WIN = 1 * MiB;
constexpr size_t WS_WB = 18 * MiB;
constexpr size_t WS_WO = 21 * MiB;
constexpr size_t WS_HB = 23 * MiB;
constexpr size_t WS_O = 55 * MiB;
constexpr size_t WS_PJ = 87 * MiB;
constexpr size_t SLOT_ELEMS = (size_t)SEQ * 512;
constexpr int YP = 1536;
constexpr size_t WS_BAR = WS_PJ + 11 * SLOT_ELEMS * 2;
constexpr size_t WS_END = WS_BAR + 65536;
enum { SL_AQ = 0, SL_AK = 1, SL_AV = 2, SL_BU = 3, SL_BV = 4, SL_CQ = 5, SL_CK = 6, SL_CV = 7, SL_AZ = 8, SL_BZ = 9, SL_CZ = 10 };

constexpr int LDS_BYTES = 147456;

__device__ __forceinline__ unsigned f2bf(float f) { unsigned u = __builtin_bit_cast(unsigned, f); return (u + 0x7fffu + ((u >> 16) & 1u)) >> 16; }
typedef float f32x2_t __attribute__((ext_vector_type(2))); typedef __bf16 bf16x2_t __attribute__((ext_vector_type(2)));
__device__ __forceinline__ unsigned pk2(float lo, float hi) { f32x2_t v = {lo, hi}; bf16x2_t b = __builtin_convertvector(v, bf16x2_t); return __builtin_bit_cast(unsigned, b); }
__device__ __forceinline__ float bflo(unsigned w) { return __uint_as_float(w << 16); }
__device__ __forceinline__ float bfhi(unsigned w) { return __uint_as_float(w & 0xffff0000u); }
__device__ __forceinline__ float fexp2(float x) { return __builtin_amdgcn_exp2f(x); }
__device__ __forceinline__ float frcp(float x) { return __builtin_amdgcn_rcpf(x); }
__device__ __forceinline__ float sigmoid_f(float x) { return frcp(1.f + fexp2(-1.4426950408889634f * x)); }
__device__ __forceinline__ float silu_f(float x) { return x * sigmoid_f(x); }
__device__ __forceinline__ float gelu_tanh_f(float x) { const float y = 0.7978845608028654f * (x + 0.044715f * x * x * x); return x * frcp(1.f + fexp2(-2.885390081777927f * y)); }
__device__ __forceinline__ float wave_sum(float v) {
#pragma unroll
    for (int o = 1; o < 64; o <<= 1) v += __shfl_xor(v, o);
    return v;
}

struct EpiProj {
    static constexpr bool PERM = true, AFTER_DRAIN = false;
    bf16* PJ; const float* rc; const float* rs;
    __device__ __forceinline__ void operator()(const f32x4 (&acc)[2][2][4][2], const pg8::Unit& u, int wr, int wc, int fr_, int fq_) const {
        int fr = fr_, fq = fq_; asm volatile("" : "+v"(fr), "+v"(fq));
        const int grp = u.pn >> 1;
        const int slot = (int)((0xA7659438210ull >> (4 * grp)) & 15ull);
        const int act = (int)((0x10341221034ull >> (4 * grp)) & 15ull);
        const bool isy = (act == 1); const int pitch = isy ? YP : 512;
        bf16* base = isy ? PJ + (size_t)SL_AZ * SLOT_ELEMS + (grp == 3 ? 0 : (grp == 6 ? 512 : 1024)) : PJ + (size_t)slot * SLOT_ELEMS;
        const int row0 = u.pm * 256 + wr * 64 + fr, col0 = (u.pn & 1) * 256 + wc * 32 + 8 * fq;
        const bool ropew = (act >= 3) && ((wc & 1) == 0);
        const float sgn = (fq == 0) ? -1.f : 1.f; const bool ropel = fq < 2;
        const float qs = (act == 4) ? QSCALE : 1.f;
#pragma unroll
        for (int ai = 0; ai < 2; ++ai) {
            f32x4 Cc[4][2], Ss[4][2];
            if (ropew) {
#pragma unroll
                for (int m = 0; m < 4; ++m) { const int row = row0 + ai * 128 + m * 16;
                    Cc[m][0] = *(const f32x4*)(rc + row * 8); Cc[m][1] = *(const f32x4*)(rc + row * 8 + 4); Ss[m][0] = *(const f32x4*)(rs + row * 8); Ss[m][1] = *(const f32x4*)(rs + row * 8 + 4); }
                __builtin_amdgcn_sched_barrier(0);
            }
#pragma unroll
            for (int m = 0; m < 4; ++m) {
                const int row = row0 + ai * 128 + m * 16;
#pragma unroll
                for (int bj = 0; bj < 2; ++bj) {
                    f32x4 v0 = acc[ai][bj][m][0], v1 = acc[ai][bj][m][1];
                    if (ropew) {
                        f32x4 o0, o1;
#pragma unroll
                        for (int e = 0; e < 4; ++e) { o0[e] = __shfl_xor(v0[e], 16); o1[e] = __shfl_xor(v1[e], 16); }
                        if (ropel) { v0 = v0 * Cc[m][0] + sgn * (o0 * Ss[m][0]); v1 = v1 * Cc[m][1] + sgn * (o1 * Ss[m][1]); }
                    }
                    if (act == 1) {
#pragma unroll
                        for (int e = 0; e < 4; ++e) { v0[e] = silu_f(v0[e]); v1[e] = silu_f(v1[e]); }
                    } else if (act == 2) {
#pragma unroll
                        for (int e = 0; e < 4; ++e) { v0[e] = gelu_tanh_f(v0[e]); v1[e] = gelu_tanh_f(v1[e]); }
                    }
                    v0 = v0 * qs; v1 = v1 * qs;
                    v4u w; w.x = pk2(v0[0], v0[1]); w.y = pk2(v0[2], v0[3]); w.z = pk2(v1[0], v1[1]); w.w = pk2(v1[2], v1[3]);
                    *(v4u*)(base + (size_t)row * pitch + col0 + bj * 128) = w;
                }
            }
            asm volatile("" ::: "memory");
        }
    }
};
struct EpiGate {
    static constexpr bool PERM = true, AFTER_DRAIN = false;
    bf16* GL;
    __device__ __forceinline__ void operator()(const f32x4 (&acc)[2][2][4][2], const pg8::Unit& u, int wr, int wc, int fr_, int fq_) const {
        int fr = fr_, fq = fq_; asm volatile("" : "+v"(fr), "+v"(fq));
        const int row0 = u.pm * 256 + wr * 64 + fr, col0 = u.pn * 256 + wc * 32 + 8 * fq;
#pragma unroll
        for (int ai = 0; ai < 2; ++ai)
#pragma unroll
            for (int m = 0; m < 4; ++m) {
                const int row = row0 + ai * 128 + m * 16;
#pragma unroll
                for (int bj = 0; bj < 2; ++bj) {
                    f32x4 v0 = acc[ai][bj][m][0], v1 = acc[ai][bj][m][1];
#pragma unroll
                    for (int e = 0; e < 4; ++e) { v0[e] = sigmoid_f(v0[e]); v1[e] = sigmoid_f(v1[e]); }
                    v4u w; w.x = pk2(v0[0], v0[1]); w.y = pk2(v0[2], v0[3]); w.z = pk2(v1[0], v1[1]); w.w = pk2(v1[2], v1[3]);
                    *(v4u*)(GL + (size_t)row * NGATE + col0 + bj * 128) = w; asm volatile("" ::: "memory");
                }
            }
    }
};
__device__ __forceinline__ float gclamp(float g) { return fmaxf(g, 1e-6f); }
struct MergeHook {
    static constexpr int PERIOD = 8;
    const bf16* GL;
    __device__ __forceinline__ void operator()(f32x4 (&acc)[2][2][4][2], const pg8::Unit& u, int seg, int wr, int wc, int fr_, int fq_) const {
        int fr = fr_, fq = fq_; asm volatile("" : "+v"(fr), "+v"(fq));
        const int row0 = u.pm * 256 + wr * 64 + fr, col0 = u.pn * 256 + wc * 32 + 8 * fq;
        const bf16* gn = GL + (seg - 1) * 1024 + col0; const bf16* gd = GL + seg * 1024 + col0; const bool cl = seg > 1;
#pragma unroll
        for (int ai = 0; ai < 2; ++ai) {
            v4u A[4][2], B[4][2];
#pragma unroll
            for (int m = 0; m < 4; ++m)
#pragma unroll
                for (int bj = 0; bj < 2; ++bj) { const size_t ro = (size_t)(row0 + ai * 128 + m * 16) * NGATE + bj * 128; A[m][bj] = *(const v4u*)(gn + ro); B[m][bj] = *(const v4u*)(gd + ro); }
            __builtin_amdgcn_sched_barrier(0);
#pragma unroll
            for (int m = 0; m < 4; ++m)
#pragma unroll
                for (int bj = 0; bj < 2; ++bj) {
                    const v4u a = A[m][bj], b = B[m][bj];
                    float n_[8] = {bflo(a.x), bfhi(a.x), bflo(a.y), bfhi(a.y), bflo(a.z), bfhi(a.z), bflo(a.w), bfhi(a.w)};
                    float d_[8] = {bflo(b.x), bfhi(b.x), bflo(b.y), bfhi(b.y), bflo(b.z), bfhi(b.z), bflo(b.w), bfhi(b.w)};
#pragma unroll
                    for (int e = 0; e < 8; ++e) { const float nn = cl ? gclamp(n_[e]) : n_[e]; const float rr = nn * frcp(gclamp(d_[e])); if (e < 4) acc[ai][bj][m][0][e] *= rr; else acc[ai][bj][m][1][e - 4] *= rr; }
                }
            asm volatile("" ::: "memory");
        }
    }
};
struct EpiMerge {
    static constexpr bool PERM = true, AFTER_DRAIN = false;
    const bf16* GL; bf16* MG;
    __device__ __forceinline__ void operator()(const f32x4 (&acc)[2][2][4][2], const pg8::Unit& u, int wr, int wc, int fr_, int fq_) const {
        int fr = fr_, fq = fq_; asm volatile("" : "+v"(fr), "+v"(fq));
        const int row0 = u.pm * 256 + wr * 64 + fr, col0 = u.pn * 256 + wc * 32 + 8 * fq;
#pragma unroll
        for (int ai = 0; ai < 2; ++ai) {
            v4u Gt[4][2];
#pragma unroll
            for (int m = 0; m < 4; ++m)
#pragma unroll
                for (int bj = 0; bj < 2; ++bj) Gt[m][bj] = *(const v4u*)(GL + (size_t)(row0 + ai * 128 + m * 16) * NGATE + 2 * 1024 + col0 + bj * 128);
            __builtin_amdgcn_sched_barrier(0);
#pragma unroll
            for (int m = 0; m < 4; ++m)
#pragma unroll
                for (int bj = 0; bj < 2; ++bj) {
                    const int row = row0 + ai * 128 + m * 16; const v4u g = Gt[m][bj];
                    f32x4 v0 = acc[ai][bj][m][0], v1 = acc[ai][bj][m][1];
                    v0[0] *= gclamp(bflo(g.x)); v0[1] *= gclamp(bfhi(g.x)); v0[2] *= gclamp(bflo(g.y)); v0[3] *= gclamp(bfhi(g.y));
                    v1[0] *= gclamp(bflo(g.z)); v1[1] *= gclamp(bfhi(g.z)); v1[2] *= gclamp(bflo(g.w)); v1[3] *= gclamp(bfhi(g.w));
                    v4u w; w.x = pk2(v0[0], v0[1]); w.y = pk2(v0[2], v0[3]); w.z = pk2(v1[0], v1[1]); w.w = pk2(v1[2], v1[3]);
                    *(v4u*)(MG + (size_t)row * DM + col0 + bj * 128) = w;
                }
            asm volatile("" ::: "memory");
        }
    }
};
struct EpiOut {
    static constexpr bool PERM = true, AFTER_DRAIN = false;
    const float* res; float* out;
    __device__ __forceinline__ void operator()(const f32x4 (&acc)[2][2][4][2], const pg8::Unit& u, int wr, int wc, int fr_, int fq_) const {
        int fr = fr_, fq = fq_; asm volatile("" : "+v"(fr), "+v"(fq));
        const int row0 = u.pm * 256 + wr * 64 + fr, col0 = u.pn * 256 + wc * 32 + 8 * fq;
#pragma unroll
        for (int ai = 0; ai < 2; ++ai) {
            f32x4 R[4][2][2];
#pragma unroll
            for (int m = 0; m < 4; ++m)
#pragma unroll
                for (int bj = 0; bj < 2; ++bj) { const size_t off = (size_t)(row0 + ai * 128 + m * 16) * DM + col0 + bj * 128; R[m][bj][0] = *(const f32x4*)(res + off); R[m][bj][1] = *(const f32x4*)(res + off + 4); }
            __builtin_amdgcn_sched_barrier(0);
#pragma unroll
            for (int m = 0; m < 4; ++m)
#pragma unroll
                for (int bj = 0; bj < 2; ++bj) { const size_t off = (size_t)(row0 + ai * 128 + m * 16) * DM + col0 + bj * 128;
                    *(f32x4*)(out + off) = R[m][bj][0] + acc[ai][bj][m][0]; *(f32x4*)(out + off + 4) = R[m][bj][1] + acc[ai][bj][m][1]; }
            asm volatile("" ::: "memory");
        }
    }
};

__device__ __forceinline__ void p0_transpose_item(const float* W, int K, int N, bf16* WT, int ldk, LAS float* scr, int item, int lane) {
    const int nblk = N / 32, kb = item / nblk, nb = item % nblk, k0 = 64 * kb, n0 = 32 * nb;
#pragma unroll 8
    for (int i = 0; i < 32; ++i) { const int kk = 2 * i + (lane >> 5); scr[kk * 33 + (lane & 31)] = W[(size_t)(k0 + kk) * N + n0 + (lane & 31)]; }
    asm volatile("s_waitcnt lgkmcnt(0)" ::: "memory");
    const int c = lane & 7;
#pragma unroll
    for (int j = 0; j < 4; ++j) { const int n = (lane >> 3) + 8 * j; const LAS float* s = scr + (8 * c) * 33 + n;
        v4u o; o.x = pk2(s[0 * 33], s[1 * 33]); o.y = pk2(s[2 * 33], s[3 * 33]); o.z = pk2(s[4 * 33], s[5 * 33]); o.w = pk2(s[6 * 33], s[7 * 33]);
        *(v4u*)(WT + (size_t)(n0 + n) * ldk + k0 + 8 * c) = o; }
    asm volatile("s_waitcnt lgkmcnt(0)" ::: "memory");
}
template <int NR, bool OUTBF> __device__ __forceinline__ void rms_rows(const float* x, size_t rstride, const float* g, void* o, int lane) {
    f32x4 v[NR][4]; float r[NR];
#pragma unroll
    for (int k = 0; k < NR; ++k)
#pragma unroll
        for (int j = 0; j < 4; ++j) v[k][j] = ((const f32x4*)(x + k * rstride) + lane)[64 * j];
#pragma unroll
    for (int k = 0; k < NR; ++k) { float s = 0.f;
#pragma unroll
        for (int j = 0; j < 4; ++j) s += (v[k][j].x * v[k][j].x + v[k][j].y * v[k][j].y) + (v[k][j].z * v[k][j].z + v[k][j].w * v[k][j].w);
        r[k] = 1.f / sqrtf(wave_sum(s) * (1.f / DM) + EPS); }
    const f32x4* gr = (const f32x4*)g + lane;
#pragma unroll
    for (int j = 0; j < 4; ++j) { const f32x4 gg = gr[64 * j];
#pragma unroll
        for (int k = 0; k < NR; ++k) { const f32x4 y = v[k][j] * r[k] * gg;
            if (OUTBF) ((unsigned long long*)((bf16*)o + k * rstride) + lane)[64 * j] = (unsigned long long)pk2(y.x, y.y) | ((unsigned long long)pk2(y.z, y.w) << 32);
            else ((f32x4*)((float*)o + k * rstride) + lane)[64 * j] = y; } }
}
constexpr int SGU_P = 136;
__device__ __forceinline__ void sgu_item(int item, const bf16* BU, const bf16* BV, bf16* BZ, const float* lng, const float* lnb, const float* sw, const float* sb,
                                         LAS unsigned char* lds, int tid, int wid, int lane) {
    const int n = item >> 2, g = item & 3, tok0 = n * 128;
    LAS bf16* Wl = (LAS bf16*)lds; LAS bf16* Vt = (LAS bf16*)(lds + 128 * SGU_P * 2); LAS float* st = (LAS float*)(lds + 2 * 128 * SGU_P * 2);
    const int r = lane & 15, q = lane >> 4, t = wid * 16 + r;
    v4u w16[16];
#pragma unroll
    for (int i = 0; i < 16; ++i) w16[i] = *(const v4u*)(BV + (size_t)(tok0 + wid * 16 + i) * 512 + lane * 8);
    v4u vst[4]; f32x4 G0[4], G1[4], B0[4], B1[4];
#pragma unroll
    for (int k = 0; k < 4; ++k) { const int idx = tid + 512 * k, s_ = idx >> 4, cch = idx & 15;
        vst[k] = *(const v4u*)(BV + (size_t)(tok0 + s_) * 512 + g * 128 + cch * 8);
        G0[k] = *(const f32x4*)(lng + g * 128 + cch * 8); G1[k] = *(const f32x4*)(lng + g * 128 + cch * 8 + 4); B0[k] = *(const f32x4*)(lnb + g * 128 + cch * 8); B1[k] = *(const f32x4*)(lnb + g * 128 + cch * 8 + 4); }
    f32x4 wW[8];
#pragma unroll
    for (int k = 0; k < 8; ++k) { const int idx = tid + 512 * k, tt = idx >> 5, s4 = (idx & 31) * 4; wW[k] = *(const f32x4*)(sw + ((size_t)g * 128 + tt) * 128 + s4); }
    v2u uu[8], zz[8];
#pragma unroll
    for (int ct = 0; ct < 8; ++ct) { uu[ct] = *(const v2u*)(BU + (size_t)(tok0 + t) * 512 + g * 128 + ct * 16 + q * 4); zz[ct] = *(const v2u*)(BZ + (size_t)(tok0 + t) * YP + g * 128 + ct * 16 + q * 4); }
    const float bias = sb[g * 128 + t];
    __builtin_amdgcn_sched_barrier(0);
#pragma unroll
    for (int i = 0; i < 16; ++i) {
        const int s_ = wid * 16 + i; const v4u w = w16[i];
        const float a0 = bflo(w.x), a1 = bfhi(w.x), a2 = bflo(w.y), a3 = bfhi(w.y), a4 = bflo(w.z), a5 = bfhi(w.z), a6 = bflo(w.w), a7 = bfhi(w.w);
        const float mu = wave_sum(((a0 + a1) + (a2 + a3)) + ((a4 + a5) + (a6 + a7))) * (1.f / 512.f);
        const float d0 = a0 - mu, d1 = a1 - mu, d2 = a2 - mu, d3 = a3 - mu, d4 = a4 - mu, d5 = a5 - mu, d6 = a6 - mu, d7 = a7 - mu;
        const float var = wave_sum(((d0 * d0 + d1 * d1) + (d2 * d2 + d3 * d3)) + ((d4 * d4 + d5 * d5) + (d6 * d6 + d7 * d7))) * (1.f / 512.f);
        if (lane == 0) { st[s_] = mu; st[128 + s_] = 1.f / sqrtf(var + EPS); }
    }
    __syncthreads();
#pragma unroll
    for (int k = 0; k < 4; ++k) {
        const int idx = tid + 512 * k, s_ = idx >> 4, cch = idx & 15; const v4u w = vst[k];
        const float mu = st[s_], rstd = st[128 + s_];
        float a[8] = {bflo(w.x), bfhi(w.x), bflo(w.y), bfhi(w.y), bflo(w.z), bfhi(w.z), bflo(w.w), bfhi(w.w)};
#pragma unroll
        for (int e = 0; e < 8; ++e) { const float gg = e < 4 ? G0[k][e & 3] : G1[k][e & 3], bb = e < 4 ? B0[k][e & 3] : B1[k][e & 3]; a[e] = (a[e] - mu) * rstd * gg + bb; }
        v4u o; o.x = pk2(a[0], a[1]); o.y = pk2(a[2], a[3]); o.z = pk2(a[4], a[5]); o.w = pk2(a[6], a[7]);
        *(LAS v4u*)(Vt + s_ * SGU_P + cch * 8) = o;
    }
#pragma unroll
    for (int k = 0; k < 8; ++k) {
        const int idx = tid + 512 * k, tt = idx >> 5, s4 = (idx & 31) * 4; const f32x4 w = wW[k];
        v2u o; o.x = pk2(s4 + 0 <= tt ? w.x : 0.f, s4 + 1 <= tt ? w.y : 0.f); o.y = pk2(s4 + 2 <= tt ? w.z : 0.f, s4 + 3 <= tt ? w.w : 0.f);
        *(LAS v2u*)(Wl + tt * SGU_P + s4) = o;
    }
    __syncthreads();
    typedef short v4i16_t __attribute__((ext_vector_type(4)));
    f32x4 acc[8];
#pragma unroll
    for (int ct = 0; ct < 8; ++ct) acc[ct] = (f32x4){0.f, 0.f, 0.f, 0.f};
#pragma unroll
    for (int ks = 0; ks < 4; ++ks) {
        const bf16x8 wf = *(const LAS bf16x8*)(Wl + (wid * 16 + r) * SGU_P + ks * 32 + q * 8);
#pragma unroll
        for (int ct = 0; ct < 8; ++ct) {
            const LAS bf16* tp = Vt + (ks * 32 + q * 8 + ((r >> 2) & 3)) * SGU_P + ct * 16 + (r & 3) * 4;
            const s16x4 lo = __builtin_bit_cast(s16x4, __builtin_amdgcn_ds_read_tr16_b64_v4i16((LAS v4i16_t*)tp));
            const s16x4 hi = __builtin_bit_cast(s16x4, __builtin_amdgcn_ds_read_tr16_b64_v4i16((LAS v4i16_t*)(tp + 4 * SGU_P)));
            const bf16x8 vf = (bf16x8){lo[0], lo[1], lo[2], lo[3], hi[0], hi[1], hi[2], hi[3]};
            acc[ct] = __builtin_amdgcn_mfma_f32_16x16x32_bf16(vf, wf, acc[ct], 0, 0, 0);
        }
    }
#pragma unroll
    for (int ct = 0; ct < 8; ++ct) {
        const size_t offz = (size_t)(tok0 + t) * YP + g * 128 + ct * 16 + q * 4;
        v2u o; o.x = pk2((acc[ct][0] + bias) * bflo(uu[ct].x) * bflo(zz[ct].x), (acc[ct][1] + bias) * bfhi(uu[ct].x) * bfhi(zz[ct].x));
        o.y = pk2((acc[ct][2] + bias) * bflo(uu[ct].y) * bflo(zz[ct].y), (acc[ct][3] + bias) * bfhi(uu[ct].y) * bfhi(zz[ct].y));
        *(v2u*)(BZ + offz) = o;
    }
    __syncthreads();
}

constexpr int CM_PB = 144, CM_NG = 4, CM_BLK = 128 * CM_NG;
constexpr int CM_S0 = (CM_BLK + 128) / 32, CM_S1 = (512 + CM_BLK - 8 + 4 * 32 - 1) / (4 * 32), CM_S2 = (2048 + CM_BLK - 8 + 8 * 32 - 1) / (8 * 32), CM_NSTEP = CM_S0 + CM_S1 + CM_S2;
struct CmStep { int kbase, sl, window, dmask, kk0; };
__device__ __forceinline__ CmStep cm_step(int j, int T0, int wid) {
    CmStep p;
    if (j < CM_S0) { p.kbase = T0 - 128; p.sl = 0; p.window = 128; p.dmask = 0; p.kk0 = 32 * j; }
    else if (j < CM_S0 + CM_S1) { p.kbase = T0 + wid - 512; p.sl = 2; p.window = 512; p.dmask = 0; p.kk0 = 32 * (j - CM_S0); }
    else { p.kbase = T0 + wid - 2048; p.sl = 3; p.window = 2048; p.dmask = 15; p.kk0 = 32 * (j - CM_S0 - CM_S1); }
    return p;
}
__device__ __forceinline__ void cm_load(int j, int T0, int wid, int h, int r, int q, int vkey, int vch, const bf16* CK, const bf16* CV, bf16x8 (&kf)[4], bf16x8 (&vv)[4]) {
    if (j >= CM_NSTEP) return;
    const CmStep p = cm_step(j, T0, wid);
    int tA = p.kbase + ((p.kk0 + r) << p.sl), tB = p.kbase + ((p.kk0 + 16 + r) << p.sl);
    tA = min(max(tA, 0), SEQ - 1); tB = min(max(tB, 0), SEQ - 1);
    const bf16* pa = CK + (size_t)tA * 512 + h * 64 + q * 8; const bf16* pb = CK + (size_t)tB * 512 + h * 64 + q * 8;
    kf[0] = *(const bf16x8*)pa; kf[1] = *(const bf16x8*)(pa + 32); kf[2] = *(const bf16x8*)pb; kf[3] = *(const bf16x8*)(pb + 32);
#pragma unroll
    for (int c = 0; c < 4; ++c) { int tv = p.kbase + ((p.kk0 + vkey + 8 * c) << p.sl); tv = min(max(tv, 0), SEQ - 1); vv[c] = *(const bf16x8*)(CV + (size_t)tv * 512 + h * 64 + vch * 8); }
}
struct CmQ { bf16x8 qf[2]; float mrun, lpart; f32x4 o[4]; int tq; };
__device__ __forceinline__ void cm_group(const CmStep& p, int r, int q, LAS unsigned char* Vl, const bf16x8 (&kf)[4], CmQ& Q, const s16x4 (&lo)[4], const s16x4 (&hi)[4]) {
    f32x4 sA = (f32x4){0.f, 0.f, 0.f, 0.f}, sB = sA;
    sA = __builtin_amdgcn_mfma_f32_16x16x32_bf16(kf[0], Q.qf[0], sA, 0, 0, 0); sA = __builtin_amdgcn_mfma_f32_16x16x32_bf16(kf[1], Q.qf[1], sA, 0, 0, 0);
    sB = __builtin_amdgcn_mfma_f32_16x16x32_bf16(kf[2], Q.qf[0], sB, 0, 0, 0); sB = __builtin_amdgcn_mfma_f32_16x16x32_bf16(kf[3], Q.qf[1], sB, 0, 0, 0);
    float sv[8]; bool ok[8]; float mx = -1e30f;
#pragma unroll
    for (int jj = 0; jj < 8; ++jj) {
        const int kk = p.kk0 + (jj < 4 ? 0 : 16) + 4 * q + (jj & 3), tk = p.kbase + (kk << p.sl), rel = Q.tq - tk;
        ok[jj] = (rel >= 0) && (rel <= p.window) && (tk >= 0) && ((rel & p.dmask) == 0);
        sv[jj] = ok[jj] ? (jj < 4 ? sA[jj & 3] : sB[jj & 3]) : -1e30f; mx = fmaxf(mx, sv[jj]);
    }
    mx = fmaxf(mx, __shfl_xor(mx, 16)); mx = fmaxf(mx, __shfl_xor(mx, 32));
    const float mnew = fmaxf(Q.mrun, mx), alpha = fexp2(Q.mrun - mnew); Q.mrun = mnew;
    float pp[8], ps = 0.f;
#pragma unroll
    for (int jj = 0; jj < 8; ++jj) { pp[jj] = ok[jj] ? fexp2(sv[jj] - mnew) : 0.f; ps += pp[jj]; }
    Q.lpart = Q.lpart * alpha + ps;
    v4u pw; pw.x = pk2(pp[0], pp[1]); pw.y = pk2(pp[2], pp[3]); pw.z = pk2(pp[4], pp[5]); pw.w = pk2(pp[6], pp[7]);
    const bf16x8 pf = __builtin_bit_cast(bf16x8, pw);
#pragma unroll
    for (int dt = 0; dt < 4; ++dt) {
        const bf16x8 vf = (bf16x8){lo[dt][0], lo[dt][1], lo[dt][2], lo[dt][3], hi[dt][0], hi[dt][1], hi[dt][2], hi[dt][3]};
        Q.o[dt] = Q.o[dt] * alpha;
        Q.o[dt] = __builtin_amdgcn_mfma_f32_16x16x32_bf16(vf, pf, Q.o[dt], 0, 0, 0);
    }
}
__device__ __forceinline__ void cm_compute(int j, int T0, int wid, int r, int q, int vkey, int vch, LAS unsigned char* Vl, const bf16x8 (&kf)[4], const bf16x8 (&vv)[4], CmQ (&Q)[CM_NG]) {
    if (j >= CM_NSTEP) return;
    const CmStep p = cm_step(j, T0, wid);
    const int klo = p.kbase + (p.kk0 << p.sl), khi = p.kbase + ((p.kk0 + 31) << p.sl);
    if (khi < 0) return;
    bool act[CM_NG]; bool any = false;
#pragma unroll
    for (int g = 0; g < CM_NG; ++g) { const int qlo = T0 + 128 * g + wid; act[g] = (khi >= qlo - p.window) && (klo <= qlo + 120); any |= act[g]; }
    if (!any) return;
#pragma unroll
    for (int c = 0; c < 4; ++c) *(LAS bf16x8*)(Vl + (vkey + 8 * c) * CM_PB + vch * 16) = vv[c];
    asm volatile("s_waitcnt lgkmcnt(0)" ::: "memory");
    typedef short v4i16_t __attribute__((ext_vector_type(4)));
    LAS unsigned char* tp = Vl + (4 * q + ((r >> 2) & 3)) * CM_PB + (r & 3) * 8;
    s16x4 lo[4], hi[4];
#pragma unroll
    for (int dt = 0; dt < 4; ++dt) {
        lo[dt] = __builtin_bit_cast(s16x4, __builtin_amdgcn_ds_read_tr16_b64_v4i16((LAS v4i16_t*)(tp + dt * 32)));
        hi[dt] = __builtin_bit_cast(s16x4, __builtin_amdgcn_ds_read_tr16_b64_v4i16((LAS v4i16_t*)(tp + 16 * CM_PB + dt * 32)));
    }
    asm volatile("s_waitcnt lgkmcnt(0)" ::: "memory");
#pragma unroll
    for (int g = 0; g < CM_NG; ++g) if (act[g]) cm_group(p, r, q, Vl, kf, Q[g], lo, hi);
}
__device__ __forceinline__ void cm_init(CmQ& Q, int tq, int h, int q, const bf16* CQ) {
    Q.tq = tq; Q.mrun = -1e30f; Q.lpart = 0.f;
#pragma unroll
    for (int ks = 0; ks < 2; ++ks) Q.qf[ks] = *(const bf16x8*)(CQ + (size_t)tq * 512 + h * 64 + ks * 32 + q * 8);
#pragma unroll
    for (int dt = 0; dt < 4; ++dt) Q.o[dt] = (f32x4){0.f, 0.f, 0.f, 0.f};
}
__device__ __forceinline__ void cm_store(const CmQ& Q, int h, int q, bf16* CZ) {
    float l = Q.lpart; l += __shfl_xor(l, 16); l += __shfl_xor(l, 32);
    const float inv = 1.f / l;
#pragma unroll
    for (int dt = 0; dt < 4; ++dt) {
        const size_t off = (size_t)Q.tq * YP + h * 64 + dt * 16 + 4 * q;
        const v2u zz = *(const v2u*)(CZ + off);
        v2u w; w.x = pk2(Q.o[dt][0] * inv * bflo(zz.x), Q.o[dt][1] * inv * bfhi(zz.x)); w.y = pk2(Q.o[dt][2] * inv * bflo(zz.y), Q.o[dt][3] * inv * bfhi(zz.y));
        *(v2u*)(CZ + off) = w;
    }
}
__device__ __forceinline__ void cmix_item(int tb, int h, const bf16* CQ, const bf16* CK, const bf16* CV, bf16* CZ, LAS unsigned char* ldsw, int wid, int lane) {
    const int r = lane & 15, q = lane >> 4, T0 = tb * CM_BLK;
    CmQ Q[CM_NG];
#pragma unroll
    for (int g = 0; g < CM_NG; ++g) cm_init(Q[g], T0 + 128 * g + wid + 8 * r, h, q, CQ);
    const int vkey = lane >> 3, vch = lane & 7;
    const int j0 = (T0 == 0) ? 3 : 0;
    bf16x8 K0[4], V0[4], K1[4], V1[4];
    cm_load(j0, T0, wid, h, r, q, vkey, vch, CK, CV, K0, V0);
#pragma unroll 1
    for (int j = j0; j < CM_NSTEP; j += 2) {
        cm_load(j + 1, T0, wid, h, r, q, vkey, vch, CK, CV, K1, V1); cm_compute(j, T0, wid, r, q, vkey, vch, ldsw, K0, V0, Q);
        cm_load(j + 2, T0, wid, h, r, q, vkey, vch, CK, CV, K0, V0); cm_compute(j + 1, T0, wid, r, q, vkey, vch, ldsw, K1, V1, Q);
    }
#pragma unroll
    for (int g = 0; g < CM_NG; ++g) cm_store(Q[g], h, q, CZ);
}

#define RLX_AGENT __ATOMIC_RELAXED, __HIP_MEMORY_SCOPE_AGENT
#define XB_TMO      128
#define XB_XCNT(j)  (256  + 64 * (j))
#define XB_XSUB(j)  (1280 + 64 * (j))
#define XB_XGEN(j)  (2304 + 64 * (j))
#define XB_TOP      3328
#define XB_TOPGEN   3392
#define XCD_BAR_WORDS 3456
#define XB_SPIN_CAP (1u << 18)

__device__ __forceinline__ unsigned xb_ld(unsigned* p)              { return __hip_atomic_load(p, __ATOMIC_RELAXED, __HIP_MEMORY_SCOPE_AGENT); }
__device__ __forceinline__ unsigned xb_add(unsigned* p, unsigned v) { return __hip_atomic_fetch_add(p, v, __ATOMIC_RELAXED, __HIP_MEMORY_SCOPE_AGENT); }
__device__ __forceinline__ unsigned xb_xcc_id() { return (unsigned)__builtin_amdgcn_s_getreg((3 << 11) | 20) & 0xFu; }
#define XB_SPIN(cond, bar) do { unsigned _sp = 0; while (cond) { __builtin_amdgcn_s_sleep(1); \
    if ((++_sp & 255u) == 0u) { if (xb_ld(&(bar)[XB_TMO])) break; if (_sp > XB_SPIN_CAP) { atomicAdd(&(bar)[XB_TMO], 1u); break; } } } } while (0)

struct XcdBarrier {
    unsigned* bar; unsigned x; int wave;
    volatile LAS unsigned* st;
};

__device__ __forceinline__ XcdBarrier xcd_barrier_post(unsigned* bar, volatile LAS unsigned* st, int wave) {
    XcdBarrier b; b.bar = bar; b.x = xb_xcc_id(); b.st = st; b.wave = wave;
    if (wave == 0 && mk_lane() == 0) (void)xb_add(&bar[XB_XCNT(b.x)], 1u);
    return b;
}
__device__ __forceinline__ void xcd_barrier_complete(unsigned* bar, unsigned x, unsigned& nloc, unsigned& nx) {
    const unsigned G = gridDim.x * gridDim.y * gridDim.z;
    unsigned sum, cnt, mine, sp = 0u;
    for (;;) {
        sum = 0u; cnt = 0u; mine = 0u;
#pragma unroll
        for (unsigned j = 0; j < 16; ++j) { const unsigned c = xb_ld(&bar[XB_XCNT(j)]); sum += c; cnt += (c > 0u) ? 1u : 0u; mine = (j == x) ? c : mine; }
        if (sum == G) break;
        __builtin_amdgcn_s_sleep(1);
        if ((++sp & 255u) == 0u) { if (xb_ld(&bar[XB_TMO])) break; if (sp > XB_SPIN_CAP) { atomicAdd(&bar[XB_TMO], 1u); break; } }
    }
    nloc = mine > 0u ? mine : 1u; nx = cnt > 0u ? cnt : 1u;
}

__device__ __forceinline__ void xcd_barrier(const XcdBarrier& b) {
    asm volatile("s_waitcnt vmcnt(0)" ::: "memory");
    __syncthreads();
    if (b.wave == 0 && mk_lane() == 0) {
        unsigned* bar = b.bar;
        __builtin_amdgcn_s_waitcnt(0);
        unsigned nloc = b.st[0], nx = b.st[1];
        if (nloc == 0u) { xcd_barrier_complete(bar, b.x, nloc, nx); b.st[0] = nloc; b.st[1] = nx; }
        const unsigned old = xb_add(&bar[XB_XSUB(b.x)], 1u);
        const unsigned gen = old / nloc;
        if (old + 1u == (gen + 1u) * nloc) {
            __builtin_amdgcn_fence(__ATOMIC_RELEASE, "agent");
            asm volatile("s_waitcnt vmcnt(0)" ::: "memory");
            const unsigned og = xb_add(&bar[XB_TOP], 1u);
            const unsigned tg = og / nx;
            if (og + 1u == (tg + 1u) * nx) xb_add(&bar[XB_TOPGEN], 1u);
            else XB_SPIN(xb_ld(&bar[XB_TOPGEN]) == tg, bar);
            __builtin_amdgcn_fence(__ATOMIC_ACQUIRE, "agent");
            xb_add(&bar[XB_XGEN(b.x)], 1u);
            asm volatile("s_waitcnt vmcnt(0)" ::: "memory");
        } else {
            XB_SPIN(xb_ld(&bar[XB_XGEN(b.x)]) == gen, bar);
            __builtin_amdgcn_fence(__ATOMIC_ACQUIRE, "agent");
            asm volatile("s_waitcnt vmcnt(0)" ::: "memory");
        }
    }
    __syncthreads();
}

struct Args { const void* in[16]; float* out; unsigned char* ws; int ph_lo, ph_hi; };
constexpr int N_PHASES = 6 * DEPTH + 1;

__global__ void __launch_bounds__(NWAVES * 64, 2) trunk_fwd(Args args) {
    extern __shared__ __attribute__((aligned(16))) unsigned char lds[];
    LAS unsigned char* L = (LAS unsigned char*)lds;
#define FRESH_TID() const int tid = mk_tid(wave0), lane = tid & 63, wid = __builtin_amdgcn_readfirstlane(tid >> 6); const int gw = vcu * NWAVES + wid; (void)tid; (void)lane; (void)gw
    const int wave0 = __builtin_amdgcn_readfirstlane((int)threadIdx.x >> 6);
    const int G = gridDim.x, bx = blockIdx.x;
    const int vcu = (G % 8 == 0) ? (bx % 8) * (G / 8) + bx / 8 : bx;
    const int NGW = G * NWAVES;
    unsigned char* ws = args.ws;
    const float* x_in = (const float*)args.in[0]; const int* pos = (const int*)args.in[1];
    float* out = args.out;
    float* ropec = (float*)(ws + WS_ROPE); float* ropes = ropec + SEQ * 8;
    bf16* WinT = (bf16*)(ws + WS_WIN); bf16* WbT = (bf16*)(ws + WS_WB); bf16* WoT = (bf16*)(ws + WS_WO);
    bf16* HB = (bf16*)(ws + WS_HB); bf16* OB = (bf16*)(ws + WS_O); bf16* PJ = (bf16*)(ws + WS_PJ);
    bf16* GL = PJ;
    const int lo = args.ph_lo, hi = args.ph_hi;
#define IN(k) (lo <= (k) && (k) < hi)
#ifdef PROBE_S1A
#define MARK(i) do { if (blockIdx.x == 0 && wave0 == 0 && mk_lane() == 0) ((LAS unsigned long long*)(L + LDS_BYTES - 512))[i] = __builtin_amdgcn_s_memrealtime(); } while (0)
#else
#define MARK(i) do {} while (0)
#endif
#define SEAM(k) do { if (IN(k) && IN((k) + 1)) { xcd_barrier(xbar); } MARK((k) + 1); } while (0)

    MARK(0);
    XcdBarrier xbar; xbar.bar = (unsigned*)(ws + WS_BAR); xbar.x = 0; xbar.wave = wave0; xbar.st = (volatile LAS unsigned*)(L + LDS_BYTES - 1024);
    {
        if (wave0 == 0 && mk_lane() < 2) ((LAS unsigned*)(L + LDS_BYTES - 1024))[mk_lane()] = 0u;
        __syncthreads();
        if (hi - lo > 1) xbar = xcd_barrier_post((unsigned*)(ws + WS_BAR), (volatile LAS unsigned*)(L + LDS_BYTES - 1024), wave0);
        if (lo < 0) cg::this_grid().sync();
    }
    for (int layer = 0; layer < DEPTH; ++layer) {
        const int pb = 6 * layer;
        const float* xsrc = layer == 0 ? x_in : out;
#ifndef SKIP_P0
        if (IN(pb + 0)) {
            FRESH_TID();
            const float* w_in = (const float*)args.in[3] + (size_t)layer * DM * NIN;
            const float* w_br = (const float*)args.in[13] + (size_t)layer * 3 * 512 * DM;
            const float* w_out = (const float*)args.in[14] + (size_t)layer * DM * DM;
            const float* ng = (const float*)args.in[2] + layer * DM;
            LAS float* scr = (LAS float*)(L + wid * 16384);
            constexpr int I_IN = (DM / 64) * (NIN / 32), I_B = (512 / 64) * (DM / 32), I_O = (DM / 64) * (DM / 32);
            constexpr int NITEMS = I_IN + 3 * I_B + I_O;
            for (int it = gw; it < NITEMS; it += NGW) {
                int r = it;
                if (r < I_IN) { p0_transpose_item(w_in, DM, NIN, WinT, DM, scr, r, lane); continue; } r -= I_IN;
                if (r < 3 * I_B) { const int br = r / I_B; p0_transpose_item(w_br + (size_t)br * 512 * DM, 512, DM, WbT + br * 512, YP, scr, r % I_B, lane); continue; } r -= 3 * I_B;
                p0_transpose_item(w_out, DM, DM, WoT, DM, scr, r, lane);
            }
            for (int m = gw; m < SEQ; m += 4 * NGW) rms_rows<4, true>(xsrc + (size_t)m * DM, (size_t)NGW * DM, ng, HB + (size_t)m * DM, lane);
            if (layer == 0) {
                for (int idx = (vcu * NWAVES * 64) + tid; idx < SEQ * 8; idx += G * NWAVES * 64) {
                    const int tok = idx >> 3, i = idx & 7;
                    const float ang = (float)pos[tok] * __builtin_amdgcn_exp2f(-(float)i * (18.931568569324174f / 8.0f));
                    const double rev = (double)ang * 0.15915494309189535; const double fr_ = rev - __builtin_rint(rev);
                    ropec[idx] = __builtin_amdgcn_cosf((float)fr_); ropes[idx] = __builtin_amdgcn_sinf((float)fr_);
                }
            }
        }
#endif
        SEAM(pb + 0);
#ifndef SKIP_P1
        if (IN(pb + 1)) {
            pg8::Gemm g{HB, WinT, SEQ, NMAIN, DM}; pg8::StaticOrder S; S.init(SEQ, NMAIN, G, bx);
            EpiProj E{PJ, ropec, ropes};
            pg8::gemm_phase<EpiProj, pg8::StaticOrder, true, true>(L, g, S, E, pg8::NoHook(), wave0);
        }
#endif
        SEAM(pb + 1);
        if (IN(pb + 2)) {
#ifndef SKIP_ATT
            {
                const int hm = vcu >> 5, s = vcu & 31;
                const int nit = (G == 256) ? 2 : (vcu < 512 ? (512 - vcu + G - 1) / G : 0);
                for (int i = 0; i < nit; ++i) {
                    int hm2, qb; if (G == 256) { hm2 = hm; qb = i ? 63 - s : s; } else { const int u = vcu + i * G; hm2 = u >> 6; qb = u & 63; }
                    attn_body::attn_unit<8>(qb, (const attn_body::bf16*)(PJ + SL_AQ * SLOT_ELEMS) + hm2 * 64, (const attn_body::bf16*)(PJ + SL_AK * SLOT_ELEMS) + hm2 * 64,
                                            (const attn_body::bf16*)(PJ + SL_AV * SLOT_ELEMS) + (hm2 >> 1) * 128, (attn_body::bf16*)OB + hm2 * 128, (char*)lds, wave0);
                }
            }
#endif
            if (layer == 0) MARK(20);
#ifndef SKIP_SGU
            {
                FRESH_TID();
                const float* lng = (const float*)args.in[9] + layer * 512; const float* lnb = (const float*)args.in[10] + layer * 512;
                const float* sw = (const float*)args.in[11] + (size_t)layer * 4 * 128 * 128; const float* sb = (const float*)args.in[12] + layer * 4 * 128;
                for (int it = vcu; it < 512; it += G) sgu_item(it, PJ + SL_BU * SLOT_ELEMS, PJ + SL_BV * SLOT_ELEMS, PJ + SL_AZ * SLOT_ELEMS + 512, lng, lnb, sw, sb, L, tid, wid, lane);
            }
#endif
            if (layer == 0) MARK(21);
#ifndef SKIP_CMIX
            {
                FRESH_TID();
                for (int it = vcu; it < (SEQ / CM_BLK) * 8; it += G) cmix_item(it >> 3, it & 7, PJ + SL_CQ * SLOT_ELEMS, PJ + SL_CK * SLOT_ELEMS, PJ + SL_CV * SLOT_ELEMS, PJ + SL_AZ * SLOT_ELEMS + 1024, L + wid * 8192, wid, lane);
                __syncthreads();
            }
#endif
            if (layer == 0) MARK(22);
        }
        SEAM(pb + 2);
#ifndef SKIP_P3
        if (IN(pb + 3)) {
            { FRESH_TID();
            const float lam_init = 0.8f - 0.6f * __expf(-0.3f * (float)layer);
            const float* lq1 = (const float*)args.in[4] + layer * 64; const float* lk1 = (const float*)args.in[5] + layer * 64;
            const float* lq2 = (const float*)args.in[6] + layer * 64; const float* lk2 = (const float*)args.in[7] + layer * 64;
            const float lam = __expf(wave_sum(lq1[lane] * lk1[lane])) - __expf(wave_sum(lq2[lane] * lk2[lane])) + lam_init;
            const float* sg = (const float*)args.in[8] + layer * 128;
            const int e0 = (lane & 15) * 8, hh = lane >> 4;
            const f32x4 g0 = *(const f32x4*)(sg + e0), g1 = *(const f32x4*)(sg + e0 + 4);
            bf16* AZ = PJ + SL_AZ * SLOT_ELEMS;
            for (int m0 = gw; m0 < SEQ; m0 += 4 * NGW) {
                v4u A4[4], B4[4], Z4[4];
#pragma unroll
                for (int k = 0; k < 4; ++k) { const size_t m = (size_t)m0 + (size_t)k * NGW;
                    A4[k] = *(const v4u*)(OB + m * DM + hh * 256 + e0); B4[k] = *(const v4u*)(OB + m * DM + hh * 256 + 128 + e0); Z4[k] = *(const v4u*)(AZ + m * YP + hh * 128 + e0); }
#pragma unroll
                for (int k = 0; k < 4; ++k) { const size_t m = (size_t)m0 + (size_t)k * NGW; const v4u a = A4[k], b = B4[k], z = Z4[k];
                float d[8] = {bflo(a.x) - lam * bflo(b.x), bfhi(a.x) - lam * bfhi(b.x), bflo(a.y) - lam * bflo(b.y), bfhi(a.y) - lam * bfhi(b.y),
                              bflo(a.z) - lam * bflo(b.z), bfhi(a.z) - lam * bfhi(b.z), bflo(a.w) - lam * bflo(b.w), bfhi(a.w) - lam * bfhi(b.w)};
                float ss = 0.f;
#pragma unroll
                for (int e = 0; e < 8; ++e) ss += d[e] * d[e];
                ss += __shfl_xor(ss, 1); ss += __shfl_xor(ss, 2); ss += __shfl_xor(ss, 4); ss += __shfl_xor(ss, 8);
                const float rr = (1.f / sqrtf(ss * (1.f / 128.f) + EPS)) * (1.f - lam_init);
                v4u w; w.x = pk2(d[0] * rr * g0[0] * bflo(z.x), d[1] * rr * g0[1] * bfhi(z.x)); w.y = pk2(d[2] * rr * g0[2] * bflo(z.y), d[3] * rr * g0[3] * bfhi(z.y));
                w.z = pk2(d[4] * rr * g1[0] * bflo(z.z), d[5] * rr * g1[1] * bfhi(z.z)); w.w = pk2(d[6] * rr * g1[2] * bflo(z.w), d[7] * rr * g1[3] * bfhi(z.w));
                *(v4u*)(AZ + m * YP + hh * 128 + e0) = w; }
            } }
            asm volatile("s_waitcnt vmcnt(0) lgkmcnt(0)" ::: "memory"); __syncthreads();
            pg8::Gemm g{HB, WinT + (size_t)NMAIN * DM, SEQ, NGATE, DM}; pg8::StaticOrder S; S.init(SEQ, NGATE, G, bx);
            EpiGate E{GL};
            pg8::gemm_phase<EpiGate, pg8::StaticOrder, true, true>(L, g, S, E, pg8::NoHook(), wave0);
        }
#endif
        SEAM(pb + 3);
#ifndef SKIP_P4
        if (IN(pb + 4)) {
            pg8::StaticOrder S; S.init(SEQ, DM, G, bx);
            pg8::Gemm g{PJ + (size_t)SL_AZ * SLOT_ELEMS, WbT, SEQ, DM, YP}; EpiMerge E{GL, OB}; MergeHook H{GL};
            pg8::gemm_phase<EpiMerge, pg8::StaticOrder, false, true, MergeHook>(L, g, S, E, H, wave0);
        }
#endif
        SEAM(pb + 4);
#ifdef PROBE_S1A
        if (layer == 0 && IN(pb + 4) && IN(pb + 5)) { MARK(23); xcd_barrier(xbar); MARK(24); }
#endif
#ifndef SKIP_P5
        if (IN(pb + 5)) {
            pg8::Gemm g{OB, WoT, SEQ, DM, DM}; pg8::StaticOrder S; S.init(SEQ, DM, G, bx);
            EpiOut E{xsrc, out};
            pg8::gemm_phase<EpiOut, pg8::StaticOrder, false, true>(L, g, S, E, pg8::NoHook(), wave0);
        }
#endif
        SEAM(pb + 5);
    }
    if (IN(6 * DEPTH)) {
        FRESH_TID();
        const float* fg = (const float*)args.in[15];
        for (int m = gw; m < SEQ; m += 4 * NGW) rms_rows<4, false>(out + (size_t)m * DM, (size_t)NGW * DM, fg, out + (size_t)m * DM, lane);
    }
#ifdef PROBE_S1A
    MARK(13);
    __syncthreads();
    if (blockIdx.x == 0 && wave0 == 0 && mk_lane() == 0) {
        const LAS unsigned long long* T = (const LAS unsigned long long*)(L + LDS_BYTES - 512);
        const unsigned long long s1 = T[PROBE_S1B] - T[PROBE_S1A], s2 = T[PROBE_S2B] - T[PROBE_S2A];
        const unsigned long long spin = 4ull * s1 + 300000ull * ((s2 + 1000ull) / 2000ull);
        const unsigned long long t0 = __builtin_amdgcn_s_memrealtime();
        while (__builtin_amdgcn_s_memrealtime() - t0 < spin) __builtin_amdgcn_s_sleep(8);
    }
#endif
#undef IN
#undef SEAM
}

extern "C" void kernel_launch(void* const* d_in, const int* in_sizes, int n_in, void* d_out, int out_size, void* d_ws, size_t ws_size, hipStream_t stream) {
    static int grid = 0;
    if (grid == 0) {
        if (n_in != 16 || out_size != SEQ * DM || ws_size < WS_END) { fprintf(stderr, "kernel_launch: unexpected shapes (n_in %d out %d ws %zu need %zu)\n", n_in, out_size, ws_size, (size_t)WS_END); grid = -1; return; }
        int dev = 0, cus = 0, per_cu = 0;
        hipGetDevice(&dev); hipDeviceGetAttribute(&cus, hipDeviceAttributeMultiprocessorCount, dev);
        if (hipFuncSetAttribute((const void*)trunk_fwd, hipFuncAttributeMaxDynamicSharedMemorySize, LDS_BYTES) != hipSuccess) { fprintf(stderr, "kernel_launch: hipFuncSetAttribute failed\n"); grid = -1; return; }
        hipOccupancyMaxActiveBlocksPerMultiprocessor(&per_cu, (const void*)trunk_fwd, NWAVES * 64, LDS_BYTES);
        (void)hipGetLastError();
        if (per_cu < 1) per_cu = 1;
        grid = cus * (per_cu > 1 ? 1 : per_cu);
        fprintf(stderr, "kernel_launch: grid %d (cus %d per_cu %d)\n", grid, cus, per_cu);
    }
    if (grid < 0) return;
    Args a{};
    for (int i = 0; i < 16; ++i) a.in[i] = d_in[i];
    a.out = (float*)d_out; a.ws = (unsigned char*)d_ws;
#if MK_ONE_LAUNCH
    if (hipMemsetAsync((unsigned char*)d_ws + WS_BAR, 0, 16384, stream) != hipSuccess) { fprintf(stderr, "kernel_launch: memset failed\n"); return; }
    a.ph_lo = 0; a.ph_hi = N_PHASES;
    void* kargs[] = {&a};
    hipError_t e = hipLaunchCooperativeKernel((const void*)trunk_fwd, dim3(grid), dim3(NWAVES * 64), kargs, LDS_BYTES, stream);
    if (e != hipSuccess) fprintf(stderr, "cooperative launch failed: %s (grid %d)\n", hipGetErrorString(e), grid);
#else
    for (int p = 0; p < N_PHASES; ++p) { a.ph_lo = p; a.ph_hi = p + 1; hipLaunchKernelGGL(trunk_fwd, dim3(grid), dim3(NWAVES * 64), LDS_BYTES, stream, a);
    }
#endif
}
```

```cpp
#include <hip/hip_runtime.h>
#include <hip/hip_cooperative_groups.h>
#include <cstdio>
#include <cstdint>
#include <cmath>
__device__ __forceinline__ int mk_lane() { return (int)__builtin_amdgcn_mbcnt_hi(~0u, __builtin_amdgcn_mbcnt_lo(~0u, 0u)); }
__device__ __forceinline__ int mk_tid(int wave) { int l; asm volatile("v_mbcnt_lo_u32_b32 %0, -1, 0\n\tv_mbcnt_hi_u32_b32 %0, -1, %0" : "=&v"(l)); return wave * 64 + l; }
#define MK_ONE_LAUNCH 1
namespace pg8 {
#define PG8_LAS __attribute__((address_space(3)))
typedef unsigned short bf16_t;
typedef short bf16x8 __attribute__((ext_vector_type(8)));
typedef float f32x4 __attribute__((ext_vector_type(4)));
typedef unsigned u32x4 __attribute__((ext_vector_type(4)));
constexpr int BM = 256, BK = 64, HALF = 128, HTB = HALF * BK * 2  , STAGE_BYTES = 8 * HTB, NXCD = 8, WGM = 8;

__host__ __device__ __forceinline__ int lds_byte(int r, int c) { const int st = (r >> 4) * 2 + (c >> 5), rr = r & 15, cc = c & 31, ob = rr * 64 + cc * 2; return st * 1024 + (ob ^ (((ob >> 9) & 1) << 5)); }
__host__ __device__ __forceinline__ void stage_rc(int b, int& R, int& C) { const int st = b / 1024, sb = b % 1024, swz = sb ^ (((sb >> 9) & 1) << 5); R = (st >> 1) * 16 + swz / 64; C = (st & 1) * 32 + (swz % 64) / 2; }
__host__ __device__ __forceinline__ int perm32(int rho) { const int n = rho >> 4, i = rho & 15; return 8 * (i >> 2) + 4 * n + (i & 3); }

struct Unit { int pm, pn; };
struct Gemm { const bf16_t* A; const bf16_t* Bt; int M, N, K; };

struct StaticOrder {
    int nM, nN, nwg, G, c;
    __host__ __device__ void init(int M, int N, int G_, int c_) { nM = M / BM; nN = N / BM; nwg = nM * nN; G = G_; c = c_; }
    __host__ __device__ bool next(int i, Unit& u) const {
        const long L = (long)i * G + c; if (L >= nwg) return false;
        int wgid = (int)L; { const int q = nwg / NXCD, r = nwg % NXCD, xcd = wgid % NXCD, off = wgid / NXCD; wgid = (xcd < r ? xcd * (q + 1) : r * (q + 1) + (xcd - r) * q) + off; }
        const int nig = WGM * nN, gid = wgid / nig, fm = gid * WGM, gsz = (nM - fm) < WGM ? (nM - fm) : WGM;
        u.pm = fm + ((wgid % nig) % gsz); u.pn = (wgid % nig) / gsz; return true;
    }
    __device__ __forceinline__ void a_ready(const Unit&) const {}
    __device__ __forceinline__ void done(const Unit&) const {}
};

__device__ __forceinline__ unsigned cvt_pk_bf16(float lo, float hi) { unsigned r; asm volatile("v_cvt_pk_bf16_f32 %0, %1, %2" : "=v"(r) : "v"(lo), "v"(hi)); return r; }
typedef float f32x2 __attribute__((ext_vector_type(2)));
struct NoHook { static constexpr int PERIOD = 0; __device__ __forceinline__ void operator()(f32x4 (&)[2][2][4][2], const Unit&, int, int, int, int, int) const {} };
template <class Epi, class Sched, bool ALIGN_EPI = false, bool SP2 = false, class Hook = NoHook>
__device__ __forceinline__ void gemm_phase(PG8_LAS unsigned char* lds, const Gemm g, const Sched& S, const Epi& E, const Hook& H, int wave_id) {
    int tid_ = mk_tid(wave_id);
    const int tid = tid_, wid = __builtin_amdgcn_readfirstlane(tid >> 6), lane = tid & 63, wr = wid >> 2, wc = wid & 3, fr = lane & 15, fq = lane >> 4;
    const int K = g.K, nt = K / BK;
    unsigned voffA[2], voffB[2];
#pragma unroll
    for (int i = 0; i < 2; ++i) { int R, C; stage_rc(tid * 16 + i * 8192, R, C); const int Rb = Epi::PERM ? ((R & ~31) + perm32(R & 31)) : R;
        voffA[i] = (unsigned)(R * K + C) * 2u; voffB[i] = (unsigned)(Rb * K + C) * 2u; }
    const size_t kstep = (size_t)(BK * 2);
    const size_t hstep = (size_t)HALF * K * 2;
    const size_t tstep = 2 * hstep;
    const unsigned ldsw = (unsigned)wid * 1024u;
    const int aoff = lds_byte(wr * 64 + fr, fq * 8), boff = lds_byte(wc * 32 + fr, fq * 8);
#define PG8_SA(b, h) (((b) * 2 + (h)) * HTB)
#define PG8_SB(b, h) ((4 + (b) * 2 + (h)) * HTB)
#define PG8_STAGE(bufoff, gbase, voff) do { _Pragma("unroll") for (int _i = 0; _i < 2; ++_i) \
        __builtin_amdgcn_global_load_lds((const unsigned*)((const char*)(gbase) + (voff)[_i]), (PG8_LAS unsigned*)(lds + (bufoff) + ldsw + _i * 8192), 16, 0, 0); } while (0)
#define PG8_LDA(dst, b, h) do { _Pragma("unroll") for (int m = 0; m < 4; ++m) _Pragma("unroll") for (int k = 0; k < 2; ++k) dst[m][k] = *(const PG8_LAS bf16x8*)(lds + PG8_SA(b, h) + aoff + m * 2048 + k * 1024); } while (0)
#define PG8_LDB(dst, b, h) do { _Pragma("unroll") for (int n = 0; n < 2; ++n) _Pragma("unroll") for (int k = 0; k < 2; ++k) dst[n][k] = *(const PG8_LAS bf16x8*)(lds + PG8_SB(b, h) + boff + n * 2048 + k * 1024); } while (0)
#define PG8_MMA(ai, bj, At, Bt) do { __builtin_amdgcn_s_setprio(1); _Pragma("unroll") for (int m = 0; m < 4; ++m) _Pragma("unroll") for (int n = 0; n < 2; ++n) _Pragma("unroll") for (int k = 0; k < 2; ++k) \
        acc[ai][bj][m][n] = __builtin_amdgcn_mfma_f32_16x16x32_bf16(Bt[n][k], At[m][k], acc[ai][bj][m][n], 0, 0, 0); __builtin_amdgcn_s_setprio(0); } while (0)
#define PG8_WAIT_V(n) asm volatile("s_waitcnt vmcnt(" #n ")" ::: "memory")
#define PG8_WAIT_L(n) asm volatile("s_waitcnt lgkmcnt(" #n ")" ::: "memory")
#define PG8_BAR __builtin_amdgcn_s_barrier()
#define PG8_SCHED __builtin_amdgcn_sched_barrier(0)
    Unit cur, nxt; int ui = 0;
    if (!S.next(0, cur)) return;
    f32x4 acc[2][2][4][2];
#pragma unroll
    for (int a = 0; a < 2; ++a)
#pragma unroll
        for (int b = 0; b < 2; ++b)
#pragma unroll
            for (int m = 0; m < 4; ++m)
#pragma unroll
                for (int n = 0; n < 2; ++n) acc[a][b][m][n] = (f32x4){0.f, 0.f, 0.f, 0.f};
    bf16x8 At[4][2], B0[2][2], B1[2][2];
    const char* cA = (const char*)g.A + (size_t)cur.pm * tstep; const char* cB = (const char*)g.Bt + (size_t)cur.pn * tstep;
    S.a_ready(cur);
    if constexpr (SP2) {
        PG8_STAGE(PG8_SB(0, 0), cB, voffB); PG8_STAGE(PG8_SB(0, 1), cB + hstep, voffB); PG8_STAGE(PG8_SA(0, 0), cA, voffA); PG8_STAGE(PG8_SA(0, 1), cA + hstep, voffA);
        if (wr == 1) PG8_BAR;
        PG8_WAIT_V(2); PG8_BAR;
        PG8_STAGE(PG8_SB(1, 0), cB + kstep, voffB); PG8_STAGE(PG8_SA(1, 0), cA + kstep, voffA); PG8_STAGE(PG8_SB(1, 1), cB + hstep + kstep, voffB);
        PG8_WAIT_V(6); PG8_BAR;
    } else {
        PG8_STAGE(PG8_SB(0, 0), cB, voffB); PG8_STAGE(PG8_SA(0, 0), cA, voffA); PG8_STAGE(PG8_SB(0, 1), cB + hstep, voffB); PG8_STAGE(PG8_SA(0, 1), cA + hstep, voffA);
        if (wr == 1) PG8_BAR;
        PG8_WAIT_V(4); PG8_BAR;
        PG8_STAGE(PG8_SB(1, 0), cB + kstep, voffB); PG8_STAGE(PG8_SA(1, 0), cA + kstep, voffA); PG8_STAGE(PG8_SB(1, 1), cB + hstep + kstep, voffB);
        PG8_WAIT_V(6); PG8_BAR;
    }
    for (;;) {
        const bool has_next = S.next(ui + 1, nxt);
        const char* nA = has_next ? (const char*)g.A + (size_t)nxt.pm * tstep : cA; const char* nB = has_next ? (const char*)g.Bt + (size_t)nxt.pn * tstep : cB;
        for (int t = 0; t < nt; t += 2) {
            if constexpr (Hook::PERIOD > 0) { if (t > 0 && (t % Hook::PERIOD) == 0) { H(acc, cur, t / Hook::PERIOD, wr, wc, fr, fq); PG8_SCHED; } }
            const bool last = (t == nt - 2);
            const char* a1 = cA + (size_t)(t + 1) * kstep;
            const char* a2 = last ? nA : cA + (size_t)(t + 2) * kstep; const char* b2 = last ? nB : cB + (size_t)(t + 2) * kstep;
            const char* a3 = a2 + kstep; const char* b3 = b2 + kstep;
            if (last && has_next) S.a_ready(nxt);
            if constexpr (SP2) {
            PG8_LDB(B0, 0, 0); PG8_LDB(B1, 0, 1); PG8_SCHED; PG8_LDA(At, 0, 0); PG8_STAGE(PG8_SA(1, 1), a1 + hstep, voffA);
            PG8_WAIT_V(8); PG8_WAIT_L(0); PG8_BAR; PG8_MMA(0, 0, At, B0); PG8_MMA(0, 1, At, B1); PG8_BAR; PG8_SCHED;
            PG8_LDA(At, 0, 1); PG8_STAGE(PG8_SB(0, 0), b2, voffB); PG8_STAGE(PG8_SB(0, 1), b2 + hstep, voffB); PG8_STAGE(PG8_SA(0, 0), a2, voffA);
            PG8_WAIT_V(8); PG8_WAIT_L(0); PG8_BAR; PG8_MMA(1, 0, At, B0); PG8_MMA(1, 1, At, B1); PG8_BAR; PG8_SCHED;
            PG8_LDB(B0, 1, 0); PG8_LDB(B1, 1, 1); PG8_SCHED; PG8_LDA(At, 1, 0); PG8_STAGE(PG8_SA(0, 1), a2 + hstep, voffA);
            PG8_WAIT_V(8); PG8_WAIT_L(0); PG8_BAR; PG8_MMA(0, 0, At, B0); PG8_MMA(0, 1, At, B1); PG8_BAR; PG8_SCHED;
            PG8_LDA(At, 1, 1); PG8_STAGE(PG8_SB(1, 0), b3, voffB); PG8_STAGE(PG8_SB(1, 1), b3 + hstep, voffB); PG8_STAGE(PG8_SA(1, 0), a3, voffA);
            PG8_WAIT_V(8); PG8_WAIT_L(0); PG8_BAR; PG8_MMA(1, 0, At, B0); PG8_MMA(1, 1, At, B1); PG8_BAR; PG8_SCHED;
            } else {
            PG8_LDB(B0, 0, 0); PG8_SCHED; PG8_LDA(At, 0, 0); PG8_STAGE(PG8_SA(1, 1), a1 + hstep, voffA);
            PG8_WAIT_L(8); PG8_BAR; PG8_WAIT_L(0); PG8_MMA(0, 0, At, B0); PG8_BAR; PG8_SCHED;
            PG8_LDB(B1, 0, 1); PG8_STAGE(PG8_SB(0, 0), b2, voffB);
            PG8_BAR; PG8_WAIT_L(0); PG8_MMA(0, 1, At, B1); PG8_BAR;
            PG8_LDA(At, 0, 1); PG8_STAGE(PG8_SA(0, 0), a2, voffA);
            PG8_BAR; PG8_WAIT_L(0); PG8_MMA(1, 0, At, B0); PG8_BAR; PG8_SCHED;
            PG8_STAGE(PG8_SB(0, 1), b2 + hstep, voffB);
            PG8_WAIT_V(6); PG8_BAR; PG8_MMA(1, 1, At, B1); PG8_BAR;
            PG8_LDB(B0, 1, 0); PG8_SCHED; PG8_LDA(At, 1, 0); PG8_STAGE(PG8_SA(0, 1), a2 + hstep, voffA);
            PG8_WAIT_L(8); PG8_BAR; PG8_WAIT_L(0); PG8_MMA(0, 0, At, B0); PG8_BAR; PG8_SCHED;
            PG8_LDB(B1, 1, 1); PG8_STAGE(PG8_SB(1, 0), b3, voffB);
            PG8_BAR; PG8_WAIT_L(0); PG8_MMA(0, 1, At, B1); PG8_BAR;
            PG8_LDA(At, 1, 1); PG8_STAGE(PG8_SA(1, 0), a3, voffA);
            PG8_BAR; PG8_WAIT_L(0); PG8_MMA(1, 0, At, B0); PG8_BAR; PG8_SCHED;
            PG8_STAGE(PG8_SB(1, 1), b3 + hstep, voffB);
            PG8_WAIT_V(6); PG8_BAR; PG8_MMA(1, 1, At, B1); PG8_BAR;
            }
        }
        if constexpr (ALIGN_EPI) { if (wr == 0) PG8_BAR; }
        if constexpr (!Epi::AFTER_DRAIN) { E(acc, cur, wr, wc, fr, fq); S.done(cur); }
        if (!has_next) break;
#pragma unroll
        for (int a = 0; a < 2; ++a)
#pragma unroll
            for (int b = 0; b < 2; ++b)
#pragma unroll
                for (int m = 0; m < 4; ++m)
#pragma unroll
                    for (int n = 0; n < 2; ++n) acc[a][b][m][n] = (f32x4){0.f, 0.f, 0.f, 0.f};
        cur = nxt; cA = nA; cB = nB; ++ui;
        if constexpr (ALIGN_EPI) { if (wr == 1) PG8_BAR; }
    }
    PG8_WAIT_V(0);
    if constexpr (!ALIGN_EPI) { if (wr == 0) PG8_BAR; }
    PG8_BAR;
    if constexpr (Epi::AFTER_DRAIN) { E.fused(acc, cur, wr, wc, fr, fq, lds, wid, lane); S.done(cur); }
#undef PG8_SA
#undef PG8_SB
#undef PG8_STAGE
#undef PG8_LDA
#undef PG8_LDB
#undef PG8_MMA
#undef PG8_WAIT_V
#undef PG8_WAIT_L
#undef PG8_BAR
#undef PG8_SCHED
}
}
#include <hip/hip_bf16.h>
namespace attn_body {
using bf16=__hip_bfloat16;
using bf16x8=__attribute__((ext_vector_type(8)))short;
using s16x4=__attribute__((ext_vector_type(4)))short;
using f32x16=__attribute__((ext_vector_type(16)))float;
using u32x4=__attribute__((ext_vector_type(4)))unsigned;
constexpr int SEQ=16384,D=64,PQ=512,PK=512,PV=512,PO=1024;
constexpr int NW=8,QBLK=32,QB=QBLK*NW,KVBLK=64,NQB=SEQ/QB;
constexpr int ATTN_UNIT_ROWS=QB;
__device__ __forceinline__ int crow(int r,int hi){return (r&3)+8*(r>>2)+4*hi;}
#define SBAR() __builtin_amdgcn_sched_barrier(0)
__device__ __forceinline__ void cmask(f32x16&p0,f32x16&p1,int jb,int qrel,int hi){
  const float NEG=-INFINITY; int kb=64*jb+4*hi;
  #pragma unroll
  for(int r=0;r<16;++r){int kv=kb+(r&3)+8*(r>>2); if(kv>qrel)p0[r]=NEG; if(kv+32>qrel)p1[r]=NEG;}
}

constexpr int NSLOT=3, SLOTB=8192;
constexpr int VSLOTB=2*SLOTB;
constexpr int LDS_K=0, LDS_V=NSLOT*SLOTB, LDS_WS=LDS_V+NSLOT*VSLOTB, LDS_OST=LDS_WS+NW*64*4, LDS_BYTES=LDS_OST+NW*8192;
constexpr float C2=0.125f*1.4426950408889634f;
__device__ __forceinline__ void glds16(const void*gsrc,unsigned lds_dst){unsigned keep;
  asm volatile("s_mov_b32 %0, m0\n\ts_mov_b32 m0, %2\n\ts_nop 0\n\tglobal_load_lds_dwordx4 %1, off\n\ts_mov_b32 m0, %0":"=&s"(keep):"v"(gsrc),"s"(lds_dst):"memory");}
__device__ __forceinline__ float max3f(float a,float b,float c){float r;asm("v_max3_f32 %0, %1, %2, %3":"=v"(r):"v"(a),"v"(b),"v"(c));return r;}
__device__ __forceinline__ float max2f(float a,float b){float r;asm("v_max_f32_e32 %0, %1, %2":"=v"(r):"v"(a),"v"(b));return r;}
__device__ __forceinline__ float fadd_s(float a,float b){float r;asm("v_add_f32_e32 %0, %1, %2":"=v"(r):"v"(a),"v"(b));return r;}
__device__ __forceinline__ float fsub_s(float a,float b){float r;asm("v_sub_f32_e32 %0, %1, %2":"=v"(r):"v"(a),"v"(b));return r;}
typedef float f32x2_t __attribute__((ext_vector_type(2))); typedef __bf16 bf16x2_t __attribute__((ext_vector_type(2)));
__device__ __forceinline__ unsigned cvtpk_s(float lo,float hi){f32x2_t v={lo,hi};bf16x2_t b=__builtin_convertvector(v,bf16x2_t);return __builtin_bit_cast(unsigned,b);}
#define WAIT_BAR(N) asm volatile("s_waitcnt vmcnt(" #N ") lgkmcnt(0)\n\ts_barrier":::"memory")

__device__ __forceinline__ void qkt(f32x16&p0,f32x16&p1,const char*Kslot,const bf16x8*qr,const f32x16&negm,int r32,int hi){
  const char*kb=Kslot+hi*1024+r32*16;
  #pragma unroll
  for(int d0=0;d0<4;++d0){
    const bf16x8 b0=*reinterpret_cast<const bf16x8*>(kb+d0*2048);
    const bf16x8 b1=*reinterpret_cast<const bf16x8*>(kb+d0*2048+512);
    if(d0==0){p0=__builtin_amdgcn_mfma_f32_32x32x16_bf16(b0,qr[0],negm,0,0,0);p1=__builtin_amdgcn_mfma_f32_32x32x16_bf16(b1,qr[0],negm,0,0,0);}
    else{p0=__builtin_amdgcn_mfma_f32_32x32x16_bf16(b0,qr[d0],p0,0,0,0);p1=__builtin_amdgcn_mfma_f32_32x32x16_bf16(b1,qr[d0],p1,0,0,0);}}
}
typedef __attribute__((address_space(3))) const char* lds_cptr;
typedef short v4i16_t __attribute__((ext_vector_type(4)));
__device__ __forceinline__ void kload8(bf16x8*kf,lds_cptr kp){
  kf[0]=*(const __attribute__((address_space(3))) bf16x8*)(kp);      kf[1]=*(const __attribute__((address_space(3))) bf16x8*)(kp+512);
  kf[2]=*(const __attribute__((address_space(3))) bf16x8*)(kp+2048); kf[3]=*(const __attribute__((address_space(3))) bf16x8*)(kp+2560);
  kf[4]=*(const __attribute__((address_space(3))) bf16x8*)(kp+4096); kf[5]=*(const __attribute__((address_space(3))) bf16x8*)(kp+4608);
  kf[6]=*(const __attribute__((address_space(3))) bf16x8*)(kp+6144); kf[7]=*(const __attribute__((address_space(3))) bf16x8*)(kp+6656);
}
__device__ __forceinline__ void kload2(bf16x8*kf,lds_cptr kp,int j){ kf[2*j]=*(const __attribute__((address_space(3))) bf16x8*)(kp+j*2048); kf[2*j+1]=*(const __attribute__((address_space(3))) bf16x8*)(kp+j*2048+512); }
__device__ __forceinline__ s16x4 vtr(lds_cptr p){ return __builtin_bit_cast(s16x4,__builtin_amdgcn_ds_read_tr16_b64_v4i16((__attribute__((address_space(3))) v4i16_t*)p)); }
__device__ __forceinline__ float rowmax(const f32x16&p0,const f32x16&p1){
  float a=max3f(p0[0],p0[1],p1[0]),b=max3f(p0[2],p0[3],p1[1]);a=max3f(a,p1[2],p1[3]);
  #pragma unroll
  for(int r=4;r<16;r+=4){a=max3f(a,p0[r],p0[r+1]);b=max3f(b,p0[r+2],p0[r+3]);a=max3f(a,p1[r],p1[r+1]);b=max3f(b,p1[r+2],p1[r+3]);}
  const float m=max2f(a,b);
  auto rr=__builtin_amdgcn_permlane32_swap(__float_as_uint(m),__float_as_uint(m),false,false);
  return max2f(__uint_as_float(rr[0]),__uint_as_float(rr[1]));
}
__device__ __forceinline__ void pv(f32x16*o,int vb,bf16x8 pa0,bf16x8 pa1,bf16x8 pa2,bf16x8 pa3){
  #pragma unroll
  for(int d0=0;d0<4;++d0){s16x4 lo[4],hi[4];
    #pragma unroll
    for(int ks=0;ks<4;++ks){
      asm volatile("ds_read_b64_tr_b16 %0,%1 offset:%c2":"=&v"(lo[ks]):"v"(vb),"i"((d0>>1)*8192+(d0&1)*4096+ks*1024):"memory");
      asm volatile("ds_read_b64_tr_b16 %0,%1 offset:%c2":"=&v"(hi[ks]):"v"(vb),"i"((d0>>1)*8192+(d0&1)*4096+ks*1024+512):"memory");}
    asm volatile("s_waitcnt lgkmcnt(0)":::"memory");SBAR();
    #define PK(k) (bf16x8){lo[k][0],lo[k][1],lo[k][2],lo[k][3],hi[k][0],hi[k][1],hi[k][2],hi[k][3]}
    o[d0]=__builtin_amdgcn_mfma_f32_32x32x16_bf16(pa0,PK(0),o[d0],0,0,0);
    o[d0]=__builtin_amdgcn_mfma_f32_32x32x16_bf16(pa1,PK(1),o[d0],0,0,0);
    o[d0]=__builtin_amdgcn_mfma_f32_32x32x16_bf16(pa2,PK(2),o[d0],0,0,0);
    o[d0]=__builtin_amdgcn_mfma_f32_32x32x16_bf16(pa3,PK(3),o[d0],0,0,0);
    #undef PK
  }
}

#ifndef ATTN_STORE16
#define ATTN_STORE16(p,v) (*(u32x4*)(p)=(v))
#endif
template<int THRL> __device__ __forceinline__ void attn_unit(int qb,const bf16*Q,const bf16*__restrict__ Kh,const bf16*__restrict__ Vh,bf16*O,char*shm,int wave_id){
  int tid_=mk_tid(wave_id); const int tid=tid_,lane=tid&63,r32=lane&31,hi=lane>>5; const int wid=__builtin_amdgcn_readfirstlane(tid>>6);
  const int q0=qb*QB;
  const bf16*Qw=Q+(long)(q0+wid*QBLK)*PQ;
  const unsigned lds0=(unsigned)(uintptr_t)shm;
  float*wsf=(float*)(shm+LDS_WS)+wid*64;
  const bf16*ksrc=Kh+(long)lane*PK+wid*8;
  const bf16*vsrc=Vh+(long)(16*(wid&3)+(lane>>2))*PV+(wid>>2)*32+(lane&3)*8;
  const unsigned kdst=lds0+LDS_K+wid*1024, vdst=lds0+LDS_V+wid*1024;
  #define DMA_K(t,slot) glds16(ksrc+(long)(t)*KVBLK*PK,(unsigned)__builtin_amdgcn_readfirstlane(kdst+(slot)))
  #define DMA_V(t,slot) do{ glds16(vsrc+(long)(t)*KVBLK*PV,(unsigned)__builtin_amdgcn_readfirstlane(vdst+2*(slot))); glds16(vsrc+(long)(t)*KVBLK*PV+64,(unsigned)__builtin_amdgcn_readfirstlane(vdst+2*(slot)+SLOTB)); }while(0)
  const int vb0=(int)(lds0+LDS_V)+((lane>>4)&1)*32+(lane&3)*8+(4*hi+((lane&15)>>2))*64;
  const char*Kbase=shm+LDS_K; bf16x8 kf[8];
  const lds_cptr shm3=(lds_cptr)shm; const lds_cptr kp0=shm3+LDS_K+hi*1024+r32*16; const lds_cptr vp0=shm3+LDS_V+((lane>>4)&1)*32+(lane&3)*8+(4*hi+((lane&15)>>2))*64;
  const int NT=(q0+QB)/KVBLK;
  DMA_K(0,0);DMA_V(0,0);DMA_K(1,SLOTB);
  bf16x8 qr[4];
  #pragma unroll
  for(int d0=0;d0<4;++d0)qr[d0]=*reinterpret_cast<const bf16x8*>(&Qw[(long)r32*PQ+d0*16+hi*8]);
  float l_reg=0.f;f32x16 o[4];     o[0]=f32x16{};o[1]=f32x16{};o[2]=f32x16{};o[3]=f32x16{};f32x16 negm=f32x16{};asm volatile("":"+v"(negm));
  const int qrel=wid*QBLK+r32;
  #define CMASK(P0,P1,t) do{int jb_=(t)-(NT-4); if(jb_>=0)cmask(P0,P1,jb_,qrel,hi);}while(0)
  bool resc=false;
  #define START(P0,P1) do{ const float rm=rowmax(P0,P1); resc=false; \
    { const float dl=rm; const float nm_=-dl; \
      _Pragma("unroll") for(int r=0;r<16;++r){P0[r]=fsub_s(P0[r],dl);P1[r]=fsub_s(P1[r],dl);} \
      _Pragma("unroll") for(int r=0;r<16;++r)negm[r]=nm_; asm volatile("":"+v"(negm)); } \
    _Pragma("unroll") for(int r=0;r<16;++r)P0[r]=__builtin_amdgcn_exp2f(P0[r]); }while(0)
  #define RESC() do{ if(resc){ asm volatile("s_waitcnt lgkmcnt(0)":::"memory"); \
      _Pragma("unroll") for(int d_=0;d_<4;++d_) _Pragma("unroll") for(int r=0;r<16;++r)o[d_][r]*=wsf[crow(r,hi)]; } }while(0)
  f32x16 pA0,pA1,pB0,pB1;
  int sl_prev=0,sl_cur=0,sl_next=SLOTB;
  #define ROT() do{sl_prev=sl_cur;sl_cur=sl_next;sl_next=(sl_next==(NSLOT-1)*SLOTB)?0:sl_next+SLOTB;}while(0)
  DMA_K(2,2*SLOTB);
  WAIT_BAR(3);
  qkt(pA0,pA1,Kbase,qr,negm,r32,hi);asm volatile("s_nop 15\n\ts_nop 7":"+v"(pA0),"+v"(pA1));CMASK(pA0,pA1,0);
  START(pA0,pA1);
  _Pragma("unroll") for(int r=0;r<16;++r)pA1[r]=__builtin_amdgcn_exp2f(pA1[r]);
  WAIT_BAR(0);
  DMA_K(3,0);DMA_V(1,SLOTB);
  ROT();
  kload8(kf,kp0+sl_cur);
  WAIT_BAR(3);
  s16x4 vlo[8],vhi[8]; u32x4 pw0,pw1,pw2,pw3;
  #define PKW(P,B) cvtpk_s(P[B],P[B+1])
  #define PAF(k) __builtin_bit_cast(bf16x8,pw##k)
  #define VFR(i) (bf16x8){vlo[i][0],vlo[i][1],vlo[i][2],vlo[i][3],vhi[i][0],vhi[i][1],vhi[i][2],vhi[i][3]}
  #define PIN(x) asm volatile("":"+v"(x))
  #define MX3(a,b,c) __builtin_fmaxf(__builtin_fmaxf((a),(b)),(c))
  #define GAPA(MF,A0,A1,A2,A3,W0,W1,PW) do{ MF; sacc+=A0; sacc+=A1; sacc+=A2; sacc+=A3; PIN(sacc); W0; W1; PIN(PW); SBAR(); }while(0)
  #define EX(v) __builtin_amdgcn_exp2f(v)
  #define GAPB(MF,X,B) do{ MF; X[B]=EX(X[B]); X[B+1]=EX(X[B+1]); X[B+2]=EX(X[B+2]); X[B+3]=EX(X[B+3]); PIN(X); SBAR(); }while(0)
  #define VRD(i) do{ vlo[i]=vtr(vp_+(((i)>>2)*4096+((i)&3)*1024)); vhi[i]=vtr(vp_+(((i)>>2)*4096+((i)&3)*1024+512)); }while(0)
  #define VRD2(i) do{ wlo[i]=vtr(vp_+(8192+((i)>>2)*4096+((i)&3)*1024)); whi[i]=vtr(vp_+(8192+((i)>>2)*4096+((i)&3)*1024+512)); }while(0)
  #define WFR(i) (bf16x8){wlo[i][0],wlo[i][1],wlo[i][2],wlo[i][3],whi[i][0],whi[i][1],whi[i][2],whi[i][3]}
  #define KRD(G,j) do{ if(G){ kload2(kf,kp0+sl_next,j); SBAR(); } }while(0)
  #define STEP(C0,C1,P0,P1,t,GK,GV,GL) do{ SBAR(); \
    const lds_cptr vp_=vp0+2*sl_prev; \
    float sacc=(P0[0]+P0[1]); \
    GAPA(C0=__builtin_amdgcn_mfma_f32_32x32x16_bf16(kf[0],qr[0],negm,0,0,0), P0[2],P0[3],P0[4],P0[5],     pw0[0]=PKW(P0,0), pw0[1]=PKW(P0,2), pw0); \
    GAPA(C1=__builtin_amdgcn_mfma_f32_32x32x16_bf16(kf[1],qr[0],negm,0,0,0), P0[6],P0[7],P0[8],P0[9],     pw0[2]=PKW(P0,4), pw0[3]=PKW(P0,6), pw0); \
    GAPA(C0=__builtin_amdgcn_mfma_f32_32x32x16_bf16(kf[2],qr[1],C0,0,0,0),   P0[10],P0[11],P0[12],P0[13], pw1[0]=PKW(P0,8), pw1[1]=PKW(P0,10), pw1); \
    GAPA(C1=__builtin_amdgcn_mfma_f32_32x32x16_bf16(kf[3],qr[1],C1,0,0,0),   P0[14],P0[15],P1[0],P1[1],   pw1[2]=PKW(P0,12),pw1[3]=PKW(P0,14), pw1); \
    GAPA(C0=__builtin_amdgcn_mfma_f32_32x32x16_bf16(kf[4],qr[2],C0,0,0,0),   P1[2],P1[3],P1[4],P1[5],     pw2[0]=PKW(P1,0), pw2[1]=PKW(P1,2), pw2); \
    GAPA(C1=__builtin_amdgcn_mfma_f32_32x32x16_bf16(kf[5],qr[2],C1,0,0,0),   P1[6],P1[7],P1[8],P1[9],     pw2[2]=PKW(P1,4), pw2[3]=PKW(P1,6), pw2); \
    GAPA(C0=__builtin_amdgcn_mfma_f32_32x32x16_bf16(kf[6],qr[3],C0,0,0,0),   P1[10],P1[11],P1[12],P1[13], pw3[0]=PKW(P1,8), pw3[1]=PKW(P1,10), pw3); \
    GAPA(C1=__builtin_amdgcn_mfma_f32_32x32x16_bf16(kf[7],qr[3],C1,0,0,0),   P1[14],P1[15],0.f,0.f,       pw3[2]=PKW(P1,12),pw3[3]=PKW(P1,14), pw3); \
    l_reg+=sacc; \
    if(GK){DMA_K((t)+3,sl_cur);} if(GV){DMA_V((t)+1,sl_next);} \
    SBAR(); VRD(0); VRD(4); VRD(1); VRD(5); SBAR(); \
    CMASK(C0,C1,t); \
    { float a=MX3(C0[0],C0[1],C1[0]),b=MX3(C0[2],C0[3],C1[1]); a=MX3(a,C1[2],C1[3]); \
      _Pragma("unroll") for(int r=4;r<16;r+=4){a=MX3(a,C0[r],C0[r+1]);b=MX3(b,C0[r+2],C0[r+3]);a=MX3(a,C1[r],C1[r+1]);b=MX3(b,C1[r+2],C1[r+3]);} \
      float rm=__builtin_fmaxf(a,b); { auto rr=__builtin_amdgcn_permlane32_swap(__float_as_uint(rm),__float_as_uint(rm),false,false); rm=__builtin_fmaxf(__uint_as_float(rr[0]),__uint_as_float(rr[1])); } \
      resc=false; \
      if(__builtin_expect(__any(rm>(float)THRL),0)){ const float dl=__builtin_fmaxf(rm,0.f); const float nm_=negm[0]-dl; \
        _Pragma("unroll") for(int r=0;r<16;++r){C0[r]-=dl;C1[r]-=dl;} \
        _Pragma("unroll") for(int r=0;r<16;++r)negm[r]=nm_; asm volatile("":"+v"(negm)); \
        const float f=__builtin_amdgcn_exp2f(-dl); l_reg*=f; { int r32_=lane; asm volatile("":"+v"(r32_)); if(r32_<32)wsf[r32_]=f; } resc=true; } } \
    SBAR(); \
    VRD(2); SBAR(); GAPB(o[0]=__builtin_amdgcn_mfma_f32_32x32x16_bf16(PAF(0),VFR(0),o[0],0,0,0), C0,0); \
    VRD(6); SBAR(); GAPB(o[1]=__builtin_amdgcn_mfma_f32_32x32x16_bf16(PAF(0),VFR(4),o[1],0,0,0), C0,4); \
    VRD(3); SBAR(); KRD(GL,0); GAPB(o[0]=__builtin_amdgcn_mfma_f32_32x32x16_bf16(PAF(1),VFR(1),o[0],0,0,0), C0,8); \
    VRD(7); SBAR(); KRD(GL,1); GAPB(o[1]=__builtin_amdgcn_mfma_f32_32x32x16_bf16(PAF(1),VFR(5),o[1],0,0,0), C0,12); \
    KRD(GL,2); GAPB(o[0]=__builtin_amdgcn_mfma_f32_32x32x16_bf16(PAF(2),VFR(2),o[0],0,0,0), C1,0); \
    KRD(GL,3); GAPB(o[1]=__builtin_amdgcn_mfma_f32_32x32x16_bf16(PAF(2),VFR(6),o[1],0,0,0), C1,4); \
    s16x4 wlo[8],whi[8]; \
    GAPB(o[0]=__builtin_amdgcn_mfma_f32_32x32x16_bf16(PAF(3),VFR(3),o[0],0,0,0), C1,8); \
    GAPB(o[1]=__builtin_amdgcn_mfma_f32_32x32x16_bf16(PAF(3),VFR(7),o[1],0,0,0), C1,12); \
    VRD2(0); VRD2(4); VRD2(1); SBAR(); o[2]=__builtin_amdgcn_mfma_f32_32x32x16_bf16(PAF(0),WFR(0),o[2],0,0,0); SBAR(); \
    VRD2(5); SBAR(); o[3]=__builtin_amdgcn_mfma_f32_32x32x16_bf16(PAF(0),WFR(4),o[3],0,0,0); SBAR(); \
    VRD2(2); SBAR(); o[2]=__builtin_amdgcn_mfma_f32_32x32x16_bf16(PAF(1),WFR(1),o[2],0,0,0); SBAR(); \
    VRD2(6); SBAR(); o[3]=__builtin_amdgcn_mfma_f32_32x32x16_bf16(PAF(1),WFR(5),o[3],0,0,0); SBAR(); \
    VRD2(3); SBAR(); o[2]=__builtin_amdgcn_mfma_f32_32x32x16_bf16(PAF(2),WFR(2),o[2],0,0,0); SBAR(); \
    VRD2(7); SBAR(); o[3]=__builtin_amdgcn_mfma_f32_32x32x16_bf16(PAF(2),WFR(6),o[3],0,0,0); SBAR(); \
    o[2]=__builtin_amdgcn_mfma_f32_32x32x16_bf16(PAF(3),WFR(3),o[2],0,0,0); SBAR(); \
    o[3]=__builtin_amdgcn_mfma_f32_32x32x16_bf16(PAF(3),WFR(7),o[3],0,0,0); SBAR(); \
    }while(0)
  int t=1;
  #undef CMASK
  #define CMASK(P0,P1,t) do{}while(0)
  for(;t+5<NT;t+=2){
    STEP(pB0,pB1,pA0,pA1,t,true,true,true);     WAIT_BAR(3); RESC(); ROT();
    STEP(pA0,pA1,pB0,pB1,t+1,true,true,true);   WAIT_BAR(3); RESC(); ROT();
  }
  #undef CMASK
  #define CMASK(P0,P1,t) do{int jb_=(t)-(NT-4); if(jb_>=0)cmask(P0,P1,jb_,qrel,hi);}while(0)
  #define ENDW(tt) do{ if((tt)+3<NT){WAIT_BAR(3);} else if((tt)+2<NT){WAIT_BAR(2);} else {WAIT_BAR(0);} }while(0)
  for(;t+1<NT;t+=2){
    STEP(pB0,pB1,pA0,pA1,t,(t+3<NT),(t+1<NT),(t+1<NT));       ENDW(t);   RESC(); ROT();
    STEP(pA0,pA1,pB0,pB1,t+1,(t+4<NT),(t+2<NT),(t+2<NT));     ENDW(t+1); RESC(); ROT();
  }
  STEP(pB0,pB1,pA0,pA1,NT-1,false,false,false); RESC();
  { float sacc=pB0[0]+pB0[1]; _Pragma("unroll") for(int r=2;r<16;++r)sacc+=pB0[r]; _Pragma("unroll") for(int r=0;r<16;++r)sacc+=pB1[r]; l_reg+=sacc;
    pw0=(u32x4){PKW(pB0,0),PKW(pB0,2),PKW(pB0,4),PKW(pB0,6)};pw1=(u32x4){PKW(pB0,8),PKW(pB0,10),PKW(pB0,12),PKW(pB0,14)};pw2=(u32x4){PKW(pB1,0),PKW(pB1,2),PKW(pB1,4),PKW(pB1,6)};pw3=(u32x4){PKW(pB1,8),PKW(pB1,10),PKW(pB1,12),PKW(pB1,14)};
    SBAR(); pv(o,vb0+2*sl_cur,PAF(0),PAF(1),PAF(2),PAF(3)); }
  #undef PKW
  #undef PAF
  #undef VFR
  #undef PIN
  #undef MX3
  #undef GAPA
  #undef GAPB
  #undef EX
  #undef VRD
  #undef VRD2
  #undef WFR
  #undef KRD
  #undef STEP
  #undef ENDW
  {auto rr=__builtin_amdgcn_permlane32_swap(__float_as_uint(l_reg),__float_as_uint(l_reg),false,false);l_reg=__uint_as_float(rr[0])+__uint_as_float(rr[1]);}
  if(hi==0)wsf[32+r32]=l_reg;asm volatile("s_waitcnt lgkmcnt(0)":::"memory");
  float rli[16];
  #pragma unroll
  for(int r=0;r<16;++r)rli[r]=__builtin_amdgcn_rcpf(wsf[32+crow(r,hi)]);
  bf16*Ow=O+(long)(q0+wid*QBLK)*PO;
  { bf16*stg=(bf16*)(shm+LDS_OST)+wid*4096;
    #pragma unroll
    for(int r=0;r<16;++r){const int orow=crow(r,hi);
      #pragma unroll
      for(int d0=0;d0<4;++d0)stg[orow*128+d0*32+r32]=__float2bfloat16(o[d0][r]*rli[r]);}
    asm volatile("s_waitcnt lgkmcnt(0)":::"memory");
    #pragma unroll
    for(int i=0;i<8;++i){const int row=i*4+(lane>>4),ch=lane&15; const u32x4 v=*(const u32x4*)(stg+row*128+ch*8); ATTN_STORE16(Ow+(long)row*PO+ch*8,v);} }
  asm volatile("s_waitcnt lgkmcnt(0)\n\ts_barrier":::"memory");
  #undef DMA_K
  #undef DMA_V
  #undef CMASK
  #undef START
  #undef RESC
  #undef ROT
}
constexpr int ATTN_LDS_BYTES=LDS_BYTES;
#undef SBAR
#undef WAIT_BAR
}
namespace cg = cooperative_groups;
#define GAS __attribute__((address_space(1)))
#define LAS __attribute__((address_space(3)))
typedef unsigned short bf16;
typedef unsigned v4u __attribute__((ext_vector_type(4)));
typedef unsigned v2u __attribute__((ext_vector_type(2)));
typedef float f32x4 __attribute__((ext_vector_type(4)));
typedef short bf16x8 __attribute__((ext_vector_type(8)));
typedef short s16x4 __attribute__((ext_vector_type(4)));

#ifndef MK_ONE_LAUNCH
#define MK_ONE_LAUNCH 1
#endif
constexpr int NWAVES = 8;
constexpr int SEQ = 16384, DM = 1024, NIN = 8704, NMAIN = 5632, NGATE = 3072, DEPTH = 2;
constexpr float EPS = 1e-6f;
constexpr float QSCALE = 0.125f * 1.4426950408889634f;
constexpr size_t MiB = 1u << 20;
constexpr size_t WS_ROPE = 0;
constexpr size_t WS_WIN = 1 * MiB;
constexpr size_t WS_WB = 18 * MiB;
constexpr size_t WS_WO = 21 * MiB;
constexpr size_t WS_HB = 23 * MiB;
constexpr size_t WS_O = 55 * MiB;
constexpr size_t WS_PJ = 87 * MiB;
constexpr size_t SLOT_ELEMS = (size_t)SEQ * 512;
constexpr int YP = 1536;
constexpr size_t WS_BAR = WS_PJ + 11 * SLOT_ELEMS * 2;
constexpr size_t WS_END = WS_BAR + 65536;
enum { SL_AQ = 0, SL_AK = 1, SL_AV = 2, SL_BU = 3, SL_BV = 4, SL_CQ = 5, SL_CK = 6, SL_CV = 7, SL_AZ = 8, SL_BZ = 9, SL_CZ = 10 };

constexpr int LDS_BYTES = 147456;

__device__ __forceinline__ unsigned f2bf(float f) { unsigned u = __builtin_bit_cast(unsigned, f); return (u + 0x7fffu + ((u >> 16) & 1u)) >> 16; }
typedef float f32x2_t __attribute__((ext_vector_type(2))); typedef __bf16 bf16x2_t __attribute__((ext_vector_type(2)));
__device__ __forceinline__ unsigned pk2(float lo, float hi) { f32x2_t v = {lo, hi}; bf16x2_t b = __builtin_convertvector(v, bf16x2_t); return __builtin_bit_cast(unsigned, b); }
__device__ __forceinline__ float bflo(unsigned w) { return __uint_as_float(w << 16); }
__device__ __forceinline__ float bfhi(unsigned w) { return __uint_as_float(w & 0xffff0000u); }
__device__ __forceinline__ float fexp2(float x) { return __builtin_amdgcn_exp2f(x); }
__device__ __forceinline__ float frcp(float x) { return __builtin_amdgcn_rcpf(x); }
__device__ __forceinline__ float sigmoid_f(float x) { return frcp(1.f + fexp2(-1.4426950408889634f * x)); }
__device__ __forceinline__ float silu_f(float x) { return x * sigmoid_f(x); }
__device__ __forceinline__ float gelu_tanh_f(float x) { const float y = 0.7978845608028654f * (x + 0.044715f * x * x * x); return x * frcp(1.f + fexp2(-2.885390081777927f * y)); }
__device__ __forceinline__ float wave_sum(float v) {
#pragma unroll
    for (int o = 1; o < 64; o <<= 1) v += __shfl_xor(v, o);
    return v;
}

struct EpiProj {
    static constexpr bool PERM = true, AFTER_DRAIN = false;
    bf16* PJ; const float* rc; const float* rs;
    __device__ __forceinline__ void operator()(const f32x4 (&acc)[2][2][4][2], const pg8::Unit& u, int wr, int wc, int fr_, int fq_) const {
        int fr = fr_, fq = fq_; asm volatile("" : "+v"(fr), "+v"(fq));
        const int grp = u.pn >> 1;
        const int slot = (int)((0xA7659438210ull >> (4 * grp)) & 15ull);
        const int act = (int)((0x10341221034ull >> (4 * grp)) & 15ull);
        const bool isy = (act == 1); const int pitch = isy ? YP : 512;
        bf16* base = isy ? PJ + (size_t)SL_AZ * SLOT_ELEMS + (grp == 3 ? 0 : (grp == 6 ? 512 : 1024)) : PJ + (size_t)slot * SLOT_ELEMS;
        const int row0 = u.pm * 256 + wr * 64 + fr, col0 = (u.pn & 1) * 256 + wc * 32 + 8 * fq;
        const bool ropew = (act >= 3) && ((wc & 1) == 0);
        const float sgn = (fq == 0) ? -1.f : 1.f; const bool ropel = fq < 2;
        const float qs = (act == 4) ? QSCALE : 1.f;
#pragma unroll
        for (int ai = 0; ai < 2; ++ai) {
            f32x4 Cc[4][2], Ss[4][2];
            if (ropew) {
#pragma unroll
                for (int m = 0; m < 4; ++m) { const int row = row0 + ai * 128 + m * 16;
                    Cc[m][0] = *(const f32x4*)(rc + row * 8); Cc[m][1] = *(const f32x4*)(rc + row * 8 + 4); Ss[m][0] = *(const f32x4*)(rs + row * 8); Ss[m][1] = *(const f32x4*)(rs + row * 8 + 4); }
                __builtin_amdgcn_sched_barrier(0);
            }
#pragma unroll
            for (int m = 0; m < 4; ++m) {
                const int row = row0 + ai * 128 + m * 16;
#pragma unroll
                for (int bj = 0; bj < 2; ++bj) {
                    f32x4 v0 = acc[ai][bj][m][0], v1 = acc[ai][bj][m][1];
                    if (ropew) {
                        f32x4 o0, o1;
#pragma unroll
                        for (int e = 0; e < 4; ++e) { o0[e] = __shfl_xor(v0[e], 16); o1[e] = __shfl_xor(v1[e], 16); }
                        if (ropel) { v0 = v0 * Cc[m][0] + sgn * (o0 * Ss[m][0]); v1 = v1 * Cc[m][1] + sgn * (o1 * Ss[m][1]); }
                    }
                    if (act == 1) {
#pragma unroll
                        for (int e = 0; e < 4; ++e) { v0[e] = silu_f(v0[e]); v1[e] = silu_f(v1[e]); }
                    } else if (act == 2) {
#pragma unroll
                        for (int e = 0; e < 4; ++e) { v0[e] = gelu_tanh_f(v0[e]); v1[e] = gelu_tanh_f(v1[e]); }
                    }
                    v0 = v0 * qs; v1 = v1 * qs;
                    v4u w; w.x = pk2(v0[0], v0[1]); w.y = pk2(v0[2], v0[3]); w.z = pk2(v1[0], v1[1]); w.w = pk2(v1[2], v1[3]);
                    *(v4u*)(base + (size_t)row * pitch + col0 + bj * 128) = w;
                }
            }
            asm volatile("" ::: "memory");
        }
    }
};
struct EpiGate {
    static constexpr bool PERM = true, AFTER_DRAIN = false;
    bf16* GL;
    __device__ __forceinline__ void operator()(const f32x4 (&acc)[2][2][4][2], const pg8::Unit& u, int wr, int wc, int fr_, int fq_) const {
        int fr = fr_, fq = fq_; asm volatile("" : "+v"(fr), "+v"(fq));
        const int row0 = u.pm * 256 + wr * 64 + fr, col0 = u.pn * 256 + wc * 32 + 8 * fq;
#pragma unroll
        for (int ai = 0; ai < 2; ++ai)
#pragma unroll
            for (int m = 0; m < 4; ++m) {
                const int row = row0 + ai * 128 + m * 16;
#pragma unroll
                for (int bj = 0; bj < 2; ++bj) {
                    f32x4 v0 = acc[ai][bj][m][0], v1 = acc[ai][bj][m][1];
#pragma unroll
                    for (int e = 0; e < 4; ++e) { v0[e] = sigmoid_f(v0[e]); v1[e] = sigmoid_f(v1[e]); }
                    v4u w; w.x = pk2(v0[0], v0[1]); w.y = pk2(v0[2], v0[3]); w.z = pk2(v1[0], v1[1]); w.w = pk2(v1[2], v1[3]);
                    *(v4u*)(GL + (size_t)row * NGATE + col0 + bj * 128) = w; asm volatile("" ::: "memory");
                }
            }
    }
};
__device__ __forceinline__ float gclamp(float g) { return fmaxf(g, 1e-6f); }
struct MergeHook {
    static constexpr int PERIOD = 8;
    const bf16* GL;
    __device__ __forceinline__ void operator()(f32x4 (&acc)[2][2][4][2], const pg8::Unit& u, int seg, int wr, int wc, int fr_, int fq_) const {
        int fr = fr_, fq = fq_; asm volatile("" : "+v"(fr), "+v"(fq));
        const int row0 = u.pm * 256 + wr * 64 + fr, col0 = u.pn * 256 + wc * 32 + 8 * fq;
        const bf16* gn = GL + (seg - 1) * 1024 + col0; const bf16* gd = GL + seg * 1024 + col0; const bool cl = seg > 1;
#pragma unroll
        for (int ai = 0; ai < 2; ++ai) {
            v4u A[4][2], B[4][2];
#pragma unroll
            for (int m = 0; m < 4; ++m)
#pragma unroll
                for (int bj = 0; bj < 2; ++bj) { const size_t ro = (size_t)(row0 + ai * 128 + m * 16) * NGATE + bj * 128; A[m][bj] = *(const v4u*)(gn + ro); B[m][bj] = *(const v4u*)(gd + ro); }
            __builtin_amdgcn_sched_barrier(0);
#pragma unroll
            for (int m = 0; m < 4; ++m)
#pragma unroll
                for (int bj = 0; bj < 2; ++bj) {
                    const v4u a = A[m][bj], b = B[m][bj];
                    float n_[8] = {bflo(a.x), bfhi(a.x), bflo(a.y), bfhi(a.y), bflo(a.z), bfhi(a.z), bflo(a.w), bfhi(a.w)};
                    float d_[8] = {bflo(b.x), bfhi(b.x), bflo(b.y), bfhi(b.y), bflo(b.z), bfhi(b.z), bflo(b.w), bfhi(b.w)};
#pragma unroll
                    for (int e = 0; e < 8; ++e) { const float nn = cl ? gclamp(n_[e]) : n_[e]; const float rr = nn * frcp(gclamp(d_[e])); if (e < 4) acc[ai][bj][m][0][e] *= rr; else acc[ai][bj][m][1][e - 4] *= rr; }
                }
            asm volatile("" ::: "memory");
        }
    }
};
struct EpiMerge {
    static constexpr bool PERM = true, AFTER_DRAIN = false;
    const bf16* GL; bf16* MG;
    __device__ __forceinline__ void operator()(const f32x4 (&acc)[2][2][4][2], const pg8::Unit& u, int wr, int wc, int fr_, int fq_) const {
        int fr = fr_, fq = fq_; asm volatile("" : "+v"(fr), "+v"(fq));
        const int row0 = u.pm * 256 + wr * 64 + fr, col0 = u.pn * 256 + wc * 32 + 8 * fq;
#pragma unroll
        for (int ai = 0; ai < 2; ++ai) {
            v4u Gt[4][2];
#pragma unroll
            for (int m = 0; m < 4; ++m)
#pragma unroll
                for (int bj = 0; bj < 2; ++bj) Gt[m][bj] = *(const v4u*)(GL + (size_t)(row0 + ai * 128 + m * 16) * NGATE + 2 * 1024 + col0 + bj * 128);
            __builtin_amdgcn_sched_barrier(0);
#pragma unroll
            for (int m = 0; m < 4; ++m)
#pragma unroll
                for (int bj = 0; bj < 2; ++bj) {
                    const int row = row0 + ai * 128 + m * 16; const v4u g = Gt[m][bj];
                    f32x4 v0 = acc[ai][bj][m][0], v1 = acc[ai][bj][m][1];
                    v0[0] *= gclamp(bflo(g.x)); v0[1] *= gclamp(bfhi(g.x)); v0[2] *= gclamp(bflo(g.y)); v0[3] *= gclamp(bfhi(g.y));
                    v1[0] *= gclamp(bflo(g.z)); v1[1] *= gclamp(bfhi(g.z)); v1[2] *= gclamp(bflo(g.w)); v1[3] *= gclamp(bfhi(g.w));
                    v4u w; w.x = pk2(v0[0], v0[1]); w.y = pk2(v0[2], v0[3]); w.z = pk2(v1[0], v1[1]); w.w = pk2(v1[2], v1[3]);
                    *(v4u*)(MG + (size_t)row * DM + col0 + bj * 128) = w;
                }
            asm volatile("" ::: "memory");
        }
    }
};
struct EpiOut {
    static constexpr bool PERM = true, AFTER_DRAIN = false;
    const float* res; float* out;
    __device__ __forceinline__ void operator()(const f32x4 (&acc)[2][2][4][2], const pg8::Unit& u, int wr, int wc, int fr_, int fq_) const {
        int fr = fr_, fq = fq_; asm volatile("" : "+v"(fr), "+v"(fq));
        const int row0 = u.pm * 256 + wr * 64 + fr, col0 = u.pn * 256 + wc * 32 + 8 * fq;
#pragma unroll
        for (int ai = 0; ai < 2; ++ai) {
            f32x4 R[4][2][2];
#pragma unroll
            for (int m = 0; m < 4; ++m)
#pragma unroll
                for (int bj = 0; bj < 2; ++bj) { const size_t off = (size_t)(row0 + ai * 128 + m * 16) * DM + col0 + bj * 128; R[m][bj][0] = *(const f32x4*)(res + off); R[m][bj][1] = *(const f32x4*)(res + off + 4); }
            __builtin_amdgcn_sched_barrier(0);
#pragma unroll
            for (int m = 0; m < 4; ++m)
#pragma unroll
                for (int bj = 0; bj < 2; ++bj) { const size_t off = (size_t)(row0 + ai * 128 + m * 16) * DM + col0 + bj * 128;
                    *(f32x4*)(out + off) = R[m][bj][0] + acc[ai][bj][m][0]; *(f32x4*)(out + off + 4) = R[m][bj][1] + acc[ai][bj][m][1]; }
            asm volatile("" ::: "memory");
        }
    }
};

__device__ __forceinline__ void p0_transpose_item(const float* W, int K, int N, bf16* WT, int ldk, LAS float* scr, int item, int lane) {
    const int nblk = N / 32, kb = item / nblk, nb = item % nblk, k0 = 64 * kb, n0 = 32 * nb;
#pragma unroll 8
    for (int i = 0; i < 32; ++i) { const int kk = 2 * i + (lane >> 5); scr[kk * 33 + (lane & 31)] = W[(size_t)(k0 + kk) * N + n0 + (lane & 31)]; }
    asm volatile("s_waitcnt lgkmcnt(0)" ::: "memory");
    const int c = lane & 7;
#pragma unroll
    for (int j = 0; j < 4; ++j) { const int n = (lane >> 3) + 8 * j; const LAS float* s = scr + (8 * c) * 33 + n;
        v4u o; o.x = pk2(s[0 * 33], s[1 * 33]); o.y = pk2(s[2 * 33], s[3 * 33]); o.z = pk2(s[4 * 33], s[5 * 33]); o.w = pk2(s[6 * 33], s[7 * 33]);
        *(v4u*)(WT + (size_t)(n0 + n) * ldk + k0 + 8 * c) = o; }
    asm volatile("s_waitcnt lgkmcnt(0)" ::: "memory");
}
template <int NR, bool OUTBF> __device__ __forceinline__ void rms_rows(const float* x, size_t rstride, const float* g, void* o, int lane) {
    f32x4 v[NR][4]; float r[NR];
#pragma unroll
    for (int k = 0; k < NR; ++k)
#pragma unroll
        for (int j = 0; j < 4; ++j) v[k][j] = ((const f32x4*)(x + k * rstride) + lane)[64 * j];
#pragma unroll
    for (int k = 0; k < NR; ++k) { float s = 0.f;
#pragma unroll
        for (int j = 0; j < 4; ++j) s += (v[k][j].x * v[k][j].x + v[k][j].y * v[k][j].y) + (v[k][j].z * v[k][j].z + v[k][j].w * v[k][j].w);
        r[k] = 1.f / sqrtf(wave_sum(s) * (1.f / DM) + EPS); }
    const f32x4* gr = (const f32x4*)g + lane;
#pragma unroll
    for (int j = 0; j < 4; ++j) { const f32x4 gg = gr[64 * j];
#pragma unroll
        for (int k = 0; k < NR; ++k) { const f32x4 y = v[k][j] * r[k] * gg;
            if (OUTBF) ((unsigned long long*)((bf16*)o + k * rstride) + lane)[64 * j] = (unsigned long long)pk2(y.x, y.y) | ((unsigned long long)pk2(y.z, y.w) << 32);
            else ((f32x4*)((float*)o + k * rstride) + lane)[64 * j] = y; } }
}
constexpr int SGU_P = 136;
__device__ __forceinline__ void sgu_item(int item, const bf16* BU, const bf16* BV, bf16* BZ, const float* lng, const float* lnb, const float* sw, const float* sb,
                                         LAS unsigned char* lds, int tid, int wid, int lane) {
    const int n = item >> 2, g = item & 3, tok0 = n * 128;
    LAS bf16* Wl = (LAS bf16*)lds; LAS bf16* Vt = (LAS bf16*)(lds + 128 * SGU_P * 2); LAS float* st = (LAS float*)(lds + 2 * 128 * SGU_P * 2);
    const int r = lane & 15, q = lane >> 4, t = wid * 16 + r;
    v4u w16[16];
#pragma unroll
    for (int i = 0; i < 16; ++i) w16[i] = *(const v4u*)(BV + (size_t)(tok0 + wid * 16 + i) * 512 + lane * 8);
    v4u vst[4]; f32x4 G0[4], G1[4], B0[4], B1[4];
#pragma unroll
    for (int k = 0; k < 4; ++k) { const int idx = tid + 512 * k, s_ = idx >> 4, cch = idx & 15;
        vst[k] = *(const v4u*)(BV + (size_t)(tok0 + s_) * 512 + g * 128 + cch * 8);
        G0[k] = *(const f32x4*)(lng + g * 128 + cch * 8); G1[k] = *(const f32x4*)(lng + g * 128 + cch * 8 + 4); B0[k] = *(const f32x4*)(lnb + g * 128 + cch * 8); B1[k] = *(const f32x4*)(lnb + g * 128 + cch * 8 + 4); }
    f32x4 wW[8];
#pragma unroll
    for (int k = 0; k < 8; ++k) { const int idx = tid + 512 * k, tt = idx >> 5, s4 = (idx & 31) * 4; wW[k] = *(const f32x4*)(sw + ((size_t)g * 128 + tt) * 128 + s4); }
    v2u uu[8], zz[8];
#pragma unroll
    for (int ct = 0; ct < 8; ++ct) { uu[ct] = *(const v2u*)(BU + (size_t)(tok0 + t) * 512 + g * 128 + ct * 16 + q * 4); zz[ct] = *(const v2u*)(BZ + (size_t)(tok0 + t) * YP + g * 128 + ct * 16 + q * 4); }
    const float bias = sb[g * 128 + t];
    __builtin_amdgcn_sched_barrier(0);
#pragma unroll
    for (int i = 0; i < 16; ++i) {
        const int s_ = wid * 16 + i; const v4u w = w16[i];
        const float a0 = bflo(w.x), a1 = bfhi(w.x), a2 = bflo(w.y), a3 = bfhi(w.y), a4 = bflo(w.z), a5 = bfhi(w.z), a6 = bflo(w.w), a7 = bfhi(w.w);
        const float mu = wave_sum(((a0 + a1) + (a2 + a3)) + ((a4 + a5) + (a6 + a7))) * (1.f / 512.f);
        const float d0 = a0 - mu, d1 = a1 - mu, d2 = a2 - mu, d3 = a3 - mu, d4 = a4 - mu, d5 = a5 - mu, d6 = a6 - mu, d7 = a7 - mu;
        const float var = wave_sum(((d0 * d0 + d1 * d1) + (d2 * d2 + d3 * d3)) + ((d4 * d4 + d5 * d5) + (d6 * d6 + d7 * d7))) * (1.f / 512.f);
        if (lane == 0) { st[s_] = mu; st[128 + s_] = 1.f / sqrtf(var + EPS); }
    }
    __syncthreads();
#pragma unroll
    for (int k = 0; k < 4; ++k) {
        const int idx = tid + 512 * k, s_ = idx >> 4, cch = idx & 15; const v4u w = vst[k];
        const float mu = st[s_], rstd = st[128 + s_];
        float a[8] = {bflo(w.x), bfhi(w.x), bflo(w.y), bfhi(w.y), bflo(w.z), bfhi(w.z), bflo(w.w), bfhi(w.w)};
#pragma unroll
        for (int e = 0; e < 8; ++e) { const float gg = e < 4 ? G0[k][e & 3] : G1[k][e & 3], bb = e < 4 ? B0[k][e & 3] : B1[k][e & 3]; a[e] = (a[e] - mu) * rstd * gg + bb; }
        v4u o; o.x = pk2(a[0], a[1]); o.y = pk2(a[2], a[3]); o.z = pk2(a[4], a[5]); o.w = pk2(a[6], a[7]);
        *(LAS v4u*)(Vt + s_ * SGU_P + cch * 8) = o;
    }
#pragma unroll
    for (int k = 0; k < 8; ++k) {
        const int idx = tid + 512 * k, tt = idx >> 5, s4 = (idx & 31) * 4; const f32x4 w = wW[k];
        v2u o; o.x = pk2(s4 + 0 <= tt ? w.x : 0.f, s4 + 1 <= tt ? w.y : 0.f); o.y = pk2(s4 + 2 <= tt ? w.z : 0.f, s4 + 3 <= tt ? w.w : 0.f);
        *(LAS v2u*)(Wl + tt * SGU_P + s4) = o;
    }
    __syncthreads();
    typedef short v4i16_t __attribute__((ext_vector_type(4)));
    f32x4 acc[8];
#pragma unroll
    for (int ct = 0; ct < 8; ++ct) acc[ct] = (f32x4){0.f, 0.f, 0.f, 0.f};
#pragma unroll
    for (int ks = 0; ks < 4; ++ks) {
        const bf16x8 wf = *(const LAS bf16x8*)(Wl + (wid * 16 + r) * SGU_P + ks * 32 + q * 8);
#pragma unroll
        for (int ct = 0; ct < 8; ++ct) {
            const LAS bf16* tp = Vt + (ks * 32 + q * 8 + ((r >> 2) & 3)) * SGU_P + ct * 16 + (r & 3) * 4;
            const s16x4 lo = __builtin_bit_cast(s16x4, __builtin_amdgcn_ds_read_tr16_b64_v4i16((LAS v4i16_t*)tp));
            const s16x4 hi = __builtin_bit_cast(s16x4, __builtin_amdgcn_ds_read_tr16_b64_v4i16((LAS v4i16_t*)(tp + 4 * SGU_P)));
            const bf16x8 vf = (bf16x8){lo[0], lo[1], lo[2], lo[3], hi[0], hi[1], hi[2], hi[3]};
            acc[ct] = __builtin_amdgcn_mfma_f32_16x16x32_bf16(vf, wf, acc[ct], 0, 0, 0);
        }
    }
#pragma unroll
    for (int ct = 0; ct < 8; ++ct) {
        const size_t offz = (size_t)(tok0 + t) * YP + g * 128 + ct * 16 + q * 4;
        v2u o; o.x = pk2((acc[ct][0] + bias) * bflo(uu[ct].x) * bflo(zz[ct].x), (acc[ct][1] + bias) * bfhi(uu[ct].x) * bfhi(zz[ct].x));
        o.y = pk2((acc[ct][2] + bias) * bflo(uu[ct].y) * bflo(zz[ct].y), (acc[ct][3] + bias) * bfhi(uu[ct].y) * bfhi(zz[ct].y));
        *(v2u*)(BZ + offz) = o;
    }
    __syncthreads();
}

constexpr int CM_PB = 144, CM_NG = 4, CM_BLK = 128 * CM_NG;
constexpr int CM_S0 = (CM_BLK + 128) / 32, CM_S1 = (512 + CM_BLK - 8 + 4 * 32 - 1) / (4 * 32), CM_S2 = (2048 + CM_BLK - 8 + 8 * 32 - 1) / (8 * 32), CM_NSTEP = CM_S0 + CM_S1 + CM_S2;
struct CmStep { int kbase, sl, window, dmask, kk0; };
__device__ __forceinline__ CmStep cm_step(int j, int T0, int wid) {
    CmStep p;
    if (j < CM_S0) { p.kbase = T0 - 128; p.sl = 0; p.window = 128; p.dmask = 0; p.kk0 = 32 * j; }
    else if (j < CM_S0 + CM_S1) { p.kbase = T0 + wid - 512; p.sl = 2; p.window = 512; p.dmask = 0; p.kk0 = 32 * (j - CM_S0); }
    else { p.kbase = T0 + wid - 2048; p.sl = 3; p.window = 2048; p.dmask = 15; p.kk0 = 32 * (j - CM_S0 - CM_S1); }
    return p;
}
__device__ __forceinline__ void cm_load(int j, int T0, int wid, int h, int r, int q, int vkey, int vch, const bf16* CK, const bf16* CV, bf16x8 (&kf)[4], bf16x8 (&vv)[4]) {
    if (j >= CM_NSTEP) return;
    const CmStep p = cm_step(j, T0, wid);
    int tA = p.kbase + ((p.kk0 + r) << p.sl), tB = p.kbase + ((p.kk0 + 16 + r) << p.sl);
    tA = min(max(tA, 0), SEQ - 1); tB = min(max(tB, 0), SEQ - 1);
    const bf16* pa = CK + (size_t)tA * 512 + h * 64 + q * 8; const bf16* pb = CK + (size_t)tB * 512 + h * 64 + q * 8;
    kf[0] = *(const bf16x8*)pa; kf[1] = *(const bf16x8*)(pa + 32); kf[2] = *(const bf16x8*)pb; kf[3] = *(const bf16x8*)(pb + 32);
#pragma unroll
    for (int c = 0; c < 4; ++c) { int tv = p.kbase + ((p.kk0 + vkey + 8 * c) << p.sl); tv = min(max(tv, 0), SEQ - 1); vv[c] = *(const bf16x8*)(CV + (size_t)tv * 512 + h * 64 + vch * 8); }
}
struct CmQ { bf16x8 qf[2]; float mrun, lpart; f32x4 o[4]; int tq; };
__device__ __forceinline__ void cm_group(const CmStep& p, int r, int q, LAS unsigned char* Vl, const bf16x8 (&kf)[4], CmQ& Q, const s16x4 (&lo)[4], const s16x4 (&hi)[4]) {
    f32x4 sA = (f32x4){0.f, 0.f, 0.f, 0.f}, sB = sA;
    sA = __builtin_amdgcn_mfma_f32_16x16x32_bf16(kf[0], Q.qf[0], sA, 0, 0, 0); sA = __builtin_amdgcn_mfma_f32_16x16x32_bf16(kf[1], Q.qf[1], sA, 0, 0, 0);
    sB = __builtin_amdgcn_mfma_f32_16x16x32_bf16(kf[2], Q.qf[0], sB, 0, 0, 0); sB = __builtin_amdgcn_mfma_f32_16x16x32_bf16(kf[3], Q.qf[1], sB, 0, 0, 0);
    float sv[8]; bool ok[8]; float mx = -1e30f;
#pragma unroll
    for (int jj = 0; jj < 8; ++jj) {
        const int kk = p.kk0 + (jj < 4 ? 0 : 16) + 4 * q + (jj & 3), tk = p.kbase + (kk << p.sl), rel = Q.tq - tk;
        ok[jj] = (rel >= 0) && (rel <= p.window) && (tk >= 0) && ((rel & p.dmask) == 0);
        sv[jj] = ok[jj] ? (jj < 4 ? sA[jj & 3] : sB[jj & 3]) : -1e30f; mx = fmaxf(mx, sv[jj]);
    }
    mx = fmaxf(mx, __shfl_xor(mx, 16)); mx = fmaxf(mx, __shfl_xor(mx, 32));
    const float mnew = fmaxf(Q.mrun, mx), alpha = fexp2(Q.mrun - mnew); Q.mrun = mnew;
    float pp[8], ps = 0.f;
#pragma unroll
    for (int jj = 0; jj < 8; ++jj) { pp[jj] = ok[jj] ? fexp2(sv[jj] - mnew) : 0.f; ps += pp[jj]; }
    Q.lpart = Q.lpart * alpha + ps;
    v4u pw; pw.x = pk2(pp[0], pp[1]); pw.y = pk2(pp[2], pp[3]); pw.z = pk2(pp[4], pp[5]); pw.w = pk2(pp[6], pp[7]);
    const bf16x8 pf = __builtin_bit_cast(bf16x8, pw);
#pragma unroll
    for (int dt = 0; dt < 4; ++dt) {
        const bf16x8 vf = (bf16x8){lo[dt][0], lo[dt][1], lo[dt][2], lo[dt][3], hi[dt][0], hi[dt][1], hi[dt][2], hi[dt][3]};
        Q.o[dt] = Q.o[dt] * alpha;
        Q.o[dt] = __builtin_amdgcn_mfma_f32_16x16x32_bf16(vf, pf, Q.o[dt], 0, 0, 0);
    }
}
__device__ __forceinline__ void cm_compute(int j, int T0, int wid, int r, int q, int vkey, int vch, LAS unsigned char* Vl, const bf16x8 (&kf)[4], const bf16x8 (&vv)[4], CmQ (&Q)[CM_NG]) {
    if (j >= CM_NSTEP) return;
    const CmStep p = cm_step(j, T0, wid);
    const int klo = p.kbase + (p.kk0 << p.sl), khi = p.kbase + ((p.kk0 + 31) << p.sl);
    if (khi < 0) return;
    bool act[CM_NG]; bool any = false;
#pragma unroll
    for (int g = 0; g < CM_NG; ++g) { const int qlo = T0 + 128 * g + wid; act[g] = (khi >= qlo - p.window) && (klo <= qlo + 120); any |= act[g]; }
    if (!any) return;
#pragma unroll
    for (int c = 0; c < 4; ++c) *(LAS bf16x8*)(Vl + (vkey + 8 * c) * CM_PB + vch * 16) = vv[c];
    asm volatile("s_waitcnt lgkmcnt(0)" ::: "memory");
    typedef short v4i16_t __attribute__((ext_vector_type(4)));
    LAS unsigned char* tp = Vl + (4 * q + ((r >> 2) & 3)) * CM_PB + (r & 3) * 8;
    s16x4 lo[4], hi[4];
#pragma unroll
    for (int dt = 0; dt < 4; ++dt) {
        lo[dt] = __builtin_bit_cast(s16x4, __builtin_amdgcn_ds_read_tr16_b64_v4i16((LAS v4i16_t*)(tp + dt * 32)));
        hi[dt] = __builtin_bit_cast(s16x4, __builtin_amdgcn_ds_read_tr16_b64_v4i16((LAS v4i16_t*)(tp + 16 * CM_PB + dt * 32)));
    }
    asm volatile("s_waitcnt lgkmcnt(0)" ::: "memory");
#pragma unroll
    for (int g = 0; g < CM_NG; ++g) if (act[g]) cm_group(p, r, q, Vl, kf, Q[g], lo, hi);
}
__device__ __forceinline__ void cm_init(CmQ& Q, int tq, int h, int q, const bf16* CQ) {
    Q.tq = tq; Q.mrun = -1e30f; Q.lpart = 0.f;
#pragma unroll
    for (int ks = 0; ks < 2; ++ks) Q.qf[ks] = *(const bf16x8*)(CQ + (size_t)tq * 512 + h * 64 + ks * 32 + q * 8);
#pragma unroll
    for (int dt = 0; dt < 4; ++dt) Q.o[dt] = (f32x4){0.f, 0.f, 0.f, 0.f};
}
__device__ __forceinline__ void cm_store(const CmQ& Q, int h, int q, bf16* CZ) {
    float l = Q.lpart; l += __shfl_xor(l, 16); l += __shfl_xor(l, 32);
    const float inv = 1.f / l;
#pragma unroll
    for (int dt = 0; dt < 4; ++dt) {
        const size_t off = (size_t)Q.tq * YP + h * 64 + dt * 16 + 4 * q;
        const v2u zz = *(const v2u*)(CZ + off);
        v2u w; w.x = pk2(Q.o[dt][0] * inv * bflo(zz.x), Q.o[dt][1] * inv * bfhi(zz.x)); w.y = pk2(Q.o[dt][2] * inv * bflo(zz.y), Q.o[dt][3] * inv * bfhi(zz.y));
        *(v2u*)(CZ + off) = w;
    }
}
__device__ __forceinline__ void cmix_item(int tb, int h, const bf16* CQ, const bf16* CK, const bf16* CV, bf16* CZ, LAS unsigned char* ldsw, int wid, int lane) {
    const int r = lane & 15, q = lane >> 4, T0 = tb * CM_BLK;
    CmQ Q[CM_NG];
#pragma unroll
    for (int g = 0; g < CM_NG; ++g) cm_init(Q[g], T0 + 128 * g + wid + 8 * r, h, q, CQ);
    const int vkey = lane >> 3, vch = lane & 7;
    const int j0 = (T0 == 0) ? 3 : 0;
    bf16x8 K0[4], V0[4], K1[4], V1[4];
    cm_load(j0, T0, wid, h, r, q, vkey, vch, CK, CV, K0, V0);
#pragma unroll 1
    for (int j = j0; j < CM_NSTEP; j += 2) {
        cm_load(j + 1, T0, wid, h, r, q, vkey, vch, CK, CV, K1, V1); cm_compute(j, T0, wid, r, q, vkey, vch, ldsw, K0, V0, Q);
        cm_load(j + 2, T0, wid, h, r, q, vkey, vch, CK, CV, K0, V0); cm_compute(j + 1, T0, wid, r, q, vkey, vch, ldsw, K1, V1, Q);
    }
#pragma unroll
    for (int g = 0; g < CM_NG; ++g) cm_store(Q[g], h, q, CZ);
}

#define RLX_AGENT __ATOMIC_RELAXED, __HIP_MEMORY_SCOPE_AGENT
#define XB_TMO      128
#define XB_XCNT(j)  (256  + 64 * (j))
#define XB_XSUB(j)  (1280 + 64 * (j))
#define XB_XGEN(j)  (2304 + 64 * (j))
#define XB_TOP      3328
#define XB_TOPGEN   3392
#define XCD_BAR_WORDS 3456
#define XB_SPIN_CAP (1u << 18)

__device__ __forceinline__ unsigned xb_ld(unsigned* p)              { return __hip_atomic_load(p, __ATOMIC_RELAXED, __HIP_MEMORY_SCOPE_AGENT); }
__device__ __forceinline__ unsigned xb_add(unsigned* p, unsigned v) { return __hip_atomic_fetch_add(p, v, __ATOMIC_RELAXED, __HIP_MEMORY_SCOPE_AGENT); }
__device__ __forceinline__ unsigned xb_xcc_id() { return (unsigned)__builtin_amdgcn_s_getreg((3 << 11) | 20) & 0xFu; }
#define XB_SPIN(cond, bar) do { unsigned _sp = 0; while (cond) { __builtin_amdgcn_s_sleep(1); \
    if ((++_sp & 255u) == 0u) { if (xb_ld(&(bar)[XB_TMO])) break; if (_sp > XB_SPIN_CAP) { atomicAdd(&(bar)[XB_TMO], 1u); break; } } } } while (0)

struct XcdBarrier {
    unsigned* bar; unsigned x; int wave;
    volatile LAS unsigned* st;
};

__device__ __forceinline__ XcdBarrier xcd_barrier_post(unsigned* bar, volatile LAS unsigned* st, int wave) {
    XcdBarrier b; b.bar = bar; b.x = xb_xcc_id(); b.st = st; b.wave = wave;
    if (wave == 0 && mk_lane() == 0) (void)xb_add(&bar[XB_XCNT(b.x)], 1u);
    return b;
}
__device__ __forceinline__ void xcd_barrier_complete(unsigned* bar, unsigned x, unsigned& nloc, unsigned& nx) {
    const unsigned G = gridDim.x * gridDim.y * gridDim.z;
    unsigned sum, cnt, mine, sp = 0u;
    for (;;) {
        sum = 0u; cnt = 0u; mine = 0u;
#pragma unroll
        for (unsigned j = 0; j < 16; ++j) { const unsigned c = xb_ld(&bar[XB_XCNT(j)]); sum += c; cnt += (c > 0u) ? 1u : 0u; mine = (j == x) ? c : mine; }
        if (sum == G) break;
        __builtin_amdgcn_s_sleep(1);
        if ((++sp & 255u) == 0u) { if (xb_ld(&bar[XB_TMO])) break; if (sp > XB_SPIN_CAP) { atomicAdd(&bar[XB_TMO], 1u); break; } }
    }
    nloc = mine > 0u ? mine : 1u; nx = cnt > 0u ? cnt : 1u;
}

__device__ __forceinline__ void xcd_barrier(const XcdBarrier& b) {
    asm volatile("s_waitcnt vmcnt(0)" ::: "memory");
    __syncthreads();
    if (b.wave == 0 && mk_lane() == 0) {
        unsigned* bar = b.bar;
        __builtin_amdgcn_s_waitcnt(0);
        unsigned nloc = b.st[0], nx = b.st[1];
        if (nloc == 0u) { xcd_barrier_complete(bar, b.x, nloc, nx); b.st[0] = nloc; b.st[1] = nx; }
        const unsigned old = xb_add(&bar[XB_XSUB(b.x)], 1u);
        const unsigned gen = old / nloc;
        if (old + 1u == (gen + 1u) * nloc) {
            __builtin_amdgcn_fence(__ATOMIC_RELEASE, "agent");
            asm volatile("s_waitcnt vmcnt(0)" ::: "memory");
            const unsigned og = xb_add(&bar[XB_TOP], 1u);
            const unsigned tg = og / nx;
            if (og + 1u == (tg + 1u) * nx) xb_add(&bar[XB_TOPGEN], 1u);
            else XB_SPIN(xb_ld(&bar[XB_TOPGEN]) == tg, bar);
            __builtin_amdgcn_fence(__ATOMIC_ACQUIRE, "agent");
            xb_add(&bar[XB_XGEN(b.x)], 1u);
            asm volatile("s_waitcnt vmcnt(0)" ::: "memory");
        } else {
            XB_SPIN(xb_ld(&bar[XB_XGEN(b.x)]) == gen, bar);
            __builtin_amdgcn_fence(__ATOMIC_ACQUIRE, "agent");
            asm volatile("s_waitcnt vmcnt(0)" ::: "memory");
        }
    }
    __syncthreads();
}

struct Args { const void* in[16]; float* out; unsigned char* ws; int ph_lo, ph_hi; };
constexpr int N_PHASES = 6 * DEPTH + 1;

__global__ void __launch_bounds__(NWAVES * 64, 2) trunk_fwd(Args args) {
    extern __shared__ __attribute__((aligned(16))) unsigned char lds[];
    LAS unsigned char* L = (LAS unsigned char*)lds;
#define FRESH_TID() const int tid = mk_tid(wave0), lane = tid & 63, wid = __builtin_amdgcn_readfirstlane(tid >> 6); const int gw = vcu * NWAVES + wid; (void)tid; (void)lane; (void)gw
    const int wave0 = __builtin_amdgcn_readfirstlane((int)threadIdx.x >> 6);
    const int G = gridDim.x, bx = blockIdx.x;
    const int vcu = (G % 8 == 0) ? (bx % 8) * (G / 8) + bx / 8 : bx;
    const int NGW = G * NWAVES;
    unsigned char* ws = args.ws;
    const float* x_in = (const float*)args.in[0]; const int* pos = (const int*)args.in[1];
    float* out = args.out;
    float* ropec = (float*)(ws + WS_ROPE); float* ropes = ropec + SEQ * 8;
    bf16* WinT = (bf16*)(ws + WS_WIN); bf16* WbT = (bf16*)(ws + WS_WB); bf16* WoT = (bf16*)(ws + WS_WO);
    bf16* HB = (bf16*)(ws + WS_HB); bf16* OB = (bf16*)(ws + WS_O); bf16* PJ = (bf16*)(ws + WS_PJ);
    bf16* GL = PJ;
    const int lo = args.ph_lo, hi = args.ph_hi;
#define IN(k) (lo <= (k) && (k) < hi)
#ifdef PROBE_S1A
#define MARK(i) do { if (blockIdx.x == 0 && wave0 == 0 && mk_lane() == 0) ((LAS unsigned long long*)(L + LDS_BYTES - 512))[i] = __builtin_amdgcn_s_memrealtime(); } while (0)
#define MARKG(i) do { if (wave0 == 0 && mk_lane() == 0) atomicMax((unsigned long long*)(ws + WS_BAR + 32768) + (i), (unsigned long long)__builtin_amdgcn_s_memrealtime()); } while (0)
#else
#define MARK(i) do {} while (0)
#define MARKG(i) do {} while (0)
#endif
#define SEAM(k) do { if (IN(k) && IN((k) + 1)) { xcd_barrier(xbar); } MARK((k) + 1); } while (0)

    MARK(0);
    XcdBarrier xbar; xbar.bar = (unsigned*)(ws + WS_BAR); xbar.x = 0; xbar.wave = wave0; xbar.st = (volatile LAS unsigned*)(L + LDS_BYTES - 1024);
    {
        if (wave0 == 0 && mk_lane() < 2) ((LAS unsigned*)(L + LDS_BYTES - 1024))[mk_lane()] = 0u;
        __syncthreads();
        if (hi - lo > 1) xbar = xcd_barrier_post((unsigned*)(ws + WS_BAR), (volatile LAS unsigned*)(L + LDS_BYTES - 1024), wave0);
        if (lo < 0) cg::this_grid().sync();
    }
    for (int layer = 0; layer < DEPTH; ++layer) {
        const int pb = 6 * layer;
        const float* xsrc = layer == 0 ? x_in : out;
#ifndef SKIP_P0
        if (IN(pb + 0)) {
            FRESH_TID();
            const float* w_in = (const float*)args.in[3] + (size_t)layer * DM * NIN;
            const float* w_br = (const float*)args.in[13] + (size_t)layer * 3 * 512 * DM;
            const float* w_out = (const float*)args.in[14] + (size_t)layer * DM * DM;
            const float* ng = (const float*)args.in[2] + layer * DM;
            LAS float* scr = (LAS float*)(L + wid * 16384);
            constexpr int I_IN = (DM / 64) * (NIN / 32), I_B = (512 / 64) * (DM / 32), I_O = (DM / 64) * (DM / 32);
            constexpr int NITEMS = I_IN + 3 * I_B + I_O;
            for (int it = gw; it < NITEMS; it += NGW) {
                int r = it;
                if (r < I_IN) { p0_transpose_item(w_in, DM, NIN, WinT, DM, scr, r, lane); continue; } r -= I_IN;
                if (r < 3 * I_B) { const int br = r / I_B; p0_transpose_item(w_br + (size_t)br * 512 * DM, 512, DM, WbT + br * 512, YP, scr, r % I_B, lane); continue; } r -= 3 * I_B;
                p0_transpose_item(w_out, DM, DM, WoT, DM, scr, r, lane);
            }
            for (int m = gw; m < SEQ; m += 4 * NGW) rms_rows<4, true>(xsrc + (size_t)m * DM, (size_t)NGW * DM, ng, HB + (size_t)m * DM, lane);
            if (layer == 0) {
                for (int idx = (vcu * NWAVES * 64) + tid; idx < SEQ * 8; idx += G * NWAVES * 64) {
                    const int tok = idx >> 3, i = idx & 7;
                    const float ang = (float)pos[tok] * __builtin_amdgcn_exp2f(-(float)i * (18.931568569324174f / 8.0f));
                    const double rev = (double)ang * 0.15915494309189535; const double fr_ = rev - __builtin_rint(rev);
                    ropec[idx] = __builtin_amdgcn_cosf((float)fr_); ropes[idx] = __builtin_amdgcn_sinf((float)fr_);
                }
            }
        }
#endif
        SEAM(pb + 0);
#ifndef SKIP_P1
        if (IN(pb + 1)) {
            pg8::Gemm g{HB, WinT, SEQ, NMAIN, DM}; pg8::StaticOrder S; S.init(SEQ, NMAIN, G, bx);
            EpiProj E{PJ, ropec, ropes};
            pg8::gemm_phase<EpiProj, pg8::StaticOrder, true, true>(L, g, S, E, pg8::NoHook(), wave0);
        }
#endif
        SEAM(pb + 1);
        if (IN(pb + 2)) {
#ifndef SKIP_ATT
            {
                const int hm = vcu >> 5, s = vcu & 31;
                const int nit = (G == 256) ? 2 : (vcu < 512 ? (512 - vcu + G - 1) / G : 0);
                for (int i = 0; i < nit; ++i) {
                    int hm2, qb; if (G == 256) { hm2 = hm; qb = i ? 63 - s : s; } else { const int u = vcu + i * G; hm2 = u >> 6; qb = u & 63; }
                    attn_body::attn_unit<8>(qb, (const attn_body::bf16*)(PJ + SL_AQ * SLOT_ELEMS) + hm2 * 64, (const attn_body::bf16*)(PJ + SL_AK * SLOT_ELEMS) + hm2 * 64,
                                            (const attn_body::bf16*)(PJ + SL_AV * SLOT_ELEMS) + (hm2 >> 1) * 128, (attn_body::bf16*)OB + hm2 * 128, (char*)lds, wave0);
                }
            }
#endif
            if (layer == 0) { MARK(20); MARKG(0); }
#ifndef SKIP_CMIX
            {
                FRESH_TID();
                for (int it = vcu; it < (SEQ / CM_BLK) * 8; it += G) cmix_item(it >> 3, it & 7, PJ + SL_CQ * SLOT_ELEMS, PJ + SL_CK * SLOT_ELEMS, PJ + SL_CV * SLOT_ELEMS, PJ + SL_AZ * SLOT_ELEMS + 1024, L + wid * 8192, wid, lane);
                __syncthreads();
            }
#endif
            if (layer == 0) { MARK(21); MARKG(1); }
#ifndef SKIP_SGU
            {
                FRESH_TID();
                const float* lng = (const float*)args.in[9] + layer * 512; const float* lnb = (const float*)args.in[10] + layer * 512;
                const float* sw = (const float*)args.in[11] + (size_t)layer * 4 * 128 * 128; const float* sb = (const float*)args.in[12] + layer * 4 * 128;
                unsigned* qctr = (unsigned*)(ws + WS_BAR + 40960) + layer * 64;
                volatile LAS unsigned* qword = (volatile LAS unsigned*)(L + LDS_BYTES - 768);
                for (;;) {
                    if (tid == 0) *qword = xb_add(qctr, 1u);
                    __syncthreads();
                    const unsigned it = *qword;
                    __syncthreads();
                    if (it >= 512u) break;
                    sgu_item((int)it, PJ + SL_BU * SLOT_ELEMS, PJ + SL_BV * SLOT_ELEMS, PJ + SL_AZ * SLOT_ELEMS + 512, lng, lnb, sw, sb, L, tid, wid, lane);
                }
            }
#endif
            if (layer == 0) { MARK(22); MARKG(2); }
        }
        SEAM(pb + 2);
#ifndef SKIP_P3
        if (IN(pb + 3)) {
            { FRESH_TID();
            const float lam_init = 0.8f - 0.6f * __expf(-0.3f * (float)layer);
            const float* lq1 = (const float*)args.in[4] + layer * 64; const float* lk1 = (const float*)args.in[5] + layer * 64;
            const float* lq2 = (const float*)args.in[6] + layer * 64; const float* lk2 = (const float*)args.in[7] + layer * 64;
            const float lam = __expf(wave_sum(lq1[lane] * lk1[lane])) - __expf(wave_sum(lq2[lane] * lk2[lane])) + lam_init;
            const float* sg = (const float*)args.in[8] + layer * 128;
            const int e0 = (lane & 15) * 8, hh = lane >> 4;
            const f32x4 g0 = *(const f32x4*)(sg + e0), g1 = *(const f32x4*)(sg + e0 + 4);
            bf16* AZ = PJ + SL_AZ * SLOT_ELEMS;
            for (int m0 = gw; m0 < SEQ; m0 += 4 * NGW) {
                v4u A4[4], B4[4], Z4[4];
#pragma unroll
                for (int k = 0; k < 4; ++k) { const size_t m = (size_t)m0 + (size_t)k * NGW;
                    A4[k] = *(const v4u*)(OB + m * DM + hh * 256 + e0); B4[k] = *(const v4u*)(OB + m * DM + hh * 256 + 128 + e0); Z4[k] = *(const v4u*)(AZ + m * YP + hh * 128 + e0); }
#pragma unroll
                for (int k = 0; k < 4; ++k) { const size_t m = (size_t)m0 + (size_t)k * NGW; const v4u a = A4[k], b = B4[k], z = Z4[k];
                float d[8] = {bflo(a.x) - lam * bflo(b.x), bfhi(a.x) - lam * bfhi(b.x), bflo(a.y) - lam * bflo(b.y), bfhi(a.y) - lam * bfhi(b.y),
                              bflo(a.z) - lam * bflo(b.z), bfhi(a.z) - lam * bfhi(b.z), bflo(a.w) - lam * bflo(b.w), bfhi(a.w) - lam * bfhi(b.w)};
                float ss = 0.f;
#pragma unroll
                for (int e = 0; e < 8; ++e) ss += d[e] * d[e];
                ss += __shfl_xor(ss, 1); ss += __shfl_xor(ss, 2); ss += __shfl_xor(ss, 4); ss += __shfl_xor(ss, 8);
                const float rr = (1.f / sqrtf(ss * (1.f / 128.f) + EPS)) * (1.f - lam_init);
                v4u w; w.x = pk2(d[0] * rr * g0[0] * bflo(z.x), d[1] * rr * g0[1] * bfhi(z.x)); w.y = pk2(d[2] * rr * g0[2] * bflo(z.y), d[3] * rr * g0[3] * bfhi(z.y));
                w.z = pk2(d[4] * rr * g1[0] * bflo(z.z), d[5] * rr * g1[1] * bfhi(z.z)); w.w = pk2(d[6] * rr * g1[2] * bflo(z.w), d[7] * rr * g1[3] * bfhi(z.w));
                *(v4u*)(AZ + m * YP + hh * 128 + e0) = w; }
            } }
            asm volatile("s_waitcnt vmcnt(0) lgkmcnt(0)" ::: "memory"); __syncthreads();
            pg8::Gemm g{HB, WinT + (size_t)NMAIN * DM, SEQ, NGATE, DM}; pg8::StaticOrder S; S.init(SEQ, NGATE, G, bx);
            EpiGate E{GL};
            pg8::gemm_phase<EpiGate, pg8::StaticOrder, true, true>(L, g, S, E, pg8::NoHook(), wave0);
        }
#endif
        SEAM(pb + 3);
#ifndef SKIP_P4
        if (IN(pb + 4)) {
            pg8::StaticOrder S; S.init(SEQ, DM, G, bx);
            pg8::Gemm g{PJ + (size_t)SL_AZ * SLOT_ELEMS, WbT, SEQ, DM, YP}; EpiMerge E{GL, OB}; MergeHook H{GL};
            pg8::gemm_phase<EpiMerge, pg8::StaticOrder, false, true, MergeHook>(L, g, S, E, H, wave0);
        }
#endif
        SEAM(pb + 4);
#ifdef PROBE_S1A
        if (layer == 0 && IN(pb + 4) && IN(pb + 5)) { MARK(23); xcd_barrier(xbar); MARK(24); }
#endif
#ifndef SKIP_P5
        if (IN(pb + 5)) {
            pg8::Gemm g{OB, WoT, SEQ, DM, DM}; pg8::StaticOrder S; S.init(SEQ, DM, G, bx);
            EpiOut E{xsrc, out};
            pg8::gemm_phase<EpiOut, pg8::StaticOrder, false, true>(L, g, S, E, pg8::NoHook(), wave0);
        }
#endif
        SEAM(pb + 5);
    }
    if (IN(6 * DEPTH)) {
        FRESH_TID();
        const float* fg = (const float*)args.in[15];
        for (int m = gw; m < SEQ; m += 4 * NGW) rms_rows<4, false>(out + (size_t)m * DM, (size_t)NGW * DM, fg, out + (size_t)m * DM, lane);
    }
#ifdef PROBE_S1A
    MARK(13);
    __syncthreads();
    if (blockIdx.x == 0 && wave0 == 0 && mk_lane() == 0) {
        LAS unsigned long long* T = (LAS unsigned long long*)(L + LDS_BYTES - 512);
        for (int i = 0; i < 3; ++i) T[40 + i] = __hip_atomic_load((unsigned long long*)(ws + WS_BAR + 32768) + i, __ATOMIC_RELAXED, __HIP_MEMORY_SCOPE_AGENT);
        const unsigned long long s1 = T[PROBE_S1B] - T[PROBE_S1A], s2 = T[PROBE_S2B] - T[PROBE_S2A];
        const unsigned long long spin = 4ull * s1 + 300000ull * ((s2 + 1000ull) / 2000ull);
        const unsigned long long t0 = __builtin_amdgcn_s_memrealtime();
        while (__builtin_amdgcn_s_memrealtime() - t0 < spin) __builtin_amdgcn_s_sleep(8);
    }
#endif
#undef IN
#undef SEAM
}

extern "C" void kernel_launch(void* const* d_in, const int* in_sizes, int n_in, void* d_out, int out_size, void* d_ws, size_t ws_size, hipStream_t stream) {
    static int grid = 0;
    if (grid == 0) {
        if (n_in != 16 || out_size != SEQ * DM || ws_size < WS_END) { fprintf(stderr, "kernel_launch: unexpected shapes (n_in %d out %d ws %zu need %zu)\n", n_in, out_size, ws_size, (size_t)WS_END); grid = -1; return; }
        int dev = 0, cus = 0, per_cu = 0;
        hipGetDevice(&dev); hipDeviceGetAttribute(&cus, hipDeviceAttributeMultiprocessorCount, dev);
        if (hipFuncSetAttribute((const void*)trunk_fwd, hipFuncAttributeMaxDynamicSharedMemorySize, LDS_BYTES) != hipSuccess) { fprintf(stderr, "kernel_launch: hipFuncSetAttribute failed\n"); grid = -1; return; }
        hipOccupancyMaxActiveBlocksPerMultiprocessor(&per_cu, (const void*)trunk_fwd, NWAVES * 64, LDS_BYTES);
        (void)hipGetLastError();
        if (per_cu < 1) per_cu = 1;
        grid = cus * (per_cu > 1 ? 1 : per_cu);
        fprintf(stderr, "kernel_launch: grid %d (cus %d per_cu %d)\n", grid, cus, per_cu);
    }
    if (grid < 0) return;
    Args a{};
    for (int i = 0; i < 16; ++i) a.in[i] = d_in[i];
    a.out = (float*)d_out; a.ws = (unsigned char*)d_ws;
#if MK_ONE_LAUNCH
    if (hipMemsetAsync((unsigned char*)d_ws + WS_BAR, 0, 65536, stream) != hipSuccess) { fprintf(stderr, "kernel_launch: memset failed\n"); return; }
    a.ph_lo = 0; a.ph_hi = N_PHASES;
    void* kargs[] = {&a};
    hipError_t e = hipLaunchCooperativeKernel((const void*)trunk_fwd, dim3(grid), dim3(NWAVES * 64), kargs, LDS_BYTES, stream);
    if (e != hipSuccess) fprintf(stderr, "cooperative launch failed: %s (grid %d)\n", hipGetErrorString(e), grid);
#else
    for (int p = 0; p < N_PHASES; ++p) { a.ph_lo = p; a.ph_hi = p + 1; hipLaunchKernelGGL(trunk_fwd, dim3(grid), dim3(NWAVES * 64), LDS_BYTES, stream, a);
    }
#endif
}
```

```cpp
#include <hip/hip_runtime.h>
#include <hip/hip_cooperative_groups.h>
#include <cstdio>
#include <cstdint>
#include <cmath>
__device__ __forceinline__ int mk_lane() { return (int)__builtin_amdgcn_mbcnt_hi(~0u, __builtin_amdgcn_mbcnt_lo(~0u, 0u)); }
__device__ __forceinline__ int mk_tid(int wave) { int l; asm volatile("v_mbcnt_lo_u32_b32 %0, -1, 0\n\tv_mbcnt_hi_u32_b32 %0, -1, %0" : "=&v"(l)); return wave * 64 + l; }
#define MK_ONE_LAUNCH 1
namespace pg8 {
#define PG8_LAS __attribute__((address_space(3)))
typedef unsigned short bf16_t;
typedef short bf16x8 __attribute__((ext_vector_type(8)));
typedef float f32x4 __attribute__((ext_vector_type(4)));
typedef unsigned u32x4 __attribute__((ext_vector_type(4)));
constexpr int BM = 256, BK = 64, HALF = 128, HTB = HALF * BK * 2  , STAGE_BYTES = 8 * HTB, NXCD = 8, WGM = 8;

__host__ __device__ __forceinline__ int lds_byte(int r, int c) { const int st = (r >> 4) * 2 + (c >> 5), rr = r & 15, cc = c & 31, ob = rr * 64 + cc * 2; return st * 1024 + (ob ^ (((ob >> 9) & 1) << 5)); }
__host__ __device__ __forceinline__ void stage_rc(int b, int& R, int& C) { const int st = b / 1024, sb = b % 1024, swz = sb ^ (((sb >> 9) & 1) << 5); R = (st >> 1) * 16 + swz / 64; C = (st & 1) * 32 + (swz % 64) / 2; }
__host__ __device__ __forceinline__ int perm32(int rho) { const int n = rho >> 4, i = rho & 15; return 8 * (i >> 2) + 4 * n + (i & 3); }

struct Unit { int pm, pn; };
struct Gemm { const bf16_t* A; const bf16_t* Bt; int M, N, K; };

struct StaticOrder {
    int nM, nN, nwg, G, c;
    __host__ __device__ void init(int M, int N, int G_, int c_) { nM = M / BM; nN = N / BM; nwg = nM * nN; G = G_; c = c_; }
    __host__ __device__ bool next(int i, Unit& u) const {
        const long L = (long)i * G + c; if (L >= nwg) return false;
        int wgid = (int)L; { const int q = nwg / NXCD, r = nwg % NXCD, xcd = wgid % NXCD, off = wgid / NXCD; wgid = (xcd < r ? xcd * (q + 1) : r * (q + 1) + (xcd - r) * q) + off; }
        const int nig = WGM * nN, gid = wgid / nig, fm = gid * WGM, gsz = (nM - fm) < WGM ? (nM - fm) : WGM;
        u.pm = fm + ((wgid % nig) % gsz); u.pn = (wgid % nig) / gsz; return true;
    }
    __device__ __forceinline__ void a_ready(const Unit&) const {}
    __device__ __forceinline__ void done(const Unit&) const {}
};

__device__ __forceinline__ unsigned cvt_pk_bf16(float lo, float hi) { unsigned r; asm volatile("v_cvt_pk_bf16_f32 %0, %1, %2" : "=v"(r) : "v"(lo), "v"(hi)); return r; }
typedef float f32x2 __attribute__((ext_vector_type(2)));
struct NoHook { static constexpr int PERIOD = 0; __device__ __forceinline__ void operator()(f32x4 (&)[2][2][4][2], const Unit&, int, int, int, int, int) const {} };
template <class Epi, class Sched, bool ALIGN_EPI = false, bool SP2 = false, class Hook = NoHook>
__device__ __forceinline__ void gemm_phase(PG8_LAS unsigned char* lds, const Gemm g, const Sched& S, const Epi& E, const Hook& H, int wave_id) {
    int tid_ = mk_tid(wave_id);
    const int tid = tid_, wid = __builtin_amdgcn_readfirstlane(tid >> 6), lane = tid & 63, wr = wid >> 2, wc = wid & 3, fr = lane & 15, fq = lane >> 4;
    const int K = g.K, nt = K / BK;
    unsigned voffA[2], voffB[2];
#pragma unroll
    for (int i = 0; i < 2; ++i) { int R, C; stage_rc(tid * 16 + i * 8192, R, C); const int Rb = Epi::PERM ? ((R & ~31) + perm32(R & 31)) : R;
        voffA[i] = (unsigned)(R * K + C) * 2u; voffB[i] = (unsigned)(Rb * K + C) * 2u; }
    const size_t kstep = (size_t)(BK * 2);
    const size_t hstep = (size_t)HALF * K * 2;
    const size_t tstep = 2 * hstep;
    const unsigned ldsw = (unsigned)wid * 1024u;
    const int aoff = lds_byte(wr * 64 + fr, fq * 8), boff = lds_byte(wc * 32 + fr, fq * 8);
#define PG8_SA(b, h) (((b) * 2 + (h)) * HTB)
#define PG8_SB(b, h) ((4 + (b) * 2 + (h)) * HTB)
#define PG8_STAGE(bufoff, gbase, voff) do { _Pragma("unroll") for (int _i = 0; _i < 2; ++_i) \
        __builtin_amdgcn_global_load_lds((const unsigned*)((const char*)(gbase) + (voff)[_i]), (PG8_LAS unsigned*)(lds + (bufoff) + ldsw + _i * 8192), 16, 0, 0); } while (0)
#define PG8_LDA(dst, b, h) do { _Pragma("unroll") for (int m = 0; m < 4; ++m) _Pragma("unroll") for (int k = 0; k < 2; ++k) dst[m][k] = *(const PG8_LAS bf16x8*)(lds + PG8_SA(b, h) + aoff + m * 2048 + k * 1024); } while (0)
#define PG8_LDB(dst, b, h) do { _Pragma("unroll") for (int n = 0; n < 2; ++n) _Pragma("unroll") for (int k = 0; k < 2; ++k) dst[n][k] = *(const PG8_LAS bf16x8*)(lds + PG8_SB(b, h) + boff + n * 2048 + k * 1024); } while (0)
#define PG8_MMA(ai, bj, At, Bt) do { __builtin_amdgcn_s_setprio(1); _Pragma("unroll") for (int m = 0; m < 4; ++m) _Pragma("unroll") for (int n = 0; n < 2; ++n) _Pragma("unroll") for (int k = 0; k < 2; ++k) \
        acc[ai][bj][m][n] = __builtin_amdgcn_mfma_f32_16x16x32_bf16(Bt[n][k], At[m][k], acc[ai][bj][m][n], 0, 0, 0); __builtin_amdgcn_s_setprio(0); } while (0)
#define PG8_WAIT_V(n) asm volatile("s_waitcnt vmcnt(" #n ")" ::: "memory")
#define PG8_WAIT_L(n) asm volatile("s_waitcnt lgkmcnt(" #n ")" ::: "memory")
#define PG8_BAR __builtin_amdgcn_s_barrier()
#define PG8_SCHED __builtin_amdgcn_sched_barrier(0)
    Unit cur, nxt; int ui = 0;
    if (!S.next(0, cur)) return;
    f32x4 acc[2][2][4][2];
#pragma unroll
    for (int a = 0; a < 2; ++a)
#pragma unroll
        for (int b = 0; b < 2; ++b)
#pragma unroll
            for (int m = 0; m < 4; ++m)
#pragma unroll
                for (int n = 0; n < 2; ++n) acc[a][b][m][n] = (f32x4){0.f, 0.f, 0.f, 0.f};
    bf16x8 At[4][2], B0[2][2], B1[2][2];
    const char* cA = (const char*)g.A + (size_t)cur.pm * tstep; const char* cB = (const char*)g.Bt + (size_t)cur.pn * tstep;
    S.a_ready(cur);
    if constexpr (SP2) {
        PG8_STAGE(PG8_SB(0, 0), cB, voffB); PG8_STAGE(PG8_SB(0, 1), cB + hstep, voffB); PG8_STAGE(PG8_SA(0, 0), cA, voffA); PG8_STAGE(PG8_SA(0, 1), cA + hstep, voffA);
        if (wr == 1) PG8_BAR;
        PG8_WAIT_V(2); PG8_BAR;
        PG8_STAGE(PG8_SB(1, 0), cB + kstep, voffB); PG8_STAGE(PG8_SA(1, 0), cA + kstep, voffA); PG8_STAGE(PG8_SB(1, 1), cB + hstep + kstep, voffB);
        PG8_WAIT_V(6); PG8_BAR;
    } else {
        PG8_STAGE(PG8_SB(0, 0), cB, voffB); PG8_STAGE(PG8_SA(0, 0), cA, voffA); PG8_STAGE(PG8_SB(0, 1), cB + hstep, voffB); PG8_STAGE(PG8_SA(0, 1), cA + hstep, voffA);
        if (wr == 1) PG8_BAR;
        PG8_WAIT_V(4); PG8_BAR;
        PG8_STAGE(PG8_SB(1, 0), cB + kstep, voffB); PG8_STAGE(PG8_SA(1, 0), cA + kstep, voffA); PG8_STAGE(PG8_SB(1, 1), cB + hstep + kstep, voffB);
        PG8_WAIT_V(6); PG8_BAR;
    }
    for (;;) {
        const bool has_next = S.next(ui + 1, nxt);
        const char* nA = has_next ? (const char*)g.A + (size_t)nxt.pm * tstep : cA; const char* nB = has_next ? (const char*)g.Bt + (size_t)nxt.pn * tstep : cB;
        for (int t = 0; t < nt; t += 2) {
            if constexpr (Hook::PERIOD > 0) { if (t > 0 && (t % Hook::PERIOD) == 0) { H(acc, cur, t / Hook::PERIOD, wr, wc, fr, fq); PG8_SCHED; } }
            const bool last = (t == nt - 2);
            const char* a1 = cA + (size_t)(t + 1) * kstep;
            const char* a2 = last ? nA : cA + (size_t)(t + 2) * kstep; const char* b2 = last ? nB : cB + (size_t)(t + 2) * kstep;
            const char* a3 = a2 + kstep; const char* b3 = b2 + kstep;
            if (last && has_next) S.a_ready(nxt);
            if constexpr (SP2) {
            PG8_LDB(B0, 0, 0); PG8_LDB(B1, 0, 1); PG8_SCHED; PG8_LDA(At, 0, 0); PG8_STAGE(PG8_SA(1, 1), a1 + hstep, voffA);
            PG8_WAIT_V(8); PG8_WAIT_L(0); PG8_BAR; PG8_MMA(0, 0, At, B0); PG8_MMA(0, 1, At, B1); PG8_BAR; PG8_SCHED;
            PG8_LDA(At, 0, 1); PG8_STAGE(PG8_SB(0, 0), b2, voffB); PG8_STAGE(PG8_SB(0, 1), b2 + hstep, voffB); PG8_STAGE(PG8_SA(0, 0), a2, voffA);
            PG8_WAIT_V(8); PG8_WAIT_L(0); PG8_BAR; PG8_MMA(1, 0, At, B0); PG8_MMA(1, 1, At, B1); PG8_BAR; PG8_SCHED;
            PG8_LDB(B0, 1, 0); PG8_LDB(B1, 1, 1); PG8_SCHED; PG8_LDA(At, 1, 0); PG8_STAGE(PG8_SA(0, 1), a2 + hstep, voffA);
            PG8_WAIT_V(8); PG8_WAIT_L(0); PG8_BAR; PG8_MMA(0, 0, At, B0); PG8_MMA(0, 1, At, B1); PG8_BAR; PG8_SCHED;
            PG8_LDA(At, 1, 1); PG8_STAGE(PG8_SB(1, 0), b3, voffB); PG8_STAGE(PG8_SB(1, 1), b3 + hstep, voffB); PG8_STAGE(PG8_SA(1, 0), a3, voffA);
            PG8_WAIT_V(8); PG8_WAIT_L(0); PG8_BAR; PG8_MMA(1, 0, At, B0); PG8_MMA(1, 1, At, B1); PG8_BAR; PG8_SCHED;
            } else {
            PG8_LDB(B0, 0, 0); PG8_SCHED; PG8_LDA(At, 0, 0); PG8_STAGE(PG8_SA(1, 1), a1 + hstep, voffA);
            PG8_WAIT_L(8); PG8_BAR; PG8_WAIT_L(0); PG8_MMA(0, 0, At, B0); PG8_BAR; PG8_SCHED;
            PG8_LDB(B1, 0, 1); PG8_STAGE(PG8_SB(0, 0), b2, voffB);
            PG8_BAR; PG8_WAIT_L(0); PG8_MMA(0, 1, At, B1); PG8_BAR;
            PG8_LDA(At, 0, 1); PG8_STAGE(PG8_SA(0, 0), a2, voffA);
            PG8_BAR; PG8_WAIT_L(0); PG8_MMA(1, 0, At, B0); PG8_BAR; PG8_SCHED;
            PG8_STAGE(PG8_SB(0, 1), b2 + hstep, voffB);
            PG8_WAIT_V(6); PG8_BAR; PG8_MMA(1, 1, At, B1); PG8_BAR;
            PG8_LDB(B0, 1, 0); PG8_SCHED; PG8_LDA(At, 1, 0); PG8_STAGE(PG8_SA(0, 1), a2 + hstep, voffA);
            PG8_WAIT_L(8); PG8_BAR; PG8_WAIT_L(0); PG8_MMA(0, 0, At, B0); PG8_BAR; PG8_SCHED;
            PG8_LDB(B1, 1, 1); PG8_STAGE(PG8_SB(1, 0), b3, voffB);
            PG8_BAR; PG8_WAIT_L(0); PG8_MMA(0, 1, At, B1); PG8_BAR;
            PG8_LDA(At, 1, 1); PG8_STAGE(PG8_SA(1, 0), a3, voffA);
            PG8_BAR; PG8_WAIT_L(0); PG8_MMA(1, 0, At, B0); PG8_BAR; PG8_SCHED;
            PG8_STAGE(PG8_SB(1, 1), b3 + hstep, voffB);
            PG8_WAIT_V(6); PG8_BAR; PG8_MMA(1, 1, At, B1); PG8_BAR;
            }
        }
        if constexpr (ALIGN_EPI) { if (wr == 0) PG8_BAR; }
        if constexpr (!Epi::AFTER_DRAIN) { E(acc, cur, wr, wc, fr, fq); S.done(cur); }
        if (!has_next) break;
#pragma unroll
        for (int a = 0; a < 2; ++a)
#pragma unroll
            for (int b = 0; b < 2; ++b)
#pragma unroll
                for (int m = 0; m < 4; ++m)
#pragma unroll
                    for (int n = 0; n < 2; ++n) acc[a][b][m][n] = (f32x4){0.f, 0.f, 0.f, 0.f};
        cur = nxt; cA = nA; cB = nB; ++ui;
        if constexpr (ALIGN_EPI) { if (wr == 1) PG8_BAR; }
    }
    PG8_WAIT_V(0);
    if constexpr (!ALIGN_EPI) { if (wr == 0) PG8_BAR; }
    PG8_BAR;
    if constexpr (Epi::AFTER_DRAIN) { E.fused(acc, cur, wr, wc, fr, fq, lds, wid, lane); S.done(cur); }
#undef PG8_SA
#undef PG8_SB
#undef PG8_STAGE
#undef PG8_LDA
#undef PG8_LDB
#undef PG8_MMA
#undef PG8_WAIT_V
#undef PG8_WAIT_L
#undef PG8_BAR
#undef PG8_SCHED
}
}
#include <hip/hip_bf16.h>
namespace attn_body {
using bf16=__hip_bfloat16;
using bf16x8=__attribute__((ext_vector_type(8)))short;
using s16x4=__attribute__((ext_vector_type(4)))short;
using f32x16=__attribute__((ext_vector_type(16)))float;
using u32x4=__attribute__((ext_vector_type(4)))unsigned;
constexpr int SEQ=16384,D=64,PQ=512,PK=512,PV=512,PO=1024;
constexpr int NW=8,QBLK=32,QB=QBLK*NW,KVBLK=64,NQB=SEQ/QB;
constexpr int ATTN_UNIT_ROWS=QB;
__device__ __forceinline__ int crow(int r,int hi){return (r&3)+8*(r>>2)+4*hi;}
#define SBAR() __builtin_amdgcn_sched_barrier(0)
__device__ __forceinline__ void cmask(f32x16&p0,f32x16&p1,int jb,int qrel,int hi){
  const float NEG=-INFINITY; int kb=64*jb+4*hi;
  #pragma unroll
  for(int r=0;r<16;++r){int kv=kb+(r&3)+8*(r>>2); if(kv>qrel)p0[r]=NEG; if(kv+32>qrel)p1[r]=NEG;}
}

constexpr int NSLOT=3, SLOTB=8192;
constexpr int VSLOTB=2*SLOTB;
constexpr int LDS_K=0, LDS_V=NSLOT*SLOTB, LDS_WS=LDS_V+NSLOT*VSLOTB, LDS_OST=LDS_WS+NW*64*4, LDS_BYTES=LDS_OST+NW*8192;
constexpr float C2=0.125f*1.4426950408889634f;
__device__ __forceinline__ void glds16(const void*gsrc,unsigned lds_dst){unsigned keep;
  asm volatile("s_mov_b32 %0, m0\n\ts_mov_b32 m0, %2\n\ts_nop 0\n\tglobal_load_lds_dwordx4 %1, off\n\ts_mov_b32 m0, %0":"=&s"(keep):"v"(gsrc),"s"(lds_dst):"memory");}
__device__ __forceinline__ float max3f(float a,float b,float c){float r;asm("v_max3_f32 %0, %1, %2, %3":"=v"(r):"v"(a),"v"(b),"v"(c));return r;}
__device__ __forceinline__ float max2f(float a,float b){float r;asm("v_max_f32_e32 %0, %1, %2":"=v"(r):"v"(a),"v"(b));return r;}
__device__ __forceinline__ float fadd_s(float a,float b){float r;asm("v_add_f32_e32 %0, %1, %2":"=v"(r):"v"(a),"v"(b));return r;}
__device__ __forceinline__ float fsub_s(float a,float b){float r;asm("v_sub_f32_e32 %0, %1, %2":"=v"(r):"v"(a),"v"(b));return r;}
typedef float f32x2_t __attribute__((ext_vector_type(2))); typedef __bf16 bf16x2_t __attribute__((ext_vector_type(2)));
__device__ __forceinline__ unsigned cvtpk_s(float lo,float hi){f32x2_t v={lo,hi};bf16x2_t b=__builtin_convertvector(v,bf16x2_t);return __builtin_bit_cast(unsigned,b);}
#define WAIT_BAR(N) asm volatile("s_waitcnt vmcnt(" #N ") lgkmcnt(0)\n\ts_barrier":::"memory")

__device__ __forceinline__ void qkt(f32x16&p0,f32x16&p1,const char*Kslot,const bf16x8*qr,const f32x16&negm,int r32,int hi){
  const char*kb=Kslot+hi*1024+r32*16;
  #pragma unroll
  for(int d0=0;d0<4;++d0){
    const bf16x8 b0=*reinterpret_cast<const bf16x8*>(kb+d0*2048);
    const bf16x8 b1=*reinterpret_cast<const bf16x8*>(kb+d0*2048+512);
    if(d0==0){p0=__builtin_amdgcn_mfma_f32_32x32x16_bf16(b0,qr[0],negm,0,0,0);p1=__builtin_amdgcn_mfma_f32_32x32x16_bf16(b1,qr[0],negm,0,0,0);}
    else{p0=__builtin_amdgcn_mfma_f32_32x32x16_bf16(b0,qr[d0],p0,0,0,0);p1=__builtin_amdgcn_mfma_f32_32x32x16_bf16(b1,qr[d0],p1,0,0,0);}}
}
typedef __attribute__((address_space(3))) const char* lds_cptr;
typedef short v4i16_t __attribute__((ext_vector_type(4)));
__device__ __forceinline__ void kload8(bf16x8*kf,lds_cptr kp){
  kf[0]=*(const __attribute__((address_space(3))) bf16x8*)(kp);      kf[1]=*(const __attribute__((address_space(3))) bf16x8*)(kp+512);
  kf[2]=*(const __attribute__((address_space(3))) bf16x8*)(kp+2048); kf[3]=*(const __attribute__((address_space(3))) bf16x8*)(kp+2560);
  kf[4]=*(const __attribute__((address_space(3))) bf16x8*)(kp+4096); kf[5]=*(const __attribute__((address_space(3))) bf16x8*)(kp+4608);
  kf[6]=*(const __attribute__((address_space(3))) bf16x8*)(kp+6144); kf[7]=*(const __attribute__((address_space(3))) bf16x8*)(kp+6656);
}
__device__ __forceinline__ void kload2(bf16x8*kf,lds_cptr kp,int j){ kf[2*j]=*(const __attribute__((address_space(3))) bf16x8*)(kp+j*2048); kf[2*j+1]=*(const __attribute__((address_space(3))) bf16x8*)(kp+j*2048+512); }
__device__ __forceinline__ s16x4 vtr(lds_cptr p){ return __builtin_bit_cast(s16x4,__builtin_amdgcn_ds_read_tr16_b64_v4i16((__attribute__((address_space(3))) v4i16_t*)p)); }
__device__ __forceinline__ float rowmax(const f32x16&p0,const f32x16&p1){
  float a=max3f(p0[0],p0[1],p1[0]),b=max3f(p0[2],p0[3],p1[1]);a=max3f(a,p1[2],p1[3]);
  #pragma unroll
  for(int r=4;r<16;r+=4){a=max3f(a,p0[r],p0[r+1]);b=max3f(b,p0[r+2],p0[r+3]);a=max3f(a,p1[r],p1[r+1]);b=max3f(b,p1[r+2],p1[r+3]);}
  const float m=max2f(a,b);
  auto rr=__builtin_amdgcn_permlane32_swap(__float_as_uint(m),__float_as_uint(m),false,false);
  return max2f(__uint_as_float(rr[0]),__uint_as_float(rr[1]));
}
__device__ __forceinline__ void pv(f32x16*o,int vb,bf16x8 pa0,bf16x8 pa1,bf16x8 pa2,bf16x8 pa3){
  #pragma unroll
  for(int d0=0;d0<4;++d0){s16x4 lo[4],hi[4];
    #pragma unroll
    for(int ks=0;ks<4;++ks){
      asm volatile("ds_read_b64_tr_b16 %0,%1 offset:%c2":"=&v"(lo[ks]):"v"(vb),"i"((d0>>1)*8192+(d0&1)*4096+ks*1024):"memory");
      asm volatile("ds_read_b64_tr_b16 %0,%1 offset:%c2":"=&v"(hi[ks]):"v"(vb),"i"((d0>>1)*8192+(d0&1)*4096+ks*1024+512):"memory");}
    asm volatile("s_waitcnt lgkmcnt(0)":::"memory");SBAR();
    #define PK(k) (bf16x8){lo[k][0],lo[k][1],lo[k][2],lo[k][3],hi[k][0],hi[k][1],hi[k][2],hi[k][3]}
    o[d0]=__builtin_amdgcn_mfma_f32_32x32x16_bf16(pa0,PK(0),o[d0],0,0,0);
    o[d0]=__builtin_amdgcn_mfma_f32_32x32x16_bf16(pa1,PK(1),o[d0],0,0,0);
    o[d0]=__builtin_amdgcn_mfma_f32_32x32x16_bf16(pa2,PK(2),o[d0],0,0,0);
    o[d0]=__builtin_amdgcn_mfma_f32_32x32x16_bf16(pa3,PK(3),o[d0],0,0,0);
    #undef PK
  }
}

#ifndef ATTN_STORE16
#define ATTN_STORE16(p,v) (*(u32x4*)(p)=(v))
#endif
template<int THRL> __device__ __forceinline__ void attn_unit(int qb,const bf16*Q,const bf16*__restrict__ Kh,const bf16*__restrict__ Vh,bf16*O,char*shm,int wave_id){
  int tid_=mk_tid(wave_id); const int tid=tid_,lane=tid&63,r32=lane&31,hi=lane>>5; const int wid=__builtin_amdgcn_readfirstlane(tid>>6);
  const int q0=qb*QB;
  const bf16*Qw=Q+(long)(q0+wid*QBLK)*PQ;
  const unsigned lds0=(unsigned)(uintptr_t)shm;
  float*wsf=(float*)(shm+LDS_WS)+wid*64;
  const bf16*ksrc=Kh+(long)lane*PK+wid*8;
  const bf16*vsrc=Vh+(long)(16*(wid&3)+(lane>>2))*PV+(wid>>2)*32+(lane&3)*8;
  const unsigned kdst=lds0+LDS_K+wid*1024, vdst=lds0+LDS_V+wid*1024;
  #define DMA_K(t,slot) glds16(ksrc+(long)(t)*KVBLK*PK,(unsigned)__builtin_amdgcn_readfirstlane(kdst+(slot)))
  #define DMA_V(t,slot) do{ glds16(vsrc+(long)(t)*KVBLK*PV,(unsigned)__builtin_amdgcn_readfirstlane(vdst+2*(slot))); glds16(vsrc+(long)(t)*KVBLK*PV+64,(unsigned)__builtin_amdgcn_readfirstlane(vdst+2*(slot)+SLOTB)); }while(0)
  const int vb0=(int)(lds0+LDS_V)+((lane>>4)&1)*32+(lane&3)*8+(4*hi+((lane&15)>>2))*64;
  const char*Kbase=shm+LDS_K; bf16x8 kf[8];
  const lds_cptr shm3=(lds_cptr)shm; const lds_cptr kp0=shm3+LDS_K+hi*1024+r32*16; const lds_cptr vp0=shm3+LDS_V+((lane>>4)&1)*32+(lane&3)*8+(4*hi+((lane&15)>>2))*64;
  const int NT=(q0+QB)/KVBLK;
  DMA_K(0,0);DMA_V(0,0);DMA_K(1,SLOTB);
  bf16x8 qr[4];
  #pragma unroll
  for(int d0=0;d0<4;++d0)qr[d0]=*reinterpret_cast<const bf16x8*>(&Qw[(long)r32*PQ+d0*16+hi*8]);
  float l_reg=0.f;f32x16 o[4];     o[0]=f32x16{};o[1]=f32x16{};o[2]=f32x16{};o[3]=f32x16{};f32x16 negm=f32x16{};asm volatile("":"+v"(negm));
  const int qrel=wid*QBLK+r32;
  #define CMASK(P0,P1,t) do{int jb_=(t)-(NT-4); if(jb_>=0)cmask(P0,P1,jb_,qrel,hi);}while(0)
  bool resc=false;
  #define START(P0,P1) do{ const float rm=rowmax(P0,P1); resc=false; \
    { const float dl=rm; const float nm_=-dl; \
      _Pragma("unroll") for(int r=0;r<16;++r){P0[r]=fsub_s(P0[r],dl);P1[r]=fsub_s(P1[r],dl);} \
      _Pragma("unroll") for(int r=0;r<16;++r)negm[r]=nm_; asm volatile("":"+v"(negm)); } \
    _Pragma("unroll") for(int r=0;r<16;++r)P0[r]=__builtin_amdgcn_exp2f(P0[r]); }while(0)
  #define RESC() do{ if(resc){ asm volatile("s_waitcnt lgkmcnt(0)":::"memory"); \
      _Pragma("unroll") for(int d_=0;d_<4;++d_) _Pragma("unroll") for(int r=0;r<16;++r)o[d_][r]*=wsf[crow(r,hi)]; } }while(0)
  f32x16 pA0,pA1,pB0,pB1;
  int sl_prev=0,sl_cur=0,sl_next=SLOTB;
  #define ROT() do{sl_prev=sl_cur;sl_cur=sl_next;sl_next=(sl_next==(NSLOT-1)*SLOTB)?0:sl_next+SLOTB;}while(0)
  DMA_K(2,2*SLOTB);
  WAIT_BAR(3);
  qkt(pA0,pA1,Kbase,qr,negm,r32,hi);asm volatile("s_nop 15\n\ts_nop 7":"+v"(pA0),"+v"(pA1));CMASK(pA0,pA1,0);
  START(pA0,pA1);
  _Pragma("unroll") for(int r=0;r<16;++r)pA1[r]=__builtin_amdgcn_exp2f(pA1[r]);
  WAIT_BAR(0);
  DMA_K(3,0);DMA_V(1,SLOTB);
  ROT();
  kload8(kf,kp0+sl_cur);
  WAIT_BAR(3);
  s16x4 vlo[8],vhi[8]; u32x4 pw0,pw1,pw2,pw3;
  #define PKW(P,B) cvtpk_s(P[B],P[B+1])
  #define PAF(k) __builtin_bit_cast(bf16x8,pw##k)
  #define VFR(i) (bf16x8){vlo[i][0],vlo[i][1],vlo[i][2],vlo[i][3],vhi[i][0],vhi[i][1],vhi[i][2],vhi[i][3]}
  #define PIN(x) asm volatile("":"+v"(x))
  #define MX3(a,b,c) __builtin_fmaxf(__builtin_fmaxf((a),(b)),(c))
  #define GAPA(MF,A0,A1,A2,A3,W0,W1,PW) do{ MF; sacc+=A0; sacc+=A1; sacc+=A2; sacc+=A3; PIN(sacc); W0; W1; PIN(PW); SBAR(); }while(0)
  #define EX(v) __builtin_amdgcn_exp2f(v)
  #define GAPB(MF,X,B) do{ MF; X[B]=EX(X[B]); X[B+1]=EX(X[B+1]); X[B+2]=EX(X[B+2]); X[B+3]=EX(X[B+3]); PIN(X); SBAR(); }while(0)
  #define VRD(i) do{ vlo[i]=vtr(vp_+(((i)>>2)*4096+((i)&3)*1024)); vhi[i]=vtr(vp_+(((i)>>2)*4096+((i)&3)*1024+512)); }while(0)
  #define VRD2(i) do{ wlo[i]=vtr(vp_+(8192+((i)>>2)*4096+((i)&3)*1024)); whi[i]=vtr(vp_+(8192+((i)>>2)*4096+((i)&3)*1024+512)); }while(0)
  #define WFR(i) (bf16x8){wlo[i][0],wlo[i][1],wlo[i][2],wlo[i][3],whi[i][0],whi[i][1],whi[i][2],whi[i][3]}
  #define KRD(G,j) do{ if(G){ kload2(kf,kp0+sl_next,j); SBAR(); } }while(0)
  #define STEP(C0,C1,P0,P1,t,GK,GV,GL) do{ SBAR(); \
    const lds_cptr vp_=vp0+2*sl_prev; \
    float sacc=(P0[0]+P0[1]); \
    GAPA(C0=__builtin_amdgcn_mfma_f32_32x32x16_bf16(kf[0],qr[0],negm,0,0,0), P0[2],P0[3],P0[4],P0[5],     pw0[0]=PKW(P0,0), pw0[1]=PKW(P0,2), pw0); \
    GAPA(C1=__builtin_amdgcn_mfma_f32_32x32x16_bf16(kf[1],qr[0],negm,0,0,0), P0[6],P0[7],P0[8],P0[9],     pw0[2]=PKW(P0,4), pw0[3]=PKW(P0,6), pw0); \
    GAPA(C0=__builtin_amdgcn_mfma_f32_32x32x16_bf16(kf[2],qr[1],C0,0,0,0),   P0[10],P0[11],P0[12],P0[13], pw1[0]=PKW(P0,8), pw1[1]=PKW(P0,10), pw1); \
    GAPA(C1=__builtin_amdgcn_mfma_f32_32x32x16_bf16(kf[3],qr[1],C1,0,0,0),   P0[14],P0[15],P1[0],P1[1],   pw1[2]=PKW(P0,12),pw1[3]=PKW(P0,14), pw1); \
    GAPA(C0=__builtin_amdgcn_mfma_f32_32x32x16_bf16(kf[4],qr[2],C0,0,0,0),   P1[2],P1[3],P1[4],P1[5],     pw2[0]=PKW(P1,0), pw2[1]=PKW(P1,2), pw2); \
    GAPA(C1=__builtin_amdgcn_mfma_f32_32x32x16_bf16(kf[5],qr[2],C1,0,0,0),   P1[6],P1[7],P1[8],P1[9],     pw2[2]=PKW(P1,4), pw2[3]=PKW(P1,6), pw2); \
    GAPA(C0=__builtin_amdgcn_mfma_f32_32x32x16_bf16(kf[6],qr[3],C0,0,0,0),   P1[10],P1[11],P1[12],P1[13], pw3[0]=PKW(P1,8), pw3[1]=PKW(P1,10), pw3); \
    GAPA(C1=__builtin_amdgcn_mfma_f32_32x32x16_bf16(kf[7],qr[3],C1,0,0,0),   P1[14],P1[15],0.f,0.f,       pw3[2]=PKW(P1,12),pw3[3]=PKW(P1,14), pw3); \
    l_reg+=sacc; \
    if(GK){DMA_K((t)+3,sl_cur);} if(GV){DMA_V((t)+1,sl_next);} \
    SBAR(); VRD(0); VRD(4); VRD(1); VRD(5); SBAR(); \
    CMASK(C0,C1,t); \
    { float a=MX3(C0[0],C0[1],C1[0]),b=MX3(C0[2],C0[3],C1[1]); a=MX3(a,C1[2],C1[3]); \
      _Pragma("unroll") for(int r=4;r<16;r+=4){a=MX3(a,C0[r],C0[r+1]);b=MX3(b,C0[r+2],C0[r+3]);a=MX3(a,C1[r],C1[r+1]);b=MX3(b,C1[r+2],C1[r+3]);} \
      float rm=__builtin_fmaxf(a,b); { auto rr=__builtin_amdgcn_permlane32_swap(__float_as_uint(rm),__float_as_uint(rm),false,false); rm=__builtin_fmaxf(__uint_as_float(rr[0]),__uint_as_float(rr[1])); } \
      resc=false; \
      if(__builtin_expect(__any(rm>(float)THRL),0)){ const float dl=__builtin_fmaxf(rm,0.f); const float nm_=negm[0]-dl; \
        _Pragma("unroll") for(int r=0;r<16;++r){C0[r]-=dl;C1[r]-=dl;} \
        _Pragma("unroll") for(int r=0;r<16;++r)negm[r]=nm_; asm volatile("":"+v"(negm)); \
        const float f=__builtin_amdgcn_exp2f(-dl); l_reg*=f; { int r32_=lane; asm volatile("":"+v"(r32_)); if(r32_<32)wsf[r32_]=f; } resc=true; } } \
    SBAR(); \
    VRD(2); SBAR(); GAPB(o[0]=__builtin_amdgcn_mfma_f32_32x32x16_bf16(PAF(0),VFR(0),o[0],0,0,0), C0,0); \
    VRD(6); SBAR(); GAPB(o[1]=__builtin_amdgcn_mfma_f32_32x32x16_bf16(PAF(0),VFR(4),o[1],0,0,0), C0,4); \
    VRD(3); SBAR(); KRD(GL,0); GAPB(o[0]=__builtin_amdgcn_mfma_f32_32x32x16_bf16(PAF(1),VFR(1),o[0],0,0,0), C0,8); \
    VRD(7); SBAR(); KRD(GL,1); GAPB(o[1]=__builtin_amdgcn_mfma_f32_32x32x16_bf16(PAF(1),VFR(5),o[1],0,0,0), C0,12); \
    KRD(GL,2); GAPB(o[0]=__builtin_amdgcn_mfma_f32_32x32x16_bf16(PAF(2),VFR(2),o[0],0,0,0), C1,0); \
    KRD(GL,3); GAPB(o[1]=__builtin_amdgcn_mfma_f32_32x32x16_bf16(PAF(2),VFR(6),o[1],0,0,0), C1,4); \
    s16x4 wlo[8],whi[8]; \
    GAPB(o[0]=__builtin_amdgcn_mfma_f32_32x32x16_bf16(PAF(3),VFR(3),o[0],0,0,0), C1,8); \
    GAPB(o[1]=__builtin_amdgcn_mfma_f32_32x32x16_bf16(PAF(3),VFR(7),o[1],0,0,0), C1,12); \
    VRD2(0); VRD2(4); VRD2(1); SBAR(); o[2]=__builtin_amdgcn_mfma_f32_32x32x16_bf16(PAF(0),WFR(0),o[2],0,0,0); SBAR(); \
    VRD2(5); SBAR(); o[3]=__builtin_amdgcn_mfma_f32_32x32x16_bf16(PAF(0),WFR(4),o[3],0,0,0); SBAR(); \
    VRD2(2); SBAR(); o[2]=__builtin_amdgcn_mfma_f32_32x32x16_bf16(PAF(1),WFR(1),o[2],0,0,0); SBAR(); \
    VRD2(6); SBAR(); o[3]=__builtin_amdgcn_mfma_f32_32x32x16_bf16(PAF(1),WFR(5),o[3],0,0,0); SBAR(); \
    VRD2(3); SBAR(); o[2]=__builtin_amdgcn_mfma_f32_32x32x16_bf16(PAF(2),WFR(2),o[2],0,0,0); SBAR(); \
    VRD2(7); SBAR(); o[3]=__builtin_amdgcn_mfma_f32_32x32x16_bf16(PAF(2),WFR(6),o[3],0,0,0); SBAR(); \
    o[2]=__builtin_amdgcn_mfma_f32_32x32x16_bf16(PAF(3),WFR(3),o[2],0,0,0); SBAR(); \
    o[3]=__builtin_amdgcn_mfma_f32_32x32x16_bf16(PAF(3),WFR(7),o[3],0,0,0); SBAR(); \
    }while(0)
  int t=1;
  #undef CMASK
  #define CMASK(P0,P1,t) do{}while(0)
  for(;t+5<NT;t+=2){
    STEP(pB0,pB1,pA0,pA1,t,true,true,true);     WAIT_BAR(3); RESC(); ROT();
    STEP(pA0,pA1,pB0,pB1,t+1,true,true,true);   WAIT_BAR(3); RESC(); ROT();
  }
  #undef CMASK
  #define CMASK(P0,P1,t) do{int jb_=(t)-(NT-4); if(jb_>=0)cmask(P0,P1,jb_,qrel,hi);}while(0)
  #define ENDW(tt) do{ if((tt)+3<NT){WAIT_BAR(3);} else if((tt)+2<NT){WAIT_BAR(2);} else {WAIT_BAR(0);} }while(0)
  for(;t+1<NT;t+=2){
    STEP(pB0,pB1,pA0,pA1,t,(t+3<NT),(t+1<NT),(t+1<NT));       ENDW(t);   RESC(); ROT();
    STEP(pA0,pA1,pB0,pB1,t+1,(t+4<NT),(t+2<NT),(t+2<NT));     ENDW(t+1); RESC(); ROT();
  }
  STEP(pB0,pB1,pA0,pA1,NT-1,false,false,false); RESC();
  { float sacc=pB0[0]+pB0[1]; _Pragma("unroll") for(int r=2;r<16;++r)sacc+=pB0[r]; _Pragma("unroll") for(int r=0;r<16;++r)sacc+=pB1[r]; l_reg+=sacc;
    pw0=(u32x4){PKW(pB0,0),PKW(pB0,2),PKW(pB0,4),PKW(pB0,6)};pw1=(u32x4){PKW(pB0,8),PKW(pB0,10),PKW(pB0,12),PKW(pB0,14)};pw2=(u32x4){PKW(pB1,0),PKW(pB1,2),PKW(pB1,4),PKW(pB1,6)};pw3=(u32x4){PKW(pB1,8),PKW(pB1,10),PKW(pB1,12),PKW(pB1,14)};
    SBAR(); pv(o,vb0+2*sl_cur,PAF(0),PAF(1),PAF(2),PAF(3)); }
  #undef PKW
  #undef PAF
  #undef VFR
  #undef PIN
  #undef MX3
  #undef GAPA
  #undef GAPB
  #undef EX
  #undef VRD
  #undef VRD2
  #undef WFR
  #undef KRD
  #undef STEP
  #undef ENDW
  {auto rr=__builtin_amdgcn_permlane32_swap(__float_as_uint(l_reg),__float_as_uint(l_reg),false,false);l_reg=__uint_as_float(rr[0])+__uint_as_float(rr[1]);}
  if(hi==0)wsf[32+r32]=l_reg;asm volatile("s_waitcnt lgkmcnt(0)":::"memory");
  float rli[16];
  #pragma unroll
  for(int r=0;r<16;++r)rli[r]=__builtin_amdgcn_rcpf(wsf[32+crow(r,hi)]);
  bf16*Ow=O+(long)(q0+wid*QBLK)*PO;
  { bf16*stg=(bf16*)(shm+LDS_OST)+wid*4096;
    #pragma unroll
    for(int r=0;r<16;++r){const int orow=crow(r,hi);
      #pragma unroll
      for(int d0=0;d0<4;++d0)stg[orow*128+d0*32+r32]=__float2bfloat16(o[d0][r]*rli[r]);}
    asm volatile("s_waitcnt lgkmcnt(0)":::"memory");
    #pragma unroll
    for(int i=0;i<8;++i){const int row=i*4+(lane>>4),ch=lane&15; const u32x4 v=*(const u32x4*)(stg+row*128+ch*8); ATTN_STORE16(Ow+(long)row*PO+ch*8,v);} }
  asm volatile("s_waitcnt lgkmcnt(0)\n\ts_barrier":::"memory");
  #undef DMA_K
  #undef DMA_V
  #undef CMASK
  #undef START
  #undef RESC
  #undef ROT
}
constexpr int ATTN_LDS_BYTES=LDS_BYTES;
#undef SBAR
#undef WAIT_BAR
}
namespace cg = cooperative_groups;
#define GAS __attribute__((address_space(1)))
#define LAS __attribute__((address_space(3)))
typedef unsigned short bf16;
typedef unsigned v4u __attribute__((ext_vector_type(4)));
typedef unsigned v2u __attribute__((ext_vector_type(2)));
typedef float f32x4 __attribute__((ext_vector_type(4)));
typedef short bf16x8 __attribute__((ext_vector_type(8)));
typedef short s16x4 __attribute__((ext_vector_type(4)));

#ifndef MK_ONE_LAUNCH
#define MK_ONE_LAUNCH 1
#endif
constexpr int NWAVES = 8;
constexpr int SEQ = 16384, DM = 1024, NIN = 8704, NMAIN = 5632, NGATE = 3072, DEPTH = 2;
constexpr float EPS = 1e-6f;
constexpr float QSCALE = 0.125f * 1.4426950408889634f;
constexpr size_t MiB = 1u << 20;
constexpr size_t WS_ROPE = 0;
constexpr size_t WS_WIN = 1 * MiB;
constexpr size_t WS_WB = 18 * MiB;
constexpr size_t WS_WO = 21 * MiB;
constexpr size_t WS_HB = 23 * MiB;
constexpr size_t WS_O = 55 * MiB;
constexpr size_t WS_PJ = 87 * MiB;
constexpr size_t SLOT_ELEMS = (size_t)SEQ * 512;
constexpr int YP = 1536;
constexpr size_t WS_BAR = WS_PJ + 11 * SLOT_ELEMS * 2;
constexpr size_t WS_END = WS_BAR + 65536;
enum { SL_AQ = 0, SL_AK = 1, SL_AV = 2, SL_BU = 3, SL_BV = 4, SL_CQ = 5, SL_CK = 6, SL_CV = 7, SL_AZ = 8, SL_BZ = 9, SL_CZ = 10 };

constexpr int LDS_BYTES = 147456;

__device__ __forceinline__ unsigned f2bf(float f) { unsigned u = __builtin_bit_cast(unsigned, f); return (u + 0x7fffu + ((u >> 16) & 1u)) >> 16; }
typedef float f32x2_t __attribute__((ext_vector_type(2))); typedef __bf16 bf16x2_t __attribute__((ext_vector_type(2)));
__device__ __forceinline__ unsigned pk2(float lo, float hi) { f32x2_t v = {lo, hi}; bf16x2_t b = __builtin_convertvector(v, bf16x2_t); return __builtin_bit_cast(unsigned, b); }
__device__ __forceinline__ float bflo(unsigned w) { return __uint_as_float(w << 16); }
__device__ __forceinline__ float bfhi(unsigned w) { return __uint_as_float(w & 0xffff0000u); }
__device__ __forceinline__ float fexp2(float x) { return __builtin_amdgcn_exp2f(x); }
__device__ __forceinline__ float frcp(float x) { return __builtin_amdgcn_rcpf(x); }
__device__ __forceinline__ float sigmoid_f(float x) { return frcp(1.f + fexp2(-1.4426950408889634f * x)); }
__device__ __forceinline__ float silu_f(float x) { return x * sigmoid_f(x); }
__device__ __forceinline__ float gelu_tanh_f(float x) { const float y = 0.7978845608028654f * (x + 0.044715f * x * x * x); return x * frcp(1.f + fexp2(-2.885390081777927f * y)); }
__device__ __forceinline__ float wave_sum(float v) {
#pragma unroll
    for (int o = 1; o < 64; o <<= 1) v += __shfl_xor(v, o);
    return v;
}

struct EpiProj {
    static constexpr bool PERM = true, AFTER_DRAIN = false;
    bf16* PJ; const float* rc; const float* rs;
    __device__ __forceinline__ void operator()(const f32x4 (&acc)[2][2][4][2], const pg8::Unit& u, int wr, int wc, int fr_, int fq_) const {
        int fr = fr_, fq = fq_; asm volatile("" : "+v"(fr), "+v"(fq));
        const int grp = u.pn >> 1;
        const int slot = (int)((0xA7659438210ull >> (4 * grp)) & 15ull);
        const int act = (int)((0x10341221034ull >> (4 * grp)) & 15ull);
        const bool isy = (act == 1); const int pitch = isy ? YP : 512;
        bf16* base = isy ? PJ + (size_t)SL_AZ * SLOT_ELEMS + (grp == 3 ? 0 : (grp == 6 ? 512 : 1024)) : PJ + (size_t)slot * SLOT_ELEMS;
        const int row0 = u.pm * 256 + wr * 64 + fr, col0 = (u.pn & 1) * 256 + wc * 32 + 8 * fq;
        const bool ropew = (act >= 3) && ((wc & 1) == 0);
        const float sgn = (fq == 0) ? -1.f : 1.f; const bool ropel = fq < 2;
        const float qs = (act == 4) ? QSCALE : 1.f;
#pragma unroll
        for (int ai = 0; ai < 2; ++ai) {
            f32x4 Cc[4][2], Ss[4][2];
            if (ropew) {
#pragma unroll
                for (int m = 0; m < 4; ++m) { const int row = row0 + ai * 128 + m * 16;
                    Cc[m][0] = *(const f32x4*)(rc + row * 8); Cc[m][1] = *(const f32x4*)(rc + row * 8 + 4); Ss[m][0] = *(const f32x4*)(rs + row * 8); Ss[m][1] = *(const f32x4*)(rs + row * 8 + 4); }
                __builtin_amdgcn_sched_barrier(0);
            }
#pragma unroll
            for (int m = 0; m < 4; ++m) {
                const int row = row0 + ai * 128 + m * 16;
#pragma unroll
                for (int bj = 0; bj < 2; ++bj) {
                    f32x4 v0 = acc[ai][bj][m][0], v1 = acc[ai][bj][m][1];
                    if (ropew) {
                        f32x4 o0, o1;
#pragma unroll
                        for (int e = 0; e < 4; ++e) { o0[e] = __shfl_xor(v0[e], 16); o1[e] = __shfl_xor(v1[e], 16); }
                        if (ropel) { v0 = v0 * Cc[m][0] + sgn * (o0 * Ss[m][0]); v1 = v1 * Cc[m][1] + sgn * (o1 * Ss[m][1]); }
                    }
                    if (act == 1) {
#pragma unroll
                        for (int e = 0; e < 4; ++e) { v0[e] = silu_f(v0[e]); v1[e] = silu_f(v1[e]); }
                    } else if (act == 2) {
#pragma unroll
                        for (int e = 0; e < 4; ++e) { v0[e] = gelu_tanh_f(v0[e]); v1[e] = gelu_tanh_f(v1[e]); }
                    }
                    v0 = v0 * qs; v1 = v1 * qs;
                    v4u w; w.x = pk2(v0[0], v0[1]); w.y = pk2(v0[2], v0[3]); w.z = pk2(v1[0], v1[1]); w.w = pk2(v1[2], v1[3]);
                    *(v4u*)(base + (size_t)row * pitch + col0 + bj * 128) = w;
                }
            }
            asm volatile("" ::: "memory");
        }
    }
};
struct EpiGate {
    static constexpr bool PERM = true, AFTER_DRAIN = false;
    bf16* GL;
    __device__ __forceinline__ void operator()(const f32x4 (&acc)[2][2][4][2], const pg8::Unit& u, int wr, int wc, int fr_, int fq_) const {
        int fr = fr_, fq = fq_; asm volatile("" : "+v"(fr), "+v"(fq));
        const int row0 = u.pm * 256 + wr * 64 + fr, col0 = u.pn * 256 + wc * 32 + 8 * fq;
#pragma unroll
        for (int ai = 0; ai < 2; ++ai)
#pragma unroll
            for (int m = 0; m < 4; ++m) {
                const int row = row0 + ai * 128 + m * 16;
#pragma unroll
                for (int bj = 0; bj < 2; ++bj) {
                    f32x4 v0 = acc[ai][bj][m][0], v1 = acc[ai][bj][m][1];
#pragma unroll
                    for (int e = 0; e < 4; ++e) { v0[e] = sigmoid_f(v0[e]); v1[e] = sigmoid_f(v1[e]); }
                    v4u w; w.x = pk2(v0[0], v0[1]); w.y = pk2(v0[2], v0[3]); w.z = pk2(v1[0], v1[1]); w.w = pk2(v1[2], v1[3]);
                    *(v4u*)(GL + (size_t)row * NGATE + col0 + bj * 128) = w; asm volatile("" ::: "memory");
                }
            }
    }
};
__device__ __forceinline__ float gclamp(float g) { return fmaxf(g, 1e-6f); }
struct MergeHook {
    static constexpr int PERIOD = 8;
    const bf16* GL;
    __device__ __forceinline__ void operator()(f32x4 (&acc)[2][2][4][2], const pg8::Unit& u, int seg, int wr, int wc, int fr_, int fq_) const {
        int fr = fr_, fq = fq_; asm volatile("" : "+v"(fr), "+v"(fq));
        const int row0 = u.pm * 256 + wr * 64 + fr, col0 = u.pn * 256 + wc * 32 + 8 * fq;
        const bf16* gn = GL + (seg - 1) * 1024 + col0; const bf16* gd = GL + seg * 1024 + col0; const bool cl = seg > 1;
#pragma unroll
        for (int ai = 0; ai < 2; ++ai) {
            v4u A[4][2], B[4][2];
#pragma unroll
            for (int m = 0; m < 4; ++m)
#pragma unroll
                for (int bj = 0; bj < 2; ++bj) { const size_t ro = (size_t)(row0 + ai * 128 + m * 16) * NGATE + bj * 128; A[m][bj] = *(const v4u*)(gn + ro); B[m][bj] = *(const v4u*)(gd + ro); }
            __builtin_amdgcn_sched_barrier(0);
#pragma unroll
            for (int m = 0; m < 4; ++m)
#pragma unroll
                for (int bj = 0; bj < 2; ++bj) {
                    const v4u a = A[m][bj], b = B[m][bj];
                    float n_[8] = {bflo(a.x), bfhi(a.x), bflo(a.y), bfhi(a.y), bflo(a.z), bfhi(a.z), bflo(a.w), bfhi(a.w)};
                    float d_[8] = {bflo(b.x), bfhi(b.x), bflo(b.y), bfhi(b.y), bflo(b.z), bfhi(b.z), bflo(b.w), bfhi(b.w)};
#pragma unroll
                    for (int e = 0; e < 8; ++e) { const float nn = cl ? gclamp(n_[e]) : n_[e]; const float rr = nn * frcp(gclamp(d_[e])); if (e < 4) acc[ai][bj][m][0][e] *= rr; else acc[ai][bj][m][1][e - 4] *= rr; }
                }
            asm volatile("" ::: "memory");
        }
    }
};
struct EpiMerge {
    static constexpr bool PERM = true, AFTER_DRAIN = false;
    const bf16* GL; bf16* MG;
    __device__ __forceinline__ void operator()(const f32x4 (&acc)[2][2][4][2], const pg8::Unit& u, int wr, int wc, int fr_, int fq_) const {
        int fr = fr_, fq = fq_; asm volatile("" : "+v"(fr), "+v"(fq));
        const int row0 = u.pm * 256 + wr * 64 + fr, col0 = u.pn * 256 + wc * 32 + 8 * fq;
#pragma unroll
        for (int ai = 0; ai < 2; ++ai) {
            v4u Gt[4][2];
#pragma unroll
            for (int m = 0; m < 4; ++m)
#pragma unroll
                for (int bj = 0; bj < 2; ++bj) Gt[m][bj] = *(const v4u*)(GL + (size_t)(row0 + ai * 128 + m * 16) * NGATE + 2 * 1024 + col0 + bj * 128);
            __builtin_amdgcn_sched_barrier(0);
#pragma unroll
            for (int m = 0; m < 4; ++m)
#pragma unroll
                for (int bj = 0; bj < 2; ++bj) {
                    const int row = row0 + ai * 128 + m * 16; const v4u g = Gt[m][bj];
                    f32x4 v0 = acc[ai][bj][m][0], v1 = acc[ai][bj][m][1];
                    v0[0] *= gclamp(bflo(g.x)); v0[1] *= gclamp(bfhi(g.x)); v0[2] *= gclamp(bflo(g.y)); v0[3] *= gclamp(bfhi(g.y));
                    v1[0] *= gclamp(bflo(g.z)); v1[1] *= gclamp(bfhi(g.z)); v1[2] *= gclamp(bflo(g.w)); v1[3] *= gclamp(bfhi(g.w));
                    v4u w; w.x = pk2(v0[0], v0[1]); w.y = pk2(v0[2], v0[3]); w.z = pk2(v1[0], v1[1]); w.w = pk2(v1[2], v1[3]);
                    *(v4u*)(MG + (size_t)row * DM + col0 + bj * 128) = w;
                }
            asm volatile("" ::: "memory");
        }
    }
};
struct EpiOut {
    static constexpr bool PERM = true, AFTER_DRAIN = false;
    const float* res; float* out;
    __device__ __forceinline__ void operator()(const f32x4 (&acc)[2][2][4][2], const pg8::Unit& u, int wr, int wc, int fr_, int fq_) const {
        int fr = fr_, fq = fq_; asm volatile("" : "+v"(fr), "+v"(fq));
        const int row0 = u.pm * 256 + wr * 64 + fr, col0 = u.pn * 256 + wc * 32 + 8 * fq;
#pragma unroll
        for (int ai = 0; ai < 2; ++ai) {
            f32x4 R[4][2][2];
#pragma unroll
            for (int m = 0; m < 4; ++m)
#pragma unroll
                for (int bj = 0; bj < 2; ++bj) { const size_t off = (size_t)(row0 + ai * 128 + m * 16) * DM + col0 + bj * 128; R[m][bj][0] = *(const f32x4*)(res + off); R[m][bj][1] = *(const f32x4*)(res + off + 4); }
            __builtin_amdgcn_sched_barrier(0);
#pragma unroll
            for (int m = 0; m < 4; ++m)
#pragma unroll
                for (int bj = 0; bj < 2; ++bj) { const size_t off = (size_t)(row0 + ai * 128 + m * 16) * DM + col0 + bj * 128;
                    *(f32x4*)(out + off) = R[m][bj][0] + acc[ai][bj][m][0]; *(f32x4*)(out + off + 4) = R[m][bj][1] + acc[ai][bj][m][1]; }
            asm volatile("" ::: "memory");
        }
    }
};

__device__ __forceinline__ void p0_transpose_item(const float* W, int K, int N, bf16* WT, int ldk, LAS float* scr, int item, int lane) {
    const int nblk = N / 32, kb = item / nblk, nb = item % nblk, k0 = 64 * kb, n0 = 32 * nb;
#pragma unroll 8
    for (int i = 0; i < 32; ++i) { const int kk = 2 * i + (lane >> 5); scr[kk * 33 + (lane & 31)] = W[(size_t)(k0 + kk) * N + n0 + (lane & 31)]; }
    asm volatile("s_waitcnt lgkmcnt(0)" ::: "memory");
    const int c = lane & 7;
#pragma unroll
    for (int j = 0; j < 4; ++j) { const int n = (lane >> 3) + 8 * j; const LAS float* s = scr + (8 * c) * 33 + n;
        v4u o; o.x = pk2(s[0 * 33], s[1 * 33]); o.y = pk2(s[2 * 33], s[3 * 33]); o.z = pk2(s[4 * 33], s[5 * 33]); o.w = pk2(s[6 * 33], s[7 * 33]);
        *(v4u*)(WT + (size_t)(n0 + n) * ldk + k0 + 8 * c) = o; }
    asm volatile("s_waitcnt lgkmcnt(0)" ::: "memory");
}
template <int NR, bool OUTBF> __device__ __forceinline__ void rms_rows(const float* x, size_t rstride, const float* g, void* o, int lane) {
    f32x4 v[NR][4]; float r[NR];
#pragma unroll
    for (int k = 0; k < NR; ++k)
#pragma unroll
        for (int j = 0; j < 4; ++j) v[k][j] = ((const f32x4*)(x + k * rstride) + lane)[64 * j];
#pragma unroll
    for (int k = 0; k < NR; ++k) { float s = 0.f;
#pragma unroll
        for (int j = 0; j < 4; ++j) s += (v[k][j].x * v[k][j].x + v[k][j].y * v[k][j].y) + (v[k][j].z * v[k][j].z + v[k][j].w * v[k][j].w);
        r[k] = 1.f / sqrtf(wave_sum(s) * (1.f / DM) + EPS); }
    const f32x4* gr = (const f32x4*)g + lane;
#pragma unroll
    for (int j = 0; j < 4; ++j) { const f32x4 gg = gr[64 * j];
#pragma unroll
        for (int k = 0; k < NR; ++k) { const f32x4 y = v[k][j] * r[k] * gg;
            if (OUTBF) ((unsigned long long*)((bf16*)o + k * rstride) + lane)[64 * j] = (unsigned long long)pk2(y.x, y.y) | ((unsigned long long)pk2(y.z, y.w) << 32);
            else ((f32x4*)((float*)o + k * rstride) + lane)[64 * j] = y; } }
}
constexpr int SGU_P = 136;
__device__ __forceinline__ void sgu_item(int item, const bf16* BU, const bf16* BV, bf16* BZ, const float* lng, const float* lnb, const float* sw, const float* sb,
                                         LAS unsigned char* lds, int tid, int wid, int lane) {
    const int n = item >> 2, g = item & 3, tok0 = n * 128;
    LAS bf16* Wl = (LAS bf16*)lds; LAS bf16* Vt = (LAS bf16*)(lds + 128 * SGU_P * 2); LAS float* st = (LAS float*)(lds + 2 * 128 * SGU_P * 2);
    const int r = lane & 15, q = lane >> 4, t = wid * 16 + r;
    v4u w16[16];
#pragma unroll
    for (int i = 0; i < 16; ++i) w16[i] = *(const v4u*)(BV + (size_t)(tok0 + wid * 16 + i) * 512 + lane * 8);
    v4u vst[4]; f32x4 G0[4], G1[4], B0[4], B1[4];
#pragma unroll
    for (int k = 0; k < 4; ++k) { const int idx = tid + 512 * k, s_ = idx >> 4, cch = idx & 15;
        vst[k] = *(const v4u*)(BV + (size_t)(tok0 + s_) * 512 + g * 128 + cch * 8);
        G0[k] = *(const f32x4*)(lng + g * 128 + cch * 8); G1[k] = *(const f32x4*)(lng + g * 128 + cch * 8 + 4); B0[k] = *(const f32x4*)(lnb + g * 128 + cch * 8); B1[k] = *(const f32x4*)(lnb + g * 128 + cch * 8 + 4); }
    f32x4 wW[8];
#pragma unroll
    for (int k = 0; k < 8; ++k) { const int idx = tid + 512 * k, tt = idx >> 5, s4 = (idx & 31) * 4; wW[k] = *(const f32x4*)(sw + ((size_t)g * 128 + tt) * 128 + s4); }
    v2u uu[8], zz[8];
#pragma unroll
    for (int ct = 0; ct < 8; ++ct) { uu[ct] = *(const v2u*)(BU + (size_t)(tok0 + t) * 512 + g * 128 + ct * 16 + q * 4); zz[ct] = *(const v2u*)(BZ + (size_t)(tok0 + t) * YP + g * 128 + ct * 16 + q * 4); }
    const float bias = sb[g * 128 + t];
    __builtin_amdgcn_sched_barrier(0);
#pragma unroll
    for (int i = 0; i < 16; ++i) {
        const int s_ = wid * 16 + i; const v4u w = w16[i];
        const float a0 = bflo(w.x), a1 = bfhi(w.x), a2 = bflo(w.y), a3 = bfhi(w.y), a4 = bflo(w.z), a5 = bfhi(w.z), a6 = bflo(w.w), a7 = bfhi(w.w);
        const float mu = wave_sum(((a0 + a1) + (a2 + a3)) + ((a4 + a5) + (a6 + a7))) * (1.f / 512.f);
        const float d0 = a0 - mu, d1 = a1 - mu, d2 = a2 - mu, d3 = a3 - mu, d4 = a4 - mu, d5 = a5 - mu, d6 = a6 - mu, d7 = a7 - mu;
        const float var = wave_sum(((d0 * d0 + d1 * d1) + (d2 * d2 + d3 * d3)) + ((d4 * d4 + d5 * d5) + (d6 * d6 + d7 * d7))) * (1.f / 512.f);
        if (lane == 0) { st[s_] = mu; st[128 + s_] = 1.f / sqrtf(var + EPS); }
    }
    __syncthreads();
#pragma unroll
    for (int k = 0; k < 4; ++k) {
        const int idx = tid + 512 * k, s_ = idx >> 4, cch = idx & 15; const v4u w = vst[k];
        const float mu = st[s_], rstd = st[128 + s_];
        float a[8] = {bflo(w.x), bfhi(w.x), bflo(w.y), bfhi(w.y), bflo(w.z), bfhi(w.z), bflo(w.w), bfhi(w.w)};
#pragma unroll
        for (int e = 0; e < 8; ++e) { const float gg = e < 4 ? G0[k][e & 3] : G1[k][e & 3], bb = e < 4 ? B0[k][e & 3] : B1[k][e & 3]; a[e] = (a[e] - mu) * rstd * gg + bb; }
        v4u o; o.x = pk2(a[0], a[1]); o.y = pk2(a[2], a[3]); o.z = pk2(a[4], a[5]); o.w = pk2(a[6], a[7]);
        *(LAS v4u*)(Vt + s_ * SGU_P + cch * 8) = o;
    }
#pragma unroll
    for (int k = 0; k < 8; ++k) {
        const int idx = tid + 512 * k, tt = idx >> 5, s4 = (idx & 31) * 4; const f32x4 w = wW[k];
        v2u o; o.x = pk2(s4 + 0 <= tt ? w.x : 0.f, s4 + 1 <= tt ? w.y : 0.f); o.y = pk2(s4 + 2 <= tt ? w.z : 0.f, s4 + 3 <= tt ? w.w : 0.f);
        *(LAS v2u*)(Wl + tt * SGU_P + s4) = o;
    }
    __syncthreads();
    typedef short v4i16_t __attribute__((ext_vector_type(4)));
    f32x4 acc[8];
#pragma unroll
    for (int ct = 0; ct < 8; ++ct) acc[ct] = (f32x4){0.f, 0.f, 0.f, 0.f};
#pragma unroll
    for (int ks = 0; ks < 4; ++ks) {
        const bf16x8 wf = *(const LAS bf16x8*)(Wl + (wid * 16 + r) * SGU_P + ks * 32 + q * 8);
#pragma unroll
        for (int ct = 0; ct < 8; ++ct) {
            const LAS bf16* tp = Vt + (ks * 32 + q * 8 + ((r >> 2) & 3)) * SGU_P + ct * 16 + (r & 3) * 4;
            const s16x4 lo = __builtin_bit_cast(s16x4, __builtin_amdgcn_ds_read_tr16_b64_v4i16((LAS v4i16_t*)tp));
            const s16x4 hi = __builtin_bit_cast(s16x4, __builtin_amdgcn_ds_read_tr16_b64_v4i16((LAS v4i16_t*)(tp + 4 * SGU_P)));
            const bf16x8 vf = (bf16x8){lo[0], lo[1], lo[2], lo[3], hi[0], hi[1], hi[2], hi[3]};
            acc[ct] = __builtin_amdgcn_mfma_f32_16x16x32_bf16(vf, wf, acc[ct], 0, 0, 0);
        }
    }
#pragma unroll
    for (int ct = 0; ct < 8; ++ct) {
        const size_t offz = (size_t)(tok0 + t) * YP + g * 128 + ct * 16 + q * 4;
        v2u o; o.x = pk2((acc[ct][0] + bias) * bflo(uu[ct].x) * bflo(zz[ct].x), (acc[ct][1] + bias) * bfhi(uu[ct].x) * bfhi(zz[ct].x));
        o.y = pk2((acc[ct][2] + bias) * bflo(uu[ct].y) * bflo(zz[ct].y), (acc[ct][3] + bias) * bfhi(uu[ct].y) * bfhi(zz[ct].y));
        *(v2u*)(BZ + offz) = o;
    }
    __syncthreads();
}

constexpr int CM_PB = 144, CM_NG = 4, CM_BLK = 128 * CM_NG;
constexpr int CM_S0 = (CM_BLK + 128) / 32, CM_S1 = (512 + CM_BLK - 8 + 4 * 32 - 1) / (4 * 32), CM_S2 = (2048 + CM_BLK - 8 + 8 * 32 - 1) / (8 * 32), CM_NSTEP = CM_S0 + CM_S1 + CM_S2;
struct CmStep { int kbase, sl, window, dmask, kk0; };
__device__ __forceinline__ CmStep cm_step(int j, int T0, int wid) {
    CmStep p;
    if (j < CM_S0) { p.kbase = T0 - 128; p.sl = 0; p.window = 128; p.dmask = 0; p.kk0 = 32 * j; }
    else if (j < CM_S0 + CM_S1) { p.kbase = T0 + wid - 512; p.sl = 2; p.window = 512; p.dmask = 0; p.kk0 = 32 * (j - CM_S0); }
    else { p.kbase = T0 + wid - 2048; p.sl = 3; p.window = 2048; p.dmask = 15; p.kk0 = 32 * (j - CM_S0 - CM_S1); }
    return p;
}
__device__ __forceinline__ void cm_load(int j, int T0, int wid, int h, int r, int q, int vkey, int vch, const bf16* CK, const bf16* CV, bf16x8 (&kf)[4], bf16x8 (&vv)[4]) {
    if (j >= CM_NSTEP) return;
    const CmStep p = cm_step(j, T0, wid);
    int tA = p.kbase + ((p.kk0 + r) << p.sl), tB = p.kbase + ((p.kk0 + 16 + r) << p.sl);
    tA = min(max(tA, 0), SEQ - 1); tB = min(max(tB, 0), SEQ - 1);
    const bf16* pa = CK + (size_t)tA * 512 + h * 64 + q * 8; const bf16* pb = CK + (size_t)tB * 512 + h * 64 + q * 8;
    kf[0] = *(const bf16x8*)pa; kf[1] = *(const bf16x8*)(pa + 32); kf[2] = *(const bf16x8*)pb; kf[3] = *(const bf16x8*)(pb + 32);
#pragma unroll
    for (int c = 0; c < 4; ++c) { int tv = p.kbase + ((p.kk0 + vkey + 8 * c) << p.sl); tv = min(max(tv, 0), SEQ - 1); vv[c] = *(const bf16x8*)(CV + (size_t)tv * 512 + h * 64 + vch * 8); }
}
struct CmQ { bf16x8 qf[2]; float mrun, lpart; f32x4 o[4]; int tq; };
__device__ __forceinline__ void cm_group(const CmStep& p, int r, int q, LAS unsigned char* Vl, const bf16x8 (&kf)[4], CmQ& Q, const s16x4 (&lo)[4], const s16x4 (&hi)[4]) {
    f32x4 sA = (f32x4){0.f, 0.f, 0.f, 0.f}, sB = sA;
    sA = __builtin_amdgcn_mfma_f32_16x16x32_bf16(kf[0], Q.qf[0], sA, 0, 0, 0); sA = __builtin_amdgcn_mfma_f32_16x16x32_bf16(kf[1], Q.qf[1], sA, 0, 0, 0);
    sB = __builtin_amdgcn_mfma_f32_16x16x32_bf16(kf[2], Q.qf[0], sB, 0, 0, 0); sB = __builtin_amdgcn_mfma_f32_16x16x32_bf16(kf[3], Q.qf[1], sB, 0, 0, 0);
    float sv[8]; bool ok[8]; float mx = -1e30f;
    const int R = Q.tq - p.kbase - ((p.kk0 + 4 * q) << p.sl); const unsigned lim = (unsigned)min(p.window, Q.tq);
#pragma unroll
    for (int jj = 0; jj < 8; ++jj) {
        const int rel = R - ((((jj < 4) ? 0 : 16) + (jj & 3)) << p.sl);
        ok[jj] = ((unsigned)rel <= lim) && ((rel & p.dmask) == 0);
        sv[jj] = ok[jj] ? (jj < 4 ? sA[jj & 3] : sB[jj & 3]) : -1e30f; mx = fmaxf(mx, sv[jj]);
    }
    mx = fmaxf(mx, __shfl_xor(mx, 16)); mx = fmaxf(mx, __shfl_xor(mx, 32));
    const float mnew = fmaxf(Q.mrun, mx), alpha = fexp2(Q.mrun - mnew); Q.mrun = mnew;
    float pp[8], ps = 0.f;
#pragma unroll
    for (int jj = 0; jj < 8; ++jj) { pp[jj] = ok[jj] ? fexp2(sv[jj] - mnew) : 0.f; ps += pp[jj]; }
    Q.lpart = Q.lpart * alpha + ps;
    v4u pw; pw.x = pk2(pp[0], pp[1]); pw.y = pk2(pp[2], pp[3]); pw.z = pk2(pp[4], pp[5]); pw.w = pk2(pp[6], pp[7]);
    const bf16x8 pf = __builtin_bit_cast(bf16x8, pw);
    const bool resc = __any(alpha != 1.f);
#pragma unroll
    for (int dt = 0; dt < 4; ++dt) {
        const bf16x8 vf = (bf16x8){lo[dt][0], lo[dt][1], lo[dt][2], lo[dt][3], hi[dt][0], hi[dt][1], hi[dt][2], hi[dt][3]};
        if (resc) Q.o[dt] = Q.o[dt] * alpha;
        Q.o[dt] = __builtin_amdgcn_mfma_f32_16x16x32_bf16(vf, pf, Q.o[dt], 0, 0, 0);
    }
}
__device__ __forceinline__ void cm_compute(int j, int T0, int wid, int r, int q, int vkey, int vch, LAS unsigned char* Vl, const bf16x8 (&kf)[4], const bf16x8 (&vv)[4], CmQ (&Q)[CM_NG]) {
    if (j >= CM_NSTEP) return;
    const CmStep p = cm_step(j, T0, wid);
    const int klo = p.kbase + (p.kk0 << p.sl), khi = p.kbase + ((p.kk0 + 31) << p.sl);
    if (khi < 0) return;
    bool act[CM_NG]; bool any = false;
#pragma unroll
    for (int g = 0; g < CM_NG; ++g) { const int qlo = T0 + 128 * g + wid; act[g] = (khi >= qlo - p.window) && (klo <= qlo + 120); any |= act[g]; }
    if (!any) return;
#pragma unroll
    for (int c = 0; c < 4; ++c) *(LAS bf16x8*)(Vl + (vkey + 8 * c) * CM_PB + vch * 16) = vv[c];
    asm volatile("s_waitcnt lgkmcnt(0)" ::: "memory");
    typedef short v4i16_t __attribute__((ext_vector_type(4)));
    LAS unsigned char* tp = Vl + (4 * q + ((r >> 2) & 3)) * CM_PB + (r & 3) * 8;
    s16x4 lo[4], hi[4];
#pragma unroll
    for (int dt = 0; dt < 4; ++dt) {
        lo[dt] = __builtin_bit_cast(s16x4, __builtin_amdgcn_ds_read_tr16_b64_v4i16((LAS v4i16_t*)(tp + dt * 32)));
        hi[dt] = __builtin_bit_cast(s16x4, __builtin_amdgcn_ds_read_tr16_b64_v4i16((LAS v4i16_t*)(tp + 16 * CM_PB + dt * 32)));
    }
    asm volatile("s_waitcnt lgkmcnt(0)" ::: "memory");
#pragma unroll
    for (int g = 0; g < CM_NG; ++g) if (act[g]) cm_group(p, r, q, Vl, kf, Q[g], lo, hi);
}
__device__ __forceinline__ void cm_compute_sh(int j, int T0, int wid, int r, int q, const LAS unsigned char* Ksh, const LAS unsigned char* Vsh, int row0, CmQ (&Q)[CM_NG]) {
    const CmStep p = cm_step(j, T0, wid);
    const int klo = p.kbase + (p.kk0 << p.sl), khi = p.kbase + ((p.kk0 + 31) << p.sl);
    if (khi < 0) return;
    bool act[CM_NG]; bool any = false;
#pragma unroll
    for (int g = 0; g < CM_NG; ++g) { const int qlo = T0 + 128 * g + wid; act[g] = (khi >= qlo - p.window) && (klo <= qlo + 120); any |= act[g]; }
    if (!any) return;
    typedef short v4i16_t __attribute__((ext_vector_type(4)));
    bf16x8 kf[4];
    const LAS unsigned char* kp = Ksh + (row0 + r) * CM_PB + q * 16;
    kf[0] = *(const LAS bf16x8*)kp; kf[1] = *(const LAS bf16x8*)(kp + 64); kf[2] = *(const LAS bf16x8*)(kp + 16 * CM_PB); kf[3] = *(const LAS bf16x8*)(kp + 16 * CM_PB + 64);
    const LAS unsigned char* tp = Vsh + (row0 + 4 * q + ((r >> 2) & 3)) * CM_PB + (r & 3) * 8;
    s16x4 lo[4], hi[4];
#pragma unroll
    for (int dt = 0; dt < 4; ++dt) {
        lo[dt] = __builtin_bit_cast(s16x4, __builtin_amdgcn_ds_read_tr16_b64_v4i16((LAS v4i16_t*)(tp + dt * 32)));
        hi[dt] = __builtin_bit_cast(s16x4, __builtin_amdgcn_ds_read_tr16_b64_v4i16((LAS v4i16_t*)(tp + 16 * CM_PB + dt * 32)));
    }
    asm volatile("s_waitcnt lgkmcnt(0)" ::: "memory");
#pragma unroll
    for (int g = 0; g < CM_NG; ++g) if (act[g]) cm_group(p, r, q, nullptr, kf, Q[g], lo, hi);
}
__device__ __forceinline__ void cm_init(CmQ& Q, int tq, int h, int q, const bf16* CQ) {
    Q.tq = tq; Q.mrun = -1e30f; Q.lpart = 0.f;
#pragma unroll
    for (int ks = 0; ks < 2; ++ks) Q.qf[ks] = *(const bf16x8*)(CQ + (size_t)tq * 512 + h * 64 + ks * 32 + q * 8);
#pragma unroll
    for (int dt = 0; dt < 4; ++dt) Q.o[dt] = (f32x4){0.f, 0.f, 0.f, 0.f};
}
__device__ __forceinline__ void cm_store(const CmQ& Q, int h, int q, bf16* CZ) {
    float l = Q.lpart; l += __shfl_xor(l, 16); l += __shfl_xor(l, 32);
    const float inv = 1.f / l;
#pragma unroll
    for (int dt = 0; dt < 4; ++dt) {
        const size_t off = (size_t)Q.tq * YP + h * 64 + dt * 16 + 4 * q;
        const v2u zz = *(const v2u*)(CZ + off);
        v2u w; w.x = pk2(Q.o[dt][0] * inv * bflo(zz.x), Q.o[dt][1] * inv * bfhi(zz.x)); w.y = pk2(Q.o[dt][2] * inv * bflo(zz.y), Q.o[dt][3] * inv * bfhi(zz.y));
        *(v2u*)(CZ + off) = w;
    }
}
__device__ __forceinline__ void cmix_item(int tb, int h, const bf16* CQ, const bf16* CK, const bf16* CV, bf16* CZ, LAS unsigned char* lds_blk, int tid, int wid, int lane) {
    const int r = lane & 15, q = lane >> 4, T0 = tb * CM_BLK;
    LAS unsigned char* ldsw = lds_blk + wid * 8192; LAS unsigned char* Ksh = lds_blk + 65536; LAS unsigned char* Vsh = Ksh + 128 * CM_PB;
    CmQ Q[CM_NG];
#pragma unroll
    for (int g = 0; g < CM_NG; ++g) cm_init(Q[g], T0 + 128 * g + wid + 8 * r, h, q, CQ);
    constexpr int NCH = CM_S0 / 4;
    bf16x8 kreg[2], vreg[2];
    auto ld_chunk = [&](int c) {
#pragma unroll
        for (int i = 0; i < 2; ++i) { const int idx = tid + 512 * i, key = idx >> 3, ch = idx & 7; int tk = T0 - 128 + 128 * c + key; tk = min(max(tk, 0), SEQ - 1);
            kreg[i] = *(const bf16x8*)(CK + (size_t)tk * 512 + h * 64 + ch * 8); vreg[i] = *(const bf16x8*)(CV + (size_t)tk * 512 + h * 64 + ch * 8); }
    };
    ld_chunk(0);
#pragma unroll 1
    for (int c = 0; c < NCH; ++c) {
        __syncthreads();
#pragma unroll
        for (int i = 0; i < 2; ++i) { const int idx = tid + 512 * i, key = idx >> 3, ch = idx & 7; *(LAS bf16x8*)(Ksh + key * CM_PB + ch * 16) = kreg[i]; *(LAS bf16x8*)(Vsh + key * CM_PB + ch * 16) = vreg[i]; }
        __syncthreads();
        if (c + 1 < NCH) ld_chunk(c + 1);
#pragma unroll 1
        for (int st = 0; st < 4; ++st) cm_compute_sh(4 * c + st, T0, wid, r, q, Ksh, Vsh, 32 * st, Q);
    }
    const int vkey = lane >> 3, vch = lane & 7;
    bf16x8 K0[4], V0[4], K1[4], V1[4];
    cm_load(CM_S0, T0, wid, h, r, q, vkey, vch, CK, CV, K0, V0);
#pragma unroll 1
    for (int j = CM_S0; j < CM_NSTEP; j += 2) {
        cm_load(j + 1, T0, wid, h, r, q, vkey, vch, CK, CV, K1, V1); cm_compute(j, T0, wid, r, q, vkey, vch, ldsw, K0, V0, Q);
        cm_load(j + 2, T0, wid, h, r, q, vkey, vch, CK, CV, K0, V0); cm_compute(j + 1, T0, wid, r, q, vkey, vch, ldsw, K1, V1, Q);
    }
#pragma unroll
    for (int g = 0; g < CM_NG; ++g) cm_store(Q[g], h, q, CZ);
}

#define RLX_AGENT __ATOMIC_RELAXED, __HIP_MEMORY_SCOPE_AGENT
#define XB_TMO      128
#define XB_XCNT(j)  (256  + 64 * (j))
#define XB_XSUB(j)  (1280 + 64 * (j))
#define XB_XGEN(j)  (2304 + 64 * (j))
#define XB_TOP      3328
#define XB_TOPGEN   3392
#define XCD_BAR_WORDS 3456
#define XB_SPIN_CAP (1u << 18)

__device__ __forceinline__ unsigned xb_ld(unsigned* p)              { return __hip_atomic_load(p, __ATOMIC_RELAXED, __HIP_MEMORY_SCOPE_AGENT); }
__device__ __forceinline__ unsigned xb_add(unsigned* p, unsigned v) { return __hip_atomic_fetch_add(p, v, __ATOMIC_RELAXED, __HIP_MEMORY_SCOPE_AGENT); }
__device__ __forceinline__ unsigned xb_xcc_id() { return (unsigned)__builtin_amdgcn_s_getreg((3 << 11) | 20) & 0xFu; }
#define XB_SPIN(cond, bar) do { unsigned _sp = 0; while (cond) { __builtin_amdgcn_s_sleep(1); \
    if ((++_sp & 255u) == 0u) { if (xb_ld(&(bar)[XB_TMO])) break; if (_sp > XB_SPIN_CAP) { atomicAdd(&(bar)[XB_TMO], 1u); break; } } } } while (0)

struct XcdBarrier {
    unsigned* bar; unsigned x; int wave;
    volatile LAS unsigned* st;
};

__device__ __forceinline__ XcdBarrier xcd_barrier_post(unsigned* bar, volatile LAS unsigned* st, int wave) {
    XcdBarrier b; b.bar = bar; b.x = xb_xcc_id(); b.st = st; b.wave = wave;
    if (wave == 0 && mk_lane() == 0) (void)xb_add(&bar[XB_XCNT(b.x)], 1u);
    return b;
}
__device__ __forceinline__ void xcd_barrier_complete(unsigned* bar, unsigned x, unsigned& nloc, unsigned& nx) {
    const unsigned G = gridDim.x * gridDim.y * gridDim.z;
    unsigned sum, cnt, mine, sp = 0u;
    for (;;) {
        sum = 0u; cnt = 0u; mine = 0u;
#pragma unroll
        for (unsigned j = 0; j < 16; ++j) { const unsigned c = xb_ld(&bar[XB_XCNT(j)]); sum += c; cnt += (c > 0u) ? 1u : 0u; mine = (j == x) ? c : mine; }
        if (sum == G) break;
        __builtin_amdgcn_s_sleep(1);
        if ((++sp & 255u) == 0u) { if (xb_ld(&bar[XB_TMO])) break; if (sp > XB_SPIN_CAP) { atomicAdd(&bar[XB_TMO], 1u); break; } }
    }
    nloc = mine > 0u ? mine : 1u; nx = cnt > 0u ? cnt : 1u;
}

__device__ __forceinline__ void xcd_barrier(const XcdBarrier& b) {
    asm volatile("s_waitcnt vmcnt(0)" ::: "memory");
    __syncthreads();
    if (b.wave == 0 && mk_lane() == 0) {
        unsigned* bar = b.bar;
        __builtin_amdgcn_s_waitcnt(0);
        unsigned nloc = b.st[0], nx = b.st[1];
        if (nloc == 0u) { xcd_barrier_complete(bar, b.x, nloc, nx); b.st[0] = nloc; b.st[1] = nx; }
        const unsigned old = xb_add(&bar[XB_XSUB(b.x)], 1u);
        const unsigned gen = old / nloc;
        if (old + 1u == (gen + 1u) * nloc) {
            __builtin_amdgcn_fence(__ATOMIC_RELEASE, "agent");
            asm volatile("s_waitcnt vmcnt(0)" ::: "memory");
            const unsigned og = xb_add(&bar[XB_TOP], 1u);
            const unsigned tg = og / nx;
            if (og + 1u == (tg + 1u) * nx) xb_add(&bar[XB_TOPGEN], 1u);
            else XB_SPIN(xb_ld(&bar[XB_TOPGEN]) == tg, bar);
            __builtin_amdgcn_fence(__ATOMIC_ACQUIRE, "agent");
            xb_add(&bar[XB_XGEN(b.x)], 1u);
            asm volatile("s_waitcnt vmcnt(0)" ::: "memory");
        } else {
            XB_SPIN(xb_ld(&bar[XB_XGEN(b.x)]) == gen, bar);
            __builtin_amdgcn_fence(__ATOMIC_ACQUIRE, "agent");
            asm volatile("s_waitcnt vmcnt(0)" ::: "memory");
        }
    }
    __syncthreads();
}

struct Args { const void* in[16]; float* out; unsigned char* ws; int ph_lo, ph_hi; };
constexpr int N_PHASES = 6 * DEPTH + 1;

__global__ void __launch_bounds__(NWAVES * 64, 2) trunk_fwd(Args args) {
    extern __shared__ __attribute__((aligned(16))) unsigned char lds[];
    LAS unsigned char* L = (LAS unsigned char*)lds;
#define FRESH_TID() const int tid = mk_tid(wave0), lane = tid & 63, wid = __builtin_amdgcn_readfirstlane(tid >> 6); const int gw = vcu * NWAVES + wid; (void)tid; (void)lane; (void)gw
    const int wave0 = __builtin_amdgcn_readfirstlane((int)threadIdx.x >> 6);
    const int G = gridDim.x, bx = blockIdx.x;
    const int vcu = (G % 8 == 0) ? (bx % 8) * (G / 8) + bx / 8 : bx;
    const int NGW = G * NWAVES;
    unsigned char* ws = args.ws;
    const float* x_in = (const float*)args.in[0]; const int* pos = (const int*)args.in[1];
    float* out = args.out;
    float* ropec = (float*)(ws + WS_ROPE); float* ropes = ropec + SEQ * 8;
    bf16* WinT = (bf16*)(ws + WS_WIN); bf16* WbT = (bf16*)(ws + WS_WB); bf16* WoT = (bf16*)(ws + WS_WO);
    bf16* HB = (bf16*)(ws + WS_HB); bf16* OB = (bf16*)(ws + WS_O); bf16* PJ = (bf16*)(ws + WS_PJ);
    bf16* GL = PJ;
    const int lo = args.ph_lo, hi = args.ph_hi;
#define IN(k) (lo <= (k) && (k) < hi)
#ifdef PROBE_S1A
#define MARK(i) do { if (blockIdx.x == 0 && wave0 == 0 && mk_lane() == 0) ((LAS unsigned long long*)(L + LDS_BYTES - 512))[i] = __builtin_amdgcn_s_memrealtime(); } while (0)
#define MARKG(i) do { if (wave0 == 0 && mk_lane() == 0) atomicMax((unsigned long long*)(ws + WS_BAR + 32768) + (i), (unsigned long long)__builtin_amdgcn_s_memrealtime()); } while (0)
#else
#define MARK(i) do {} while (0)
#define MARKG(i) do {} while (0)
#endif
#define SEAM(k) do { if (IN(k) && IN((k) + 1)) { xcd_barrier(xbar); } MARK((k) + 1); } while (0)

    MARK(0);
    XcdBarrier xbar; xbar.bar = (unsigned*)(ws + WS_BAR); xbar.x = 0; xbar.wave = wave0; xbar.st = (volatile LAS unsigned*)(L + LDS_BYTES - 1024);
    {
        if (wave0 == 0 && mk_lane() < 2) ((LAS unsigned*)(L + LDS_BYTES - 1024))[mk_lane()] = 0u;
        __syncthreads();
        if (hi - lo > 1) xbar = xcd_barrier_post((unsigned*)(ws + WS_BAR), (volatile LAS unsigned*)(L + LDS_BYTES - 1024), wave0);
        if (lo < 0) cg::this_grid().sync();
    }
    for (int layer = 0; layer < DEPTH; ++layer) {
        const int pb = 6 * layer;
        const float* xsrc = layer == 0 ? x_in : out;
#ifndef SKIP_P0
        if (IN(pb + 0)) {
            FRESH_TID();
            const float* w_in = (const float*)args.in[3] + (size_t)layer * DM * NIN;
            const float* w_br = (const float*)args.in[13] + (size_t)layer * 3 * 512 * DM;
            const float* w_out = (const float*)args.in[14] + (size_t)layer * DM * DM;
            const float* ng = (const float*)args.in[2] + layer * DM;
            LAS float* scr = (LAS float*)(L + wid * 16384);
            constexpr int I_IN = (DM / 64) * (NIN / 32), I_B = (512 / 64) * (DM / 32), I_O = (DM / 64) * (DM / 32);
            constexpr int NITEMS = I_IN + 3 * I_B + I_O;
            for (int it = gw; it < NITEMS; it += NGW) {
                int r = it;
                if (r < I_IN) { p0_transpose_item(w_in, DM, NIN, WinT, DM, scr, r, lane); continue; } r -= I_IN;
                if (r < 3 * I_B) { const int br = r / I_B; p0_transpose_item(w_br + (size_t)br * 512 * DM, 512, DM, WbT + br * 512, YP, scr, r % I_B, lane); continue; } r -= 3 * I_B;
                p0_transpose_item(w_out, DM, DM, WoT, DM, scr, r, lane);
            }
            for (int m = gw; m < SEQ; m += 4 * NGW) rms_rows<4, true>(xsrc + (size_t)m * DM, (size_t)NGW * DM, ng, HB + (size_t)m * DM, lane);
            if (layer == 0) {
                for (int idx = (vcu * NWAVES * 64) + tid; idx < SEQ * 8; idx += G * NWAVES * 64) {
                    const int tok = idx >> 3, i = idx & 7;
                    const float ang = (float)pos[tok] * __builtin_amdgcn_exp2f(-(float)i * (18.931568569324174f / 8.0f));
                    const double rev = (double)ang * 0.15915494309189535; const double fr_ = rev - __builtin_rint(rev);
                    ropec[idx] = __builtin_amdgcn_cosf((float)fr_); ropes[idx] = __builtin_amdgcn_sinf((float)fr_);
                }
            }
        }
#endif
        SEAM(pb + 0);
#ifndef SKIP_P1
        if (IN(pb + 1)) {
            pg8::Gemm g{HB, WinT, SEQ, NMAIN, DM}; pg8::StaticOrder S; S.init(SEQ, NMAIN, G, bx);
            EpiProj E{PJ, ropec, ropes};
            pg8::gemm_phase<EpiProj, pg8::StaticOrder, true, true>(L, g, S, E, pg8::NoHook(), wave0);
        }
#endif
        SEAM(pb + 1);
        if (IN(pb + 2)) {
#ifndef SKIP_ATT
            {
                const int hm = vcu >> 5, s = vcu & 31;
                const int nit = (G == 256) ? 2 : (vcu < 512 ? (512 - vcu + G - 1) / G : 0);
                for (int i = 0; i < nit; ++i) {
                    int hm2, qb; if (G == 256) { hm2 = hm; qb = i ? 63 - s : s; } else { const int u = vcu + i * G; hm2 = u >> 6; qb = u & 63; }
                    attn_body::attn_unit<8>(qb, (const attn_body::bf16*)(PJ + SL_AQ * SLOT_ELEMS) + hm2 * 64, (const attn_body::bf16*)(PJ + SL_AK * SLOT_ELEMS) + hm2 * 64,
                                            (const attn_body::bf16*)(PJ + SL_AV * SLOT_ELEMS) + (hm2 >> 1) * 128, (attn_body::bf16*)OB + hm2 * 128, (char*)lds, wave0);
                }
            }
#endif
            if (layer == 0) { MARK(20); MARKG(0); }
#ifndef SKIP_CMIX
            {
                FRESH_TID();
                for (int it = vcu; it < (SEQ / CM_BLK) * 8; it += G) cmix_item(it >> 3, it & 7, PJ + SL_CQ * SLOT_ELEMS, PJ + SL_CK * SLOT_ELEMS, PJ + SL_CV * SLOT_ELEMS, PJ + SL_AZ * SLOT_ELEMS + 1024, L, tid, wid, lane);
                __syncthreads();
            }
#endif
            if (layer == 0) { MARK(21); MARKG(1); }
#ifndef SKIP_SGU
            {
                FRESH_TID();
                const float* lng = (const float*)args.in[9] + layer * 512; const float* lnb = (const float*)args.in[10] + layer * 512;
                const float* sw = (const float*)args.in[11] + (size_t)layer * 4 * 128 * 128; const float* sb = (const float*)args.in[12] + layer * 4 * 128;
                unsigned* qctr = (unsigned*)(ws + WS_BAR + 40960) + layer * 64;
                volatile LAS unsigned* qword = (volatile LAS unsigned*)(L + LDS_BYTES - 768);
                for (;;) {
                    if (tid == 0) *qword = xb_add(qctr, 1u);
                    __syncthreads();
                    const unsigned it = *qword;
                    __syncthreads();
                    if (it >= 512u) break;
                    sgu_item((int)it, PJ + SL_BU * SLOT_ELEMS, PJ + SL_BV * SLOT_ELEMS, PJ + SL_AZ * SLOT_ELEMS + 512, lng, lnb, sw, sb, L, tid, wid, lane);
                }
            }
#endif
            if (layer == 0) { MARK(22); MARKG(2); }
        }
        SEAM(pb + 2);
#ifndef SKIP_P3
        if (IN(pb + 3)) {
            { FRESH_TID();
            const float lam_init = 0.8f - 0.6f * __expf(-0.3f * (float)layer);
            const float* lq1 = (const float*)args.in[4] + layer * 64; const float* lk1 = (const float*)args.in[5] + layer * 64;
            const float* lq2 = (const float*)args.in[6] + layer * 64; const float* lk2 = (const float*)args.in[7] + layer * 64;
            const float lam = __expf(wave_sum(lq1[lane] * lk1[lane])) - __expf(wave_sum(lq2[lane] * lk2[lane])) + lam_init;
            const float* sg = (const float*)args.in[8] + layer * 128;
            const int e0 = (lane & 15) * 8, hh = lane >> 4;
            const f32x4 g0 = *(const f32x4*)(sg + e0), g1 = *(const f32x4*)(sg + e0 + 4);
            bf16* AZ = PJ + SL_AZ * SLOT_ELEMS;
            for (int m0 = gw; m0 < SEQ; m0 += 4 * NGW) {
                v4u A4[4], B4[4], Z4[4];
#pragma unroll
                for (int k = 0; k < 4; ++k) { const size_t m = (size_t)m0 + (size_t)k * NGW;
                    A4[k] = *(const v4u*)(OB + m * DM + hh * 256 + e0); B4[k] = *(const v4u*)(OB + m * DM + hh * 256 + 128 + e0); Z4[k] = *(const v4u*)(AZ + m * YP + hh * 128 + e0); }
#pragma unroll
                for (int k = 0; k < 4; ++k) { const size_t m = (size_t)m0 + (size_t)k * NGW; const v4u a = A4[k], b = B4[k], z = Z4[k];
                float d[8] = {bflo(a.x) - lam * bflo(b.x), bfhi(a.x) - lam * bfhi(b.x), bflo(a.y) - lam * bflo(b.y), bfhi(a.y) - lam * bfhi(b.y),
                              bflo(a.z) - lam * bflo(b.z), bfhi(a.z) - lam * bfhi(b.z), bflo(a.w) - lam * bflo(b.w), bfhi(a.w) - lam * bfhi(b.w)};
                float ss = 0.f;
#pragma unroll
                for (int e = 0; e < 8; ++e) ss += d[e] * d[e];
                ss += __shfl_xor(ss, 1); ss += __shfl_xor(ss, 2); ss += __shfl_xor(ss, 4); ss += __shfl_xor(ss, 8);
                const float rr = (1.f / sqrtf(ss * (1.f / 128.f) + EPS)) * (1.f - lam_init);
                v4u w; w.x = pk2(d[0] * rr * g0[0] * bflo(z.x), d[1] * rr * g0[1] * bfhi(z.x)); w.y = pk2(d[2] * rr * g0[2] * bflo(z.y), d[3] * rr * g0[3] * bfhi(z.y));
                w.z = pk2(d[4] * rr * g1[0] * bflo(z.z), d[5] * rr * g1[1] * bfhi(z.z)); w.w = pk2(d[6] * rr * g1[2] * bflo(z.w), d[7] * rr * g1[3] * bfhi(z.w));
                *(v4u*)(AZ + m * YP + hh * 128 + e0) = w; }
            } }
            asm volatile("s_waitcnt vmcnt(0) lgkmcnt(0)" ::: "memory"); __syncthreads();
            pg8::Gemm g{HB, WinT + (size_t)NMAIN * DM, SEQ, NGATE, DM}; pg8::StaticOrder S; S.init(SEQ, NGATE, G, bx);
            EpiGate E{GL};
            pg8::gemm_phase<EpiGate, pg8::StaticOrder, true, true>(L, g, S, E, pg8::NoHook(), wave0);
        }
#endif
        SEAM(pb + 3);
#ifndef SKIP_P4
        if (IN(pb + 4)) {
            pg8::StaticOrder S; S.init(SEQ, DM, G, bx);
            pg8::Gemm g{PJ + (size_t)SL_AZ * SLOT_ELEMS, WbT, SEQ, DM, YP}; EpiMerge E{GL, OB}; MergeHook H{GL};
            pg8::gemm_phase<EpiMerge, pg8::StaticOrder, false, true, MergeHook>(L, g, S, E, H, wave0);
        }
#endif
        SEAM(pb + 4);
#ifdef PROBE_S1A
        if (layer == 0 && IN(pb + 4) && IN(pb + 5)) { MARK(23); xcd_barrier(xbar); MARK(24); }
#endif
#ifndef SKIP_P5
        if (IN(pb + 5)) {
            pg8::Gemm g{OB, WoT, SEQ, DM, DM}; pg8::StaticOrder S; S.init(SEQ, DM, G, bx);
            EpiOut E{xsrc, out};
            pg8::gemm_phase<EpiOut, pg8::StaticOrder, false, true>(L, g, S, E, pg8::NoHook(), wave0);
        }
#endif
        SEAM(pb + 5);
    }
    if (IN(6 * DEPTH)) {
        FRESH_TID();
        const float* fg = (const float*)args.in[15];
        for (int m = gw; m < SEQ; m += 4 * NGW) rms_rows<4, false>(out + (size_t)m * DM, (size_t)NGW * DM, fg, out + (size_t)m * DM, lane);
    }
#ifdef PROBE_S1A
    MARK(13);
    __syncthreads();
    if (blockIdx.x == 0 && wave0 == 0 && mk_lane() == 0) {
        LAS unsigned long long* T = (LAS unsigned long long*)(L + LDS_BYTES - 512);
        for (int i = 0; i < 3; ++i) T[40 + i] = __hip_atomic_load((unsigned long long*)(ws + WS_BAR + 32768) + i, __ATOMIC_RELAXED, __HIP_MEMORY_SCOPE_AGENT);
        const unsigned long long s1 = T[PROBE_S1B] - T[PROBE_S1A], s2 = T[PROBE_S2B] - T[PROBE_S2A];
        const unsigned long long spin = 4ull * s1 + 300000ull * ((s2 + 1000ull) / 2000ull);
        const unsigned long long t0 = __builtin_amdgcn_s_memrealtime();
        while (__builtin_amdgcn_s_memrealtime() - t0 < spin) __builtin_amdgcn_s_sleep(8);
    }
#endif
#undef IN
#undef SEAM
}

extern "C" void kernel_launch(void* const* d_in, const int* in_sizes, int n_in, void* d_out, int out_size, void* d_ws, size_t ws_size, hipStream_t stream) {
    static int grid = 0;
    if (grid == 0) {
        if (n_in != 16 || out_size != SEQ * DM || ws_size < WS_END) { fprintf(stderr, "kernel_launch: unexpected shapes (n_in %d out %d ws %zu need %zu)\n", n_in, out_size, ws_size, (size_t)WS_END); grid = -1; return; }
        int dev = 0, cus = 0, per_cu = 0;
        hipGetDevice(&dev); hipDeviceGetAttribute(&cus, hipDeviceAttributeMultiprocessorCount, dev);
        if (hipFuncSetAttribute((const void*)trunk_fwd, hipFuncAttributeMaxDynamicSharedMemorySize, LDS_BYTES) != hipSuccess) { fprintf(stderr, "kernel_launch: hipFuncSetAttribute failed\n"); grid = -1; return; }
        hipOccupancyMaxActiveBlocksPerMultiprocessor(&per_cu, (const void*)trunk_fwd, NWAVES * 64, LDS_BYTES);
        (void)hipGetLastError();
        if (per_cu < 1) per_cu = 1;
        grid = cus * (per_cu > 1 ? 1 : per_cu);
        fprintf(stderr, "kernel_launch: grid %d (cus %d per_cu %d)\n", grid, cus, per_cu);
    }
    if (grid < 0) return;
    Args a{};
    for (int i = 0; i < 16; ++i) a.in[i] = d_in[i];
    a.out = (float*)d_out; a.ws = (unsigned char*)d_ws;
#if MK_ONE_LAUNCH
    if (hipMemsetAsync((unsigned char*)d_ws + WS_BAR, 0, 65536, stream) != hipSuccess) { fprintf(stderr, "kernel_launch: memset failed\n"); return; }
    a.ph_lo = 0; a.ph_hi = N_PHASES;
    void* kargs[] = {&a};
    hipError_t e = hipLaunchCooperativeKernel((const void*)trunk_fwd, dim3(grid), dim3(NWAVES * 64), kargs, LDS_BYTES, stream);
    if (e != hipSuccess) fprintf(stderr, "cooperative launch failed: %s (grid %d)\n", hipGetErrorString(e), grid);
#else
    for (int p = 0; p < N_PHASES; ++p) { a.ph_lo = p; a.ph_hi = p + 1; hipLaunchKernelGGL(trunk_fwd, dim3(grid), dim3(NWAVES * 64), LDS_BYTES, stream, a);
    }
#endif
}
```

```cpp
#include <hip/hip_runtime.h>
#include <hip/hip_cooperative_groups.h>
#include <cstdio>
#include <cstdint>
#include <cmath>
__device__ __forceinline__ int mk_lane() { return (int)__builtin_amdgcn_mbcnt_hi(~0u, __builtin_amdgcn_mbcnt_lo(~0u, 0u)); }
__device__ __forceinline__ int mk_tid(int wave) { int l; asm volatile("v_mbcnt_lo_u32_b32 %0, -1, 0\n\tv_mbcnt_hi_u32_b32 %0, -1, %0" : "=&v"(l)); return wave * 64 + l; }
#define MK_ONE_LAUNCH 1
namespace pg8 {
#define PG8_LAS __attribute__((address_space(3)))
typedef unsigned short bf16_t;
typedef short bf16x8 __attribute__((ext_vector_type(8)));
typedef float f32x4 __attribute__((ext_vector_type(4)));
typedef unsigned u32x4 __attribute__((ext_vector_type(4)));
constexpr int BM = 256, BK = 64, HALF = 128, HTB = HALF * BK * 2  , STAGE_BYTES = 8 * HTB, NXCD = 8, WGM = 8;

__host__ __device__ __forceinline__ int lds_byte(int r, int c) { const int st = (r >> 4) * 2 + (c >> 5), rr = r & 15, cc = c & 31, ob = rr * 64 + cc * 2; return st * 1024 + (ob ^ (((ob >> 9) & 1) << 5)); }
__host__ __device__ __forceinline__ void stage_rc(int b, int& R, int& C) { const int st = b / 1024, sb = b % 1024, swz = sb ^ (((sb >> 9) & 1) << 5); R = (st >> 1) * 16 + swz / 64; C = (st & 1) * 32 + (swz % 64) / 2; }
__host__ __device__ __forceinline__ int perm32(int rho) { const int n = rho >> 4, i = rho & 15; return 8 * (i >> 2) + 4 * n + (i & 3); }

struct Unit { int pm, pn; };
struct Gemm { const bf16_t* A; const bf16_t* Bt; int M, N, K; };

struct StaticOrder {
    int nM, nN, nwg, G, c;
    __host__ __device__ void init(int M, int N, int G_, int c_) { nM = M / BM; nN = N / BM; nwg = nM * nN; G = G_; c = c_; }
    __host__ __device__ bool next(int i, Unit& u) const {
        const long L = (long)i * G + c; if (L >= nwg) return false;
        int wgid = (int)L; { const int q = nwg / NXCD, r = nwg % NXCD, xcd = wgid % NXCD, off = wgid / NXCD; wgid = (xcd < r ? xcd * (q + 1) : r * (q + 1) + (xcd - r) * q) + off; }
        const int nig = WGM * nN, gid = wgid / nig, fm = gid * WGM, gsz = (nM - fm) < WGM ? (nM - fm) : WGM;
        u.pm = fm + ((wgid % nig) % gsz); u.pn = (wgid % nig) / gsz; return true;
    }
    __device__ __forceinline__ void a_ready(const Unit&) const {}
    __device__ __forceinline__ void done(const Unit&) const {}
};

__device__ __forceinline__ unsigned cvt_pk_bf16(float lo, float hi) { unsigned r; asm volatile("v_cvt_pk_bf16_f32 %0, %1, %2" : "=v"(r) : "v"(lo), "v"(hi)); return r; }
typedef float f32x2 __attribute__((ext_vector_type(2)));
struct NoHook { static constexpr int PERIOD = 0; __device__ __forceinline__ void operator()(f32x4 (&)[2][2][4][2], const Unit&, int, int, int, int, int) const {} };
template <class Epi, class Sched, bool ALIGN_EPI = false, bool SP2 = false, class Hook = NoHook>
__device__ __forceinline__ void gemm_phase(PG8_LAS unsigned char* lds, const Gemm g, const Sched& S, const Epi& E, const Hook& H, int wave_id) {
    int tid_ = mk_tid(wave_id);
    const int tid = tid_, wid = __builtin_amdgcn_readfirstlane(tid >> 6), lane = tid & 63, wr = wid >> 2, wc = wid & 3, fr = lane & 15, fq = lane >> 4;
    const int K = g.K, nt = K / BK;
    unsigned voffA[2], voffB[2];
#pragma unroll
    for (int i = 0; i < 2; ++i) { int R, C; stage_rc(tid * 16 + i * 8192, R, C); const int Rb = Epi::PERM ? ((R & ~31) + perm32(R & 31)) : R;
        voffA[i] = (unsigned)(R * K + C) * 2u; voffB[i] = (unsigned)(Rb * K + C) * 2u; }
    const size_t kstep = (size_t)(BK * 2);
    const size_t hstep = (size_t)HALF * K * 2;
    const size_t tstep = 2 * hstep;
    const unsigned ldsw = (unsigned)wid * 1024u;
    const int aoff = lds_byte(wr * 64 + fr, fq * 8), boff = lds_byte(wc * 32 + fr, fq * 8);
#define PG8_SA(b, h) (((b) * 2 + (h)) * HTB)
#define PG8_SB(b, h) ((4 + (b) * 2 + (h)) * HTB)
#define PG8_STAGE(bufoff, gbase, voff) do { _Pragma("unroll") for (int _i = 0; _i < 2; ++_i) \
        __builtin_amdgcn_global_load_lds((const unsigned*)((const char*)(gbase) + (voff)[_i]), (PG8_LAS unsigned*)(lds + (bufoff) + ldsw + _i * 8192), 16, 0, 0); } while (0)
#define PG8_LDA(dst, b, h) do { _Pragma("unroll") for (int m = 0; m < 4; ++m) _Pragma("unroll") for (int k = 0; k < 2; ++k) dst[m][k] = *(const PG8_LAS bf16x8*)(lds + PG8_SA(b, h) + aoff + m * 2048 + k * 1024); } while (0)
#define PG8_LDB(dst, b, h) do { _Pragma("unroll") for (int n = 0; n < 2; ++n) _Pragma("unroll") for (int k = 0; k < 2; ++k) dst[n][k] = *(const PG8_LAS bf16x8*)(lds + PG8_SB(b, h) + boff + n * 2048 + k * 1024); } while (0)
#define PG8_MMA(ai, bj, At, Bt) do { __builtin_amdgcn_s_setprio(1); _Pragma("unroll") for (int m = 0; m < 4; ++m) _Pragma("unroll") for (int n = 0; n < 2; ++n) _Pragma("unroll") for (int k = 0; k < 2; ++k) \
        acc[ai][bj][m][n] = __builtin_amdgcn_mfma_f32_16x16x32_bf16(Bt[n][k], At[m][k], acc[ai][bj][m][n], 0, 0, 0); __builtin_amdgcn_s_setprio(0); } while (0)
#define PG8_WAIT_V(n) asm volatile("s_waitcnt vmcnt(" #n ")" ::: "memory")
#define PG8_WAIT_L(n) asm volatile("s_waitcnt lgkmcnt(" #n ")" ::: "memory")
#define PG8_BAR __builtin_amdgcn_s_barrier()
#define PG8_SCHED __builtin_amdgcn_sched_barrier(0)
    Unit cur, nxt; int ui = 0;
    if (!S.next(0, cur)) return;
    f32x4 acc[2][2][4][2];
#pragma unroll
    for (int a = 0; a < 2; ++a)
#pragma unroll
        for (int b = 0; b < 2; ++b)
#pragma unroll
            for (int m = 0; m < 4; ++m)
#pragma unroll
                for (int n = 0; n < 2; ++n) acc[a][b][m][n] = (f32x4){0.f, 0.f, 0.f, 0.f};
    bf16x8 At[4][2], B0[2][2], B1[2][2];
    const char* cA = (const char*)g.A + (size_t)cur.pm * tstep; const char* cB = (const char*)g.Bt + (size_t)cur.pn * tstep;
    S.a_ready(cur);
    if constexpr (SP2) {
        PG8_STAGE(PG8_SB(0, 0), cB, voffB); PG8_STAGE(PG8_SB(0, 1), cB + hstep, voffB); PG8_STAGE(PG8_SA(0, 0), cA, voffA); PG8_STAGE(PG8_SA(0, 1), cA + hstep, voffA);
        if (wr == 1) PG8_BAR;
        PG8_WAIT_V(2); PG8_BAR;
        PG8_STAGE(PG8_SB(1, 0), cB + kstep, voffB); PG8_STAGE(PG8_SA(1, 0), cA + kstep, voffA); PG8_STAGE(PG8_SB(1, 1), cB + hstep + kstep, voffB);
        PG8_WAIT_V(6); PG8_BAR;
    } else {
        PG8_STAGE(PG8_SB(0, 0), cB, voffB); PG8_STAGE(PG8_SA(0, 0), cA, voffA); PG8_STAGE(PG8_SB(0, 1), cB + hstep, voffB); PG8_STAGE(PG8_SA(0, 1), cA + hstep, voffA);
        if (wr == 1) PG8_BAR;
        PG8_WAIT_V(4); PG8_BAR;
        PG8_STAGE(PG8_SB(1, 0), cB + kstep, voffB); PG8_STAGE(PG8_SA(1, 0), cA + kstep, voffA); PG8_STAGE(PG8_SB(1, 1), cB + hstep + kstep, voffB);
        PG8_WAIT_V(6); PG8_BAR;
    }
    for (;;) {
        const bool has_next = S.next(ui + 1, nxt);
        const char* nA = has_next ? (const char*)g.A + (size_t)nxt.pm * tstep : cA; const char* nB = has_next ? (const char*)g.Bt + (size_t)nxt.pn * tstep : cB;
        for (int t = 0; t < nt; t += 2) {
            if constexpr (Hook::PERIOD > 0) { if (t > 0 && (t % Hook::PERIOD) == 0) { H(acc, cur, t / Hook::PERIOD, wr, wc, fr, fq); PG8_SCHED; } }
            const bool last = (t == nt - 2);
            const char* a1 = cA + (size_t)(t + 1) * kstep;
            const char* a2 = last ? nA : cA + (size_t)(t + 2) * kstep; const char* b2 = last ? nB : cB + (size_t)(t + 2) * kstep;
            const char* a3 = a2 + kstep; const char* b3 = b2 + kstep;
            if (last && has_next) S.a_ready(nxt);
            if constexpr (SP2) {
            PG8_LDB(B0, 0, 0); PG8_LDB(B1, 0, 1); PG8_SCHED; PG8_LDA(At, 0, 0); PG8_STAGE(PG8_SA(1, 1), a1 + hstep, voffA);
            PG8_WAIT_V(8); PG8_WAIT_L(0); PG8_BAR; PG8_MMA(0, 0, At, B0); PG8_MMA(0, 1, At, B1); PG8_BAR; PG8_SCHED;
            PG8_LDA(At, 0, 1); PG8_STAGE(PG8_SB(0, 0), b2, voffB); PG8_STAGE(PG8_SB(0, 1), b2 + hstep, voffB); PG8_STAGE(PG8_SA(0, 0), a2, voffA);
            PG8_WAIT_V(8); PG8_WAIT_L(0); PG8_BAR; PG8_MMA(1, 0, At, B0); PG8_MMA(1, 1, At, B1); PG8_BAR; PG8_SCHED;
            PG8_LDB(B0, 1, 0); PG8_LDB(B1, 1, 1); PG8_SCHED; PG8_LDA(At, 1, 0); PG8_STAGE(PG8_SA(0, 1), a2 + hstep, voffA);
            PG8_WAIT_V(8); PG8_WAIT_L(0); PG8_BAR; PG8_MMA(0, 0, At, B0); PG8_MMA(0, 1, At, B1); PG8_BAR; PG8_SCHED;
            PG8_LDA(At, 1, 1); PG8_STAGE(PG8_SB(1, 0), b3, voffB); PG8_STAGE(PG8_SB(1, 1), b3 + hstep, voffB); PG8_STAGE(PG8_SA(1, 0), a3, voffA);
            PG8_WAIT_V(8); PG8_WAIT_L(0); PG8_BAR; PG8_MMA(1, 0, At, B0); PG8_MMA(1, 1, At, B1); PG8_BAR; PG8_SCHED;
            } else {
            PG8_LDB(B0, 0, 0); PG8_SCHED; PG8_LDA(At, 0, 0); PG8_STAGE(PG8_SA(1, 1), a1 + hstep, voffA);
            PG8_WAIT_L(8); PG8_BAR; PG8_WAIT_L(0); PG8_MMA(0, 0, At, B0); PG8_BAR; PG8_SCHED;
            PG8_LDB(B1, 0, 1); PG8_STAGE(PG8_SB(0, 0), b2, voffB);
            PG8_BAR; PG8_WAIT_L(0); PG8_MMA(0, 1, At, B1); PG8_BAR;
            PG8_LDA(At, 0, 1); PG8_STAGE(PG8_SA(0, 0), a2, voffA);
            PG8_BAR; PG8_WAIT_L(0); PG8_MMA(1, 0, At, B0); PG8_BAR; PG8_SCHED;
            PG8_STAGE(PG8_SB(0, 1), b2 + hstep, voffB);
            PG8_WAIT_V(6); PG8_BAR; PG8_MMA(1, 1, At, B1); PG8_BAR;
            PG8_LDB(B0, 1, 0); PG8_SCHED; PG8_LDA(At, 1, 0); PG8_STAGE(PG8_SA(0, 1), a2 + hstep, voffA);
            PG8_WAIT_L(8); PG8_BAR; PG8_WAIT_L(0); PG8_MMA(0, 0, At, B0); PG8_BAR; PG8_SCHED;
            PG8_LDB(B1, 1, 1); PG8_STAGE(PG8_SB(1, 0), b3, voffB);
            PG8_BAR; PG8_WAIT_L(0); PG8_MMA(0, 1, At, B1); PG8_BAR;
            PG8_LDA(At, 1, 1); PG8_STAGE(PG8_SA(1, 0), a3, voffA);
            PG8_BAR; PG8_WAIT_L(0); PG8_MMA(1, 0, At, B0); PG8_BAR; PG8_SCHED;
            PG8_STAGE(PG8_SB(1, 1), b3 + hstep, voffB);
            PG8_WAIT_V(6); PG8_BAR; PG8_MMA(1, 1, At, B1); PG8_BAR;
            }
        }
        if constexpr (ALIGN_EPI) { if (wr == 0) PG8_BAR; }
        if constexpr (!Epi::AFTER_DRAIN) { E(acc, cur, wr, wc, fr, fq); S.done(cur); }
        if (!has_next) break;
#pragma unroll
        for (int a = 0; a < 2; ++a)
#pragma unroll
            for (int b = 0; b < 2; ++b)
#pragma unroll
                for (int m = 0; m < 4; ++m)
#pragma unroll
                    for (int n = 0; n < 2; ++n) acc[a][b][m][n] = (f32x4){0.f, 0.f, 0.f, 0.f};
        cur = nxt; cA = nA; cB = nB; ++ui;
        if constexpr (ALIGN_EPI) { if (wr == 1) PG8_BAR; }
    }
    PG8_WAIT_V(0);
    if constexpr (!ALIGN_EPI) { if (wr == 0) PG8_BAR; }
    PG8_BAR;
    if constexpr (Epi::AFTER_DRAIN) { E.fused(acc, cur, wr, wc, fr, fq, lds, wid, lane); S.done(cur); }
#undef PG8_SA
#undef PG8_SB
#undef PG8_STAGE
#undef PG8_LDA
#undef PG8_LDB
#undef PG8_MMA
#undef PG8_WAIT_V
#undef PG8_WAIT_L
#undef PG8_BAR
#undef PG8_SCHED
}
}
#include <hip/hip_bf16.h>
namespace attn_body {
using bf16=__hip_bfloat16;
using bf16x8=__attribute__((ext_vector_type(8)))short;
using s16x4=__attribute__((ext_vector_type(4)))short;
using f32x16=__attribute__((ext_vector_type(16)))float;
using u32x4=__attribute__((ext_vector_type(4)))unsigned;
constexpr int SEQ=16384,D=64,PQ=512,PK=512,PV=512,PO=1024;
constexpr int NW=8,QBLK=32,QB=QBLK*NW,KVBLK=64,NQB=SEQ/QB;
constexpr int ATTN_UNIT_ROWS=QB;
__device__ __forceinline__ int crow(int r,int hi){return (r&3)+8*(r>>2)+4*hi;}
#define SBAR() __builtin_amdgcn_sched_barrier(0)
__device__ __forceinline__ void cmask(f32x16&p0,f32x16&p1,int jb,int qrel,int hi){
  const float NEG=-INFINITY; int kb=64*jb+4*hi;
  #pragma unroll
  for(int r=0;r<16;++r){int kv=kb+(r&3)+8*(r>>2); if(kv>qrel)p0[r]=NEG; if(kv+32>qrel)p1[r]=NEG;}
}

constexpr int NSLOT=3, SLOTB=8192;
constexpr int VSLOTB=2*SLOTB;
constexpr int LDS_K=0, LDS_V=NSLOT*SLOTB, LDS_WS=LDS_V+NSLOT*VSLOTB, LDS_OST=LDS_WS+NW*64*4, LDS_BYTES=LDS_OST+NW*8192;
constexpr float C2=0.125f*1.4426950408889634f;
__device__ __forceinline__ void glds16(const void*gsrc,unsigned lds_dst){unsigned keep;
  asm volatile("s_mov_b32 %0, m0\n\ts_mov_b32 m0, %2\n\ts_nop 0\n\tglobal_load_lds_dwordx4 %1, off\n\ts_mov_b32 m0, %0":"=&s"(keep):"v"(gsrc),"s"(lds_dst):"memory");}
__device__ __forceinline__ float max3f(float a,float b,float c){float r;asm("v_max3_f32 %0, %1, %2, %3":"=v"(r):"v"(a),"v"(b),"v"(c));return r;}
__device__ __forceinline__ float max2f(float a,float b){float r;asm("v_max_f32_e32 %0, %1, %2":"=v"(r):"v"(a),"v"(b));return r;}
__device__ __forceinline__ float fadd_s(float a,float b){float r;asm("v_add_f32_e32 %0, %1, %2":"=v"(r):"v"(a),"v"(b));return r;}
__device__ __forceinline__ float fsub_s(float a,float b){float r;asm("v_sub_f32_e32 %0, %1, %2":"=v"(r):"v"(a),"v"(b));return r;}
typedef float f32x2_t __attribute__((ext_vector_type(2))); typedef __bf16 bf16x2_t __attribute__((ext_vector_type(2)));
__device__ __forceinline__ unsigned cvtpk_s(float lo,float hi){f32x2_t v={lo,hi};bf16x2_t b=__builtin_convertvector(v,bf16x2_t);return __builtin_bit_cast(unsigned,b);}
#define WAIT_BAR(N) asm volatile("s_waitcnt vmcnt(" #N ") lgkmcnt(0)\n\ts_barrier":::"memory")

__device__ __forceinline__ void qkt(f32x16&p0,f32x16&p1,const char*Kslot,const bf16x8*qr,const f32x16&negm,int r32,int hi){
  const char*kb=Kslot+hi*1024+r32*16;
  #pragma unroll
  for(int d0=0;d0<4;++d0){
    const bf16x8 b0=*reinterpret_cast<const bf16x8*>(kb+d0*2048);
    const bf16x8 b1=*reinterpret_cast<const bf16x8*>(kb+d0*2048+512);
    if(d0==0){p0=__builtin_amdgcn_mfma_f32_32x32x16_bf16(b0,qr[0],negm,0,0,0);p1=__builtin_amdgcn_mfma_f32_32x32x16_bf16(b1,qr[0],negm,0,0,0);}
    else{p0=__builtin_amdgcn_mfma_f32_32x32x16_bf16(b0,qr[d0],p0,0,0,0);p1=__builtin_amdgcn_mfma_f32_32x32x16_bf16(b1,qr[d0],p1,0,0,0);}}
}
typedef __attribute__((address_space(3))) const char* lds_cptr;
typedef short v4i16_t __attribute__((ext_vector_type(4)));
__device__ __forceinline__ void kload8(bf16x8*kf,lds_cptr kp){
  kf[0]=*(const __attribute__((address_space(3))) bf16x8*)(kp);      kf[1]=*(const __attribute__((address_space(3))) bf16x8*)(kp+512);
  kf[2]=*(const __attribute__((address_space(3))) bf16x8*)(kp+2048); kf[3]=*(const __attribute__((address_space(3))) bf16x8*)(kp+2560);
  kf[4]=*(const __attribute__((address_space(3))) bf16x8*)(kp+4096); kf[5]=*(const __attribute__((address_space(3))) bf16x8*)(kp+4608);
  kf[6]=*(const __attribute__((address_space(3))) bf16x8*)(kp+6144); kf[7]=*(const __attribute__((address_space(3))) bf16x8*)(kp+6656);
}
__device__ __forceinline__ void kload2(bf16x8*kf,lds_cptr kp,int j){ kf[2*j]=*(const __attribute__((address_space(3))) bf16x8*)(kp+j*2048); kf[2*j+1]=*(const __attribute__((address_space(3))) bf16x8*)(kp+j*2048+512); }
__device__ __forceinline__ s16x4 vtr(lds_cptr p){ return __builtin_bit_cast(s16x4,__builtin_amdgcn_ds_read_tr16_b64_v4i16((__attribute__((address_space(3))) v4i16_t*)p)); }
__device__ __forceinline__ float rowmax(const f32x16&p0,const f32x16&p1){
  float a=max3f(p0[0],p0[1],p1[0]),b=max3f(p0[2],p0[3],p1[1]);a=max3f(a,p1[2],p1[3]);
  #pragma unroll
  for(int r=4;r<16;r+=4){a=max3f(a,p0[r],p0[r+1]);b=max3f(b,p0[r+2],p0[r+3]);a=max3f(a,p1[r],p1[r+1]);b=max3f(b,p1[r+2],p1[r+3]);}
  const float m=max2f(a,b);
  auto rr=__builtin_amdgcn_permlane32_swap(__float_as_uint(m),__float_as_uint(m),false,false);
  return max2f(__uint_as_float(rr[0]),__uint_as_float(rr[1]));
}
__device__ __forceinline__ void pv(f32x16*o,int vb,bf16x8 pa0,bf16x8 pa1,bf16x8 pa2,bf16x8 pa3){
  #pragma unroll
  for(int d0=0;d0<4;++d0){s16x4 lo[4],hi[4];
    #pragma unroll
    for(int ks=0;ks<4;++ks){
      asm volatile("ds_read_b64_tr_b16 %0,%1 offset:%c2":"=&v"(lo[ks]):"v"(vb),"i"((d0>>1)*8192+(d0&1)*4096+ks*1024):"memory");
      asm volatile("ds_read_b64_tr_b16 %0,%1 offset:%c2":"=&v"(hi[ks]):"v"(vb),"i"((d0>>1)*8192+(d0&1)*4096+ks*1024+512):"memory");}
    asm volatile("s_waitcnt lgkmcnt(0)":::"memory");SBAR();
    #define PK(k) (bf16x8){lo[k][0],lo[k][1],lo[k][2],lo[k][3],hi[k][0],hi[k][1],hi[k][2],hi[k][3]}
    o[d0]=__builtin_amdgcn_mfma_f32_32x32x16_bf16(pa0,PK(0),o[d0],0,0,0);
    o[d0]=__builtin_amdgcn_mfma_f32_32x32x16_bf16(pa1,PK(1),o[d0],0,0,0);
    o[d0]=__builtin_amdgcn_mfma_f32_32x32x16_bf16(pa2,PK(2),o[d0],0,0,0);
    o[d0]=__builtin_amdgcn_mfma_f32_32x32x16_bf16(pa3,PK(3),o[d0],0,0,0);
    #undef PK
  }
}

#ifndef ATTN_STORE16
#define ATTN_STORE16(p,v) (*(u32x4*)(p)=(v))
#endif
template<int THRL> __device__ __forceinline__ void attn_unit(int qb,const bf16*Q,const bf16*__restrict__ Kh,const bf16*__restrict__ Vh,bf16*O,char*shm,int wave_id){
  int tid_=mk_tid(wave_id); const int tid=tid_,lane=tid&63,r32=lane&31,hi=lane>>5; const int wid=__builtin_amdgcn_readfirstlane(tid>>6);
  const int q0=qb*QB;
  const bf16*Qw=Q+(long)(q0+wid*QBLK)*PQ;
  const unsigned lds0=(unsigned)(uintptr_t)shm;
  float*wsf=(float*)(shm+LDS_WS)+wid*64;
  const bf16*ksrc=Kh+(long)lane*PK+wid*8;
  const bf16*vsrc=Vh+(long)(16*(wid&3)+(lane>>2))*PV+(wid>>2)*32+(lane&3)*8;
  const unsigned kdst=lds0+LDS_K+wid*1024, vdst=lds0+LDS_V+wid*1024;
  #define DMA_K(t,slot) glds16(ksrc+(long)(t)*KVBLK*PK,(unsigned)__builtin_amdgcn_readfirstlane(kdst+(slot)))
  #define DMA_V(t,slot) do{ glds16(vsrc+(long)(t)*KVBLK*PV,(unsigned)__builtin_amdgcn_readfirstlane(vdst+2*(slot))); glds16(vsrc+(long)(t)*KVBLK*PV+64,(unsigned)__builtin_amdgcn_readfirstlane(vdst+2*(slot)+SLOTB)); }while(0)
  const int vb0=(int)(lds0+LDS_V)+((lane>>4)&1)*32+(lane&3)*8+(4*hi+((lane&15)>>2))*64;
  const char*Kbase=shm+LDS_K; bf16x8 kf[8];
  const lds_cptr shm3=(lds_cptr)shm; const lds_cptr kp0=shm3+LDS_K+hi*1024+r32*16; const lds_cptr vp0=shm3+LDS_V+((lane>>4)&1)*32+(lane&3)*8+(4*hi+((lane&15)>>2))*64;
  const int NT=(q0+QB)/KVBLK;
  DMA_K(0,0);DMA_V(0,0);DMA_K(1,SLOTB);
  bf16x8 qr[4];
  #pragma unroll
  for(int d0=0;d0<4;++d0)qr[d0]=*reinterpret_cast<const bf16x8*>(&Qw[(long)r32*PQ+d0*16+hi*8]);
  float l_reg=0.f;f32x16 o[4];     o[0]=f32x16{};o[1]=f32x16{};o[2]=f32x16{};o[3]=f32x16{};f32x16 negm=f32x16{};asm volatile("":"+v"(negm));
  const int qrel=wid*QBLK+r32;
  #define CMASK(P0,P1,t) do{int jb_=(t)-(NT-4); if(jb_>=0)cmask(P0,P1,jb_,qrel,hi);}while(0)
  bool resc=false;
  #define START(P0,P1) do{ const float rm=rowmax(P0,P1); resc=false; \
    { const float dl=rm; const float nm_=-dl; \
      _Pragma("unroll") for(int r=0;r<16;++r){P0[r]=fsub_s(P0[r],dl);P1[r]=fsub_s(P1[r],dl);} \
      _Pragma("unroll") for(int r=0;r<16;++r)negm[r]=nm_; asm volatile("":"+v"(negm)); } \
    _Pragma("unroll") for(int r=0;r<16;++r)P0[r]=__builtin_amdgcn_exp2f(P0[r]); }while(0)
  #define RESC() do{ if(resc){ asm volatile("s_waitcnt lgkmcnt(0)":::"memory"); \
      _Pragma("unroll") for(int d_=0;d_<4;++d_) _Pragma("unroll") for(int r=0;r<16;++r)o[d_][r]*=wsf[crow(r,hi)]; } }while(0)
  f32x16 pA0,pA1,pB0,pB1;
  int sl_prev=0,sl_cur=0,sl_next=SLOTB;
  #define ROT() do{sl_prev=sl_cur;sl_cur=sl_next;sl_next=(sl_next==(NSLOT-1)*SLOTB)?0:sl_next+SLOTB;}while(0)
  DMA_K(2,2*SLOTB);
  WAIT_BAR(3);
  qkt(pA0,pA1,Kbase,qr,negm,r32,hi);asm volatile("s_nop 15\n\ts_nop 7":"+v"(pA0),"+v"(pA1));CMASK(pA0,pA1,0);
  START(pA0,pA1);
  _Pragma("unroll") for(int r=0;r<16;++r)pA1[r]=__builtin_amdgcn_exp2f(pA1[r]);
  WAIT_BAR(0);
  DMA_K(3,0);DMA_V(1,SLOTB);
  ROT();
  kload8(kf,kp0+sl_cur);
  WAIT_BAR(3);
  s16x4 vlo[8],vhi[8]; u32x4 pw0,pw1,pw2,pw3;
  #define PKW(P,B) cvtpk_s(P[B],P[B+1])
  #define PAF(k) __builtin_bit_cast(bf16x8,pw##k)
  #define VFR(i) (bf16x8){vlo[i][0],vlo[i][1],vlo[i][2],vlo[i][3],vhi[i][0],vhi[i][1],vhi[i][2],vhi[i][3]}
  #define PIN(x) asm volatile("":"+v"(x))
  #define MX3(a,b,c) __builtin_fmaxf(__builtin_fmaxf((a),(b)),(c))
  #define GAPA(MF,A0,A1,A2,A3,W0,W1,PW) do{ MF; sacc+=A0; sacc+=A1; sacc+=A2; sacc+=A3; PIN(sacc); W0; W1; PIN(PW); SBAR(); }while(0)
  #define EX(v) __builtin_amdgcn_exp2f(v)
  #define GAPB(MF,X,B) do{ MF; X[B]=EX(X[B]); X[B+1]=EX(X[B+1]); X[B+2]=EX(X[B+2]); X[B+3]=EX(X[B+3]); PIN(X); SBAR(); }while(0)
  #define VRD(i) do{ vlo[i]=vtr(vp_+(((i)>>2)*4096+((i)&3)*1024)); vhi[i]=vtr(vp_+(((i)>>2)*4096+((i)&3)*1024+512)); }while(0)
  #define VRD2(i) do{ wlo[i]=vtr(vp_+(8192+((i)>>2)*4096+((i)&3)*1024)); whi[i]=vtr(vp_+(8192+((i)>>2)*4096+((i)&3)*1024+512)); }while(0)
  #define WFR(i) (bf16x8){wlo[i][0],wlo[i][1],wlo[i][2],wlo[i][3],whi[i][0],whi[i][1],whi[i][2],whi[i][3]}
  #define KRD(G,j) do{ if(G){ kload2(kf,kp0+sl_next,j); SBAR(); } }while(0)
  #define STEP(C0,C1,P0,P1,t,GK,GV,GL) do{ SBAR(); \
    const lds_cptr vp_=vp0+2*sl_prev; \
    float sacc=(P0[0]+P0[1]); \
    GAPA(C0=__builtin_amdgcn_mfma_f32_32x32x16_bf16(kf[0],qr[0],negm,0,0,0), P0[2],P0[3],P0[4],P0[5],     pw0[0]=PKW(P0,0), pw0[1]=PKW(P0,2), pw0); \
    GAPA(C1=__builtin_amdgcn_mfma_f32_32x32x16_bf16(kf[1],qr[0],negm,0,0,0), P0[6],P0[7],P0[8],P0[9],     pw0[2]=PKW(P0,4), pw0[3]=PKW(P0,6), pw0); \
    GAPA(C0=__builtin_amdgcn_mfma_f32_32x32x16_bf16(kf[2],qr[1],C0,0,0,0),   P0[10],P0[11],P0[12],P0[13], pw1[0]=PKW(P0,8), pw1[1]=PKW(P0,10), pw1); \
    GAPA(C1=__builtin_amdgcn_mfma_f32_32x32x16_bf16(kf[3],qr[1],C1,0,0,0),   P0[14],P0[15],P1[0],P1[1],   pw1[2]=PKW(P0,12),pw1[3]=PKW(P0,14), pw1); \
    GAPA(C0=__builtin_amdgcn_mfma_f32_32x32x16_bf16(kf[4],qr[2],C0,0,0,0),   P1[2],P1[3],P1[4],P1[5],     pw2[0]=PKW(P1,0), pw2[1]=PKW(P1,2), pw2); \
    GAPA(C1=__builtin_amdgcn_mfma_f32_32x32x16_bf16(kf[5],qr[2],C1,0,0,0),   P1[6],P1[7],P1[8],P1[9],     pw2[2]=PKW(P1,4), pw2[3]=PKW(P1,6), pw2); \
    GAPA(C0=__builtin_amdgcn_mfma_f32_32x32x16_bf16(kf[6],qr[3],C0,0,0,0),   P1[10],P1[11],P1[12],P1[13], pw3[0]=PKW(P1,8), pw3[1]=PKW(P1,10), pw3); \
    GAPA(C1=__builtin_amdgcn_mfma_f32_32x32x16_bf16(kf[7],qr[3],C1,0,0,0),   P1[14],P1[15],0.f,0.f,       pw3[2]=PKW(P1,12),pw3[3]=PKW(P1,14), pw3); \
    l_reg+=sacc; \
    if(GK){DMA_K((t)+3,sl_cur);} if(GV){DMA_V((t)+1,sl_next);} \
    SBAR(); VRD(0); VRD(4); VRD(1); VRD(5); SBAR(); \
    CMASK(C0,C1,t); \
    { float a=MX3(C0[0],C0[1],C1[0]),b=MX3(C0[2],C0[3],C1[1]); a=MX3(a,C1[2],C1[3]); \
      _Pragma("unroll") for(int r=4;r<16;r+=4){a=MX3(a,C0[r],C0[r+1]);b=MX3(b,C0[r+2],C0[r+3]);a=MX3(a,C1[r],C1[r+1]);b=MX3(b,C1[r+2],C1[r+3]);} \
      float rm=__builtin_fmaxf(a,b); { auto rr=__builtin_amdgcn_permlane32_swap(__float_as_uint(rm),__float_as_uint(rm),false,false); rm=__builtin_fmaxf(__uint_as_float(rr[0]),__uint_as_float(rr[1])); } \
      resc=false; \
      if(__builtin_expect(__any(rm>(float)THRL),0)){ const float dl=__builtin_fmaxf(rm,0.f); const float nm_=negm[0]-dl; \
        _Pragma("unroll") for(int r=0;r<16;++r){C0[r]-=dl;C1[r]-=dl;} \
        _Pragma("unroll") for(int r=0;r<16;++r)negm[r]=nm_; asm volatile("":"+v"(negm)); \
        const float f=__builtin_amdgcn_exp2f(-dl); l_reg*=f; { int r32_=lane; asm volatile("":"+v"(r32_)); if(r32_<32)wsf[r32_]=f; } resc=true; } } \
    SBAR(); \
    VRD(2); SBAR(); GAPB(o[0]=__builtin_amdgcn_mfma_f32_32x32x16_bf16(PAF(0),VFR(0),o[0],0,0,0), C0,0); \
    VRD(6); SBAR(); GAPB(o[1]=__builtin_amdgcn_mfma_f32_32x32x16_bf16(PAF(0),VFR(4),o[1],0,0,0), C0,4); \
    VRD(3); SBAR(); KRD(GL,0); GAPB(o[0]=__builtin_amdgcn_mfma_f32_32x32x16_bf16(PAF(1),VFR(1),o[0],0,0,0), C0,8); \
    VRD(7); SBAR(); KRD(GL,1); GAPB(o[1]=__builtin_amdgcn_mfma_f32_32x32x16_bf16(PAF(1),VFR(5),o[1],0,0,0), C0,12); \
    KRD(GL,2); GAPB(o[0]=__builtin_amdgcn_mfma_f32_32x32x16_bf16(PAF(2),VFR(2),o[0],0,0,0), C1,0); \
    KRD(GL,3); GAPB(o[1]=__builtin_amdgcn_mfma_f32_32x32x16_bf16(PAF(2),VFR(6),o[1],0,0,0), C1,4); \
    s16x4 wlo[8],whi[8]; \
    GAPB(o[0]=__builtin_amdgcn_mfma_f32_32x32x16_bf16(PAF(3),VFR(3),o[0],0,0,0), C1,8); \
    GAPB(o[1]=__builtin_amdgcn_mfma_f32_32x32x16_bf16(PAF(3),VFR(7),o[1],0,0,0), C1,12); \
    VRD2(0); VRD2(4); VRD2(1); SBAR(); o[2]=__builtin_amdgcn_mfma_f32_32x32x16_bf16(PAF(0),WFR(0),o[2],0,0,0); SBAR(); \
    VRD2(5); SBAR(); o[3]=__builtin_amdgcn_mfma_f32_32x32x16_bf16(PAF(0),WFR(4),o[3],0,0,0); SBAR(); \
    VRD2(2); SBAR(); o[2]=__builtin_amdgcn_mfma_f32_32x32x16_bf16(PAF(1),WFR(1),o[2],0,0,0); SBAR(); \
    VRD2(6); SBAR(); o[3]=__builtin_amdgcn_mfma_f32_32x32x16_bf16(PAF(1),WFR(5),o[3],0,0,0); SBAR(); \
    VRD2(3); SBAR(); o[2]=__builtin_amdgcn_mfma_f32_32x32x16_bf16(PAF(2),WFR(2),o[2],0,0,0); SBAR(); \
    VRD2(7); SBAR(); o[3]=__builtin_amdgcn_mfma_f32_32x32x16_bf16(PAF(2),WFR(6),o[3],0,0,0); SBAR(); \
    o[2]=__builtin_amdgcn_mfma_f32_32x32x16_bf16(PAF(3),WFR(3),o[2],0,0,0); SBAR(); \
    o[3]=__builtin_amdgcn_mfma_f32_32x32x16_bf16(PAF(3),WFR(7),o[3],0,0,0); SBAR(); \
    }while(0)
  int t=1;
  #undef CMASK
  #define CMASK(P0,P1,t) do{}while(0)
  for(;t+5<NT;t+=2){
    STEP(pB0,pB1,pA0,pA1,t,true,true,true);     WAIT_BAR(3); RESC(); ROT();
    STEP(pA0,pA1,pB0,pB1,t+1,true,true,true);   WAIT_BAR(3); RESC(); ROT();
  }
  #undef CMASK
  #define CMASK(P0,P1,t) do{int jb_=(t)-(NT-4); if(jb_>=0)cmask(P0,P1,jb_,qrel,hi);}while(0)
  #define ENDW(tt) do{ if((tt)+3<NT){WAIT_BAR(3);} else if((tt)+2<NT){WAIT_BAR(2);} else {WAIT_BAR(0);} }while(0)
  for(;t+1<NT;t+=2){
    STEP(pB0,pB1,pA0,pA1,t,(t+3<NT),(t+1<NT),(t+1<NT));       ENDW(t);   RESC(); ROT();
    STEP(pA0,pA1,pB0,pB1,t+1,(t+4<NT),(t+2<NT),(t+2<NT));     ENDW(t+1); RESC(); ROT();
  }
  STEP(pB0,pB1,pA0,pA1,NT-1,false,false,false); RESC();
  { float sacc=pB0[0]+pB0[1]; _Pragma("unroll") for(int r=2;r<16;++r)sacc+=pB0[r]; _Pragma("unroll") for(int r=0;r<16;++r)sacc+=pB1[r]; l_reg+=sacc;
    pw0=(u32x4){PKW(pB0,0),PKW(pB0,2),PKW(pB0,4),PKW(pB0,6)};pw1=(u32x4){PKW(pB0,8),PKW(pB0,10),PKW(pB0,12),PKW(pB0,14)};pw2=(u32x4){PKW(pB1,0),PKW(pB1,2),PKW(pB1,4),PKW(pB1,6)};pw3=(u32x4){PKW(pB1,8),PKW(pB1,10),PKW(pB1,12),PKW(pB1,14)};
    SBAR(); pv(o,vb0+2*sl_cur,PAF(0),PAF(1),PAF(2),PAF(3)); }
  #undef PKW
  #undef PAF
  #undef VFR
  #undef PIN
  #undef MX3
  #undef GAPA
  #undef GAPB
  #undef EX
  #undef VRD
  #undef VRD2
  #undef WFR
  #undef KRD
  #undef STEP
  #undef ENDW
  {auto rr=__builtin_amdgcn_permlane32_swap(__float_as_uint(l_reg),__float_as_uint(l_reg),false,false);l_reg=__uint_as_float(rr[0])+__uint_as_float(rr[1]);}
  if(hi==0)wsf[32+r32]=l_reg;asm volatile("s_waitcnt lgkmcnt(0)":::"memory");
  float rli[16];
  #pragma unroll
  for(int r=0;r<16;++r)rli[r]=__builtin_amdgcn_rcpf(wsf[32+crow(r,hi)]);
  bf16*Ow=O+(long)(q0+wid*QBLK)*PO;
  { bf16*stg=(bf16*)(shm+LDS_OST)+wid*4096;
    #pragma unroll
    for(int r=0;r<16;++r){const int orow=crow(r,hi);
      #pragma unroll
      for(int d0=0;d0<4;++d0)stg[orow*128+d0*32+r32]=__float2bfloat16(o[d0][r]*rli[r]);}
    asm volatile("s_waitcnt lgkmcnt(0)":::"memory");
    #pragma unroll
    for(int i=0;i<8;++i){const int row=i*4+(lane>>4),ch=lane&15; const u32x4 v=*(const u32x4*)(stg+row*128+ch*8); ATTN_STORE16(Ow+(long)row*PO+ch*8,v);} }
  asm volatile("s_waitcnt lgkmcnt(0)\n\ts_barrier":::"memory");
  #undef DMA_K
  #undef DMA_V
  #undef CMASK
  #undef START
  #undef RESC
  #undef ROT
}
constexpr int ATTN_LDS_BYTES=LDS_BYTES;
#undef SBAR
#undef WAIT_BAR
}
namespace cg = cooperative_groups;
#define GAS __attribute__((address_space(1)))
#define LAS __attribute__((address_space(3)))
typedef unsigned short bf16;
typedef unsigned v4u __attribute__((ext_vector_type(4)));
typedef unsigned v2u __attribute__((ext_vector_type(2)));
typedef float f32x4 __attribute__((ext_vector_type(4)));
typedef short bf16x8 __attribute__((ext_vector_type(8)));
typedef short s16x4 __attribute__((ext_vector_type(4)));

#ifndef MK_ONE_LAUNCH
#define MK_ONE_LAUNCH 1
#endif
constexpr int NWAVES = 8;
constexpr int SEQ = 16384, DM = 1024, NIN = 8704, NMAIN = 5632, NGATE = 3072, DEPTH = 2;
constexpr float EPS = 1e-6f;
constexpr float QSCALE = 0.125f * 1.4426950408889634f;
constexpr size_t MiB = 1u << 20;
constexpr size_t WS_ROPE = 0;
constexpr size_t WS_WIN = 1 * MiB;
constexpr size_t WS_WB = 18 * MiB;
constexpr size_t WS_WO = 21 * MiB;
constexpr size_t WS_HB = 23 * MiB;
constexpr size_t WS_O = 55 * MiB;
constexpr size_t WS_PJ = 87 * MiB;
constexpr size_t SLOT_ELEMS = (size_t)SEQ * 512;
constexpr int YP = 1536;
constexpr size_t WS_BAR = WS_PJ + 11 * SLOT_ELEMS * 2;
constexpr size_t WS_END = WS_BAR + 65536;
enum { SL_AQ = 0, SL_AK = 1, SL_AV = 2, SL_BU = 3, SL_BV = 4, SL_CQ = 5, SL_CK = 6, SL_CV = 7, SL_AZ = 8, SL_BZ = 9, SL_CZ = 10 };

constexpr int LDS_BYTES = 147456;

__device__ __forceinline__ unsigned f2bf(float f) { unsigned u = __builtin_bit_cast(unsigned, f); return (u + 0x7fffu + ((u >> 16) & 1u)) >> 16; }
typedef float f32x2_t __attribute__((ext_vector_type(2))); typedef __bf16 bf16x2_t __attribute__((ext_vector_type(2)));
__device__ __forceinline__ unsigned pk2(float lo, float hi) { f32x2_t v = {lo, hi}; bf16x2_t b = __builtin_convertvector(v, bf16x2_t); return __builtin_bit_cast(unsigned, b); }
__device__ __forceinline__ float bflo(unsigned w) { return __uint_as_float(w << 16); }
__device__ __forceinline__ float bfhi(unsigned w) { return __uint_as_float(w & 0xffff0000u); }
__device__ __forceinline__ float fexp2(float x) { return __builtin_amdgcn_exp2f(x); }
__device__ __forceinline__ float frcp(float x) { return __builtin_amdgcn_rcpf(x); }
__device__ __forceinline__ float sigmoid_f(float x) { return frcp(1.f + fexp2(-1.4426950408889634f * x)); }
__device__ __forceinline__ float silu_f(float x) { return x * sigmoid_f(x); }
__device__ __forceinline__ float gelu_tanh_f(float x) { const float y = 0.7978845608028654f * (x + 0.044715f * x * x * x); return x * frcp(1.f + fexp2(-2.885390081777927f * y)); }
__device__ __forceinline__ float wave_sum(float v) {
#pragma unroll
    for (int o = 1; o < 64; o <<= 1) v += __shfl_xor(v, o);
    return v;
}

struct EpiProj {
    static constexpr bool PERM = true, AFTER_DRAIN = false;
    bf16* PJ; const float* rc; const float* rs;
    __device__ __forceinline__ void operator()(const f32x4 (&acc)[2][2][4][2], const pg8::Unit& u, int wr, int wc, int fr_, int fq_) const {
        int fr = fr_, fq = fq_; asm volatile("" : "+v"(fr), "+v"(fq));
        const int grp = u.pn >> 1;
        const int slot = (int)((0xA7659438210ull >> (4 * grp)) & 15ull);
        const int act = (int)((0x10341221034ull >> (4 * grp)) & 15ull);
        const bool isy = (act == 1); const int pitch = isy ? YP : 512;
        bf16* base = isy ? PJ + (size_t)SL_AZ * SLOT_ELEMS + (grp == 3 ? 0 : (grp == 6 ? 512 : 1024)) : PJ + (size_t)slot * SLOT_ELEMS;
        const int row0 = u.pm * 256 + wr * 64 + fr, col0 = (u.pn & 1) * 256 + wc * 32 + 8 * fq;
        const bool ropew = (act >= 3) && ((wc & 1) == 0);
        const float sgn = (fq == 0) ? -1.f : 1.f; const bool ropel = fq < 2;
        const float qs = (act == 4) ? QSCALE : 1.f;
#pragma unroll
        for (int ai = 0; ai < 2; ++ai) {
            f32x4 Cc[4][2], Ss[4][2];
            if (ropew) {
#pragma unroll
                for (int m = 0; m < 4; ++m) { const int row = row0 + ai * 128 + m * 16;
                    Cc[m][0] = *(const f32x4*)(rc + row * 8); Cc[m][1] = *(const f32x4*)(rc + row * 8 + 4); Ss[m][0] = *(const f32x4*)(rs + row * 8); Ss[m][1] = *(const f32x4*)(rs + row * 8 + 4); }
                __builtin_amdgcn_sched_barrier(0);
            }
#pragma unroll
            for (int m = 0; m < 4; ++m) {
                const int row = row0 + ai * 128 + m * 16;
#pragma unroll
                for (int bj = 0; bj < 2; ++bj) {
                    f32x4 v0 = acc[ai][bj][m][0], v1 = acc[ai][bj][m][1];
                    if (ropew) {
                        f32x4 o0, o1;
#pragma unroll
                        for (int e = 0; e < 4; ++e) { o0[e] = __shfl_xor(v0[e], 16); o1[e] = __shfl_xor(v1[e], 16); }
                        if (ropel) { v0 = v0 * Cc[m][0] + sgn * (o0 * Ss[m][0]); v1 = v1 * Cc[m][1] + sgn * (o1 * Ss[m][1]); }
                    }
                    if (act == 1) {
#pragma unroll
                        for (int e = 0; e < 4; ++e) { v0[e] = silu_f(v0[e]); v1[e] = silu_f(v1[e]); }
                    } else if (act == 2) {
#pragma unroll
                        for (int e = 0; e < 4; ++e) { v0[e] = gelu_tanh_f(v0[e]); v1[e] = gelu_tanh_f(v1[e]); }
                    }
                    v0 = v0 * qs; v1 = v1 * qs;
                    v4u w; w.x = pk2(v0[0], v0[1]); w.y = pk2(v0[2], v0[3]); w.z = pk2(v1[0], v1[1]); w.w = pk2(v1[2], v1[3]);
                    *(v4u*)(base + (size_t)row * pitch + col0 + bj * 128) = w;
                }
            }
            asm volatile("" ::: "memory");
        }
    }
};
struct EpiGate {
    static constexpr bool PERM = true, AFTER_DRAIN = false;
    bf16* GL;
    __device__ __forceinline__ void operator()(const f32x4 (&acc)[2][2][4][2], const pg8::Unit& u, int wr, int wc, int fr_, int fq_) const {
        int fr = fr_, fq = fq_; asm volatile("" : "+v"(fr), "+v"(fq));
        const int row0 = u.pm * 256 + wr * 64 + fr, col0 = u.pn * 256 + wc * 32 + 8 * fq;
#pragma unroll
        for (int ai = 0; ai < 2; ++ai)
#pragma unroll
            for (int m = 0; m < 4; ++m) {
                const int row = row0 + ai * 128 + m * 16;
#pragma unroll
                for (int bj = 0; bj < 2; ++bj) {
                    f32x4 v0 = acc[ai][bj][m][0], v1 = acc[ai][bj][m][1];
#pragma unroll
                    for (int e = 0; e < 4; ++e) { v0[e] = sigmoid_f(v0[e]); v1[e] = sigmoid_f(v1[e]); }
                    v4u w; w.x = pk2(v0[0], v0[1]); w.y = pk2(v0[2], v0[3]); w.z = pk2(v1[0], v1[1]); w.w = pk2(v1[2], v1[3]);
                    *(v4u*)(GL + (size_t)row * NGATE + col0 + bj * 128) = w; asm volatile("" ::: "memory");
                }
            }
    }
};
__device__ __forceinline__ float gclamp(float g) { return fmaxf(g, 1e-6f); }
struct MergeHook {
    static constexpr int PERIOD = 8;
    const bf16* GL;
    __device__ __forceinline__ void operator()(f32x4 (&acc)[2][2][4][2], const pg8::Unit& u, int seg, int wr, int wc, int fr_, int fq_) const {
        int fr = fr_, fq = fq_; asm volatile("" : "+v"(fr), "+v"(fq));
        const int row0 = u.pm * 256 + wr * 64 + fr, col0 = u.pn * 256 + wc * 32 + 8 * fq;
        const bf16* gn = GL + (seg - 1) * 1024 + col0; const bf16* gd = GL + seg * 1024 + col0; const bool cl = seg > 1;
#pragma unroll
        for (int ai = 0; ai < 2; ++ai) {
            v4u A[4][2], B[4][2];
#pragma unroll
            for (int m = 0; m < 4; ++m)
#pragma unroll
                for (int bj = 0; bj < 2; ++bj) { const size_t ro = (size_t)(row0 + ai * 128 + m * 16) * NGATE + bj * 128; A[m][bj] = *(const v4u*)(gn + ro); B[m][bj] = *(const v4u*)(gd + ro); }
            __builtin_amdgcn_sched_barrier(0);
#pragma unroll
            for (int m = 0; m < 4; ++m)
#pragma unroll
                for (int bj = 0; bj < 2; ++bj) {
                    const v4u a = A[m][bj], b = B[m][bj];
                    float n_[8] = {bflo(a.x), bfhi(a.x), bflo(a.y), bfhi(a.y), bflo(a.z), bfhi(a.z), bflo(a.w), bfhi(a.w)};
                    float d_[8] = {bflo(b.x), bfhi(b.x), bflo(b.y), bfhi(b.y), bflo(b.z), bfhi(b.z), bflo(b.w), bfhi(b.w)};
#pragma unroll
                    for (int e = 0; e < 8; ++e) { const float nn = cl ? gclamp(n_[e]) : n_[e]; const float rr = nn * frcp(gclamp(d_[e])); if (e < 4) acc[ai][bj][m][0][e] *= rr; else acc[ai][bj][m][1][e - 4] *= rr; }
                }
            asm volatile("" ::: "memory");
        }
    }
};
struct EpiMerge {
    static constexpr bool PERM = true, AFTER_DRAIN = false;
    const bf16* GL; bf16* MG;
    __device__ __forceinline__ void operator()(const f32x4 (&acc)[2][2][4][2], const pg8::Unit& u, int wr, int wc, int fr_, int fq_) const {
        int fr = fr_, fq = fq_; asm volatile("" : "+v"(fr), "+v"(fq));
        const int row0 = u.pm * 256 + wr * 64 + fr, col0 = u.pn * 256 + wc * 32 + 8 * fq;
#pragma unroll
        for (int ai = 0; ai < 2; ++ai) {
            v4u Gt[4][2];
#pragma unroll
            for (int m = 0; m < 4; ++m)
#pragma unroll
                for (int bj = 0; bj < 2; ++bj) Gt[m][bj] = *(const v4u*)(GL + (size_t)(row0 + ai * 128 + m * 16) * NGATE + 2 * 1024 + col0 + bj * 128);
            __builtin_amdgcn_sched_barrier(0);
#pragma unroll
            for (int m = 0; m < 4; ++m)
#pragma unroll
                for (int bj = 0; bj < 2; ++bj) {
                    const int row = row0 + ai * 128 + m * 16; const v4u g = Gt[m][bj];
                    f32x4 v0 = acc[ai][bj][m][0], v1 = acc[ai][bj][m][1];
                    v0[0] *= gclamp(bflo(g.x)); v0[1] *= gclamp(bfhi(g.x)); v0[2] *= gclamp(bflo(g.y)); v0[3] *= gclamp(bfhi(g.y));
                    v1[0] *= gclamp(bflo(g.z)); v1[1] *= gclamp(bfhi(g.z)); v1[2] *= gclamp(bflo(g.w)); v1[3] *= gclamp(bfhi(g.w));
                    v4u w; w.x = pk2(v0[0], v0[1]); w.y = pk2(v0[2], v0[3]); w.z = pk2(v1[0], v1[1]); w.w = pk2(v1[2], v1[3]);
                    *(v4u*)(MG + (size_t)row * DM + col0 + bj * 128) = w;
                }
            asm volatile("" ::: "memory");
        }
    }
};
struct EpiOut {
    static constexpr bool PERM = true, AFTER_DRAIN = false;
    const float* res; float* out;
    __device__ __forceinline__ void operator()(const f32x4 (&acc)[2][2][4][2], const pg8::Unit& u, int wr, int wc, int fr_, int fq_) const {
        int fr = fr_, fq = fq_; asm volatile("" : "+v"(fr), "+v"(fq));
        const int row0 = u.pm * 256 + wr * 64 + fr, col0 = u.pn * 256 + wc * 32 + 8 * fq;
#pragma unroll
        for (int ai = 0; ai < 2; ++ai) {
            f32x4 R[4][2][2];
#pragma unroll
            for (int m = 0; m < 4; ++m)
#pragma unroll
                for (int bj = 0; bj < 2; ++bj) { const size_t off = (size_t)(row0 + ai * 128 + m * 16) * DM + col0 + bj * 128; R[m][bj][0] = *(const f32x4*)(res + off); R[m][bj][1] = *(const f32x4*)(res + off + 4); }
            __builtin_amdgcn_sched_barrier(0);
#pragma unroll
            for (int m = 0; m < 4; ++m)
#pragma unroll
                for (int bj = 0; bj < 2; ++bj) { const size_t off = (size_t)(row0 + ai * 128 + m * 16) * DM + col0 + bj * 128;
                    *(f32x4*)(out + off) = R[m][bj][0] + acc[ai][bj][m][0]; *(f32x4*)(out + off + 4) = R[m][bj][1] + acc[ai][bj][m][1]; }
            asm volatile("" ::: "memory");
        }
    }
};

__device__ __forceinline__ void p0_transpose_item(const float* W, int K, int N, bf16* WT, int ldk, LAS float* scr, int item, int lane) {
    const int nblk = N / 32, kb = item / nblk, nb = item % nblk, k0 = 64 * kb, n0 = 32 * nb;
#pragma unroll 8
    for (int i = 0; i < 32; ++i) { const int kk = 2 * i + (lane >> 5); scr[kk * 33 + (lane & 31)] = W[(size_t)(k0 + kk) * N + n0 + (lane & 31)]; }
    asm volatile("s_waitcnt lgkmcnt(0)" ::: "memory");
    const int c = lane & 7;
#pragma unroll
    for (int j = 0; j < 4; ++j) { const int n = (lane >> 3) + 8 * j; const LAS float* s = scr + (8 * c) * 33 + n;
        v4u o; o.x = pk2(s[0 * 33], s[1 * 33]); o.y = pk2(s[2 * 33], s[3 * 33]); o.z = pk2(s[4 * 33], s[5 * 33]); o.w = pk2(s[6 * 33], s[7 * 33]);
        *(v4u*)(WT + (size_t)(n0 + n) * ldk + k0 + 8 * c) = o; }
    asm volatile("s_waitcnt lgkmcnt(0)" ::: "memory");
}
template <int NR, bool OUTBF> __device__ __forceinline__ void rms_rows(const float* x, size_t rstride, const float* g, void* o, int lane) {
    f32x4 v[NR][4]; float r[NR];
#pragma unroll
    for (int k = 0; k < NR; ++k)
#pragma unroll
        for (int j = 0; j < 4; ++j) v[k][j] = ((const f32x4*)(x + k * rstride) + lane)[64 * j];
#pragma unroll
    for (int k = 0; k < NR; ++k) { float s = 0.f;
#pragma unroll
        for (int j = 0; j < 4; ++j) s += (v[k][j].x * v[k][j].x + v[k][j].y * v[k][j].y) + (v[k][j].z * v[k][j].z + v[k][j].w * v[k][j].w);
        r[k] = 1.f / sqrtf(wave_sum(s) * (1.f / DM) + EPS); }
    const f32x4* gr = (const f32x4*)g + lane;
#pragma unroll
    for (int j = 0; j < 4; ++j) { const f32x4 gg = gr[64 * j];
#pragma unroll
        for (int k = 0; k < NR; ++k) { const f32x4 y = v[k][j] * r[k] * gg;
            if (OUTBF) ((unsigned long long*)((bf16*)o + k * rstride) + lane)[64 * j] = (unsigned long long)pk2(y.x, y.y) | ((unsigned long long)pk2(y.z, y.w) << 32);
            else ((f32x4*)((float*)o + k * rstride) + lane)[64 * j] = y; } }
}
constexpr int SGU_P = 136;
__device__ __forceinline__ void sgu_item(int item, const bf16* BU, const bf16* BV, bf16* BZ, const float* lng, const float* lnb, const float* sw, const float* sb,
                                         LAS unsigned char* lds, int tid, int wid, int lane) {
    const int n = item >> 2, g = item & 3, tok0 = n * 128;
    LAS bf16* Wl = (LAS bf16*)lds; LAS bf16* Vt = (LAS bf16*)(lds + 128 * SGU_P * 2); LAS float* st = (LAS float*)(lds + 2 * 128 * SGU_P * 2);
    const int r = lane & 15, q = lane >> 4, t = wid * 16 + r;
    v4u w16[16];
#pragma unroll
    for (int i = 0; i < 16; ++i) w16[i] = *(const v4u*)(BV + (size_t)(tok0 + wid * 16 + i) * 512 + lane * 8);
    v4u vst[4]; f32x4 G0[4], G1[4], B0[4], B1[4];
#pragma unroll
    for (int k = 0; k < 4; ++k) { const int idx = tid + 512 * k, s_ = idx >> 4, cch = idx & 15;
        vst[k] = *(const v4u*)(BV + (size_t)(tok0 + s_) * 512 + g * 128 + cch * 8);
        G0[k] = *(const f32x4*)(lng + g * 128 + cch * 8); G1[k] = *(const f32x4*)(lng + g * 128 + cch * 8 + 4); B0[k] = *(const f32x4*)(lnb + g * 128 + cch * 8); B1[k] = *(const f32x4*)(lnb + g * 128 + cch * 8 + 4); }
    f32x4 wW[8];
#pragma unroll
    for (int k = 0; k < 8; ++k) { const int idx = tid + 512 * k, tt = idx >> 5, s4 = (idx & 31) * 4; wW[k] = *(const f32x4*)(sw + ((size_t)g * 128 + tt) * 128 + s4); }
    v2u uu[8], zz[8];
#pragma unroll
    for (int ct = 0; ct < 8; ++ct) { uu[ct] = *(const v2u*)(BU + (size_t)(tok0 + t) * 512 + g * 128 + ct * 16 + q * 4); zz[ct] = *(const v2u*)(BZ + (size_t)(tok0 + t) * YP + g * 128 + ct * 16 + q * 4); }
    const float bias = sb[g * 128 + t];
    __builtin_amdgcn_sched_barrier(0);
#pragma unroll
    for (int i = 0; i < 16; ++i) {
        const int s_ = wid * 16 + i; const v4u w = w16[i];
        const float a0 = bflo(w.x), a1 = bfhi(w.x), a2 = bflo(w.y), a3 = bfhi(w.y), a4 = bflo(w.z), a5 = bfhi(w.z), a6 = bflo(w.w), a7 = bfhi(w.w);
        const float mu = wave_sum(((a0 + a1) + (a2 + a3)) + ((a4 + a5) + (a6 + a7))) * (1.f / 512.f);
        const float d0 = a0 - mu, d1 = a1 - mu, d2 = a2 - mu, d3 = a3 - mu, d4 = a4 - mu, d5 = a5 - mu, d6 = a6 - mu, d7 = a7 - mu;
        const float var = wave_sum(((d0 * d0 + d1 * d1) + (d2 * d2 + d3 * d3)) + ((d4 * d4 + d5 * d5) + (d6 * d6 + d7 * d7))) * (1.f / 512.f);
        if (lane == 0) { st[s_] = mu; st[128 + s_] = 1.f / sqrtf(var + EPS); }
    }
    __syncthreads();
#pragma unroll
    for (int k = 0; k < 4; ++k) {
        const int idx = tid + 512 * k, s_ = idx >> 4, cch = idx & 15; const v4u w = vst[k];
        const float mu = st[s_], rstd = st[128 + s_];
        float a[8] = {bflo(w.x), bfhi(w.x), bflo(w.y), bfhi(w.y), bflo(w.z), bfhi(w.z), bflo(w.w), bfhi(w.w)};
#pragma unroll
        for (int e = 0; e < 8; ++e) { const float gg = e < 4 ? G0[k][e & 3] : G1[k][e & 3], bb = e < 4 ? B0[k][e & 3] : B1[k][e & 3]; a[e] = (a[e] - mu) * rstd * gg + bb; }
        v4u o; o.x = pk2(a[0], a[1]); o.y = pk2(a[2], a[3]); o.z = pk2(a[4], a[5]); o.w = pk2(a[6], a[7]);
        *(LAS v4u*)(Vt + s_ * SGU_P + cch * 8) = o;
    }
#pragma unroll
    for (int k = 0; k < 8; ++k) {
        const int idx = tid + 512 * k, tt = idx >> 5, s4 = (idx & 31) * 4; const f32x4 w = wW[k];
        v2u o; o.x = pk2(s4 + 0 <= tt ? w.x : 0.f, s4 + 1 <= tt ? w.y : 0.f); o.y = pk2(s4 + 2 <= tt ? w.z : 0.f, s4 + 3 <= tt ? w.w : 0.f);
        *(LAS v2u*)(Wl + tt * SGU_P + s4) = o;
    }
    __syncthreads();
    typedef short v4i16_t __attribute__((ext_vector_type(4)));
    f32x4 acc[8];
#pragma unroll
    for (int ct = 0; ct < 8; ++ct) acc[ct] = (f32x4){0.f, 0.f, 0.f, 0.f};
#pragma unroll
    for (int ks = 0; ks < 4; ++ks) {
        const bf16x8 wf = *(const LAS bf16x8*)(Wl + (wid * 16 + r) * SGU_P + ks * 32 + q * 8);
#pragma unroll
        for (int ct = 0; ct < 8; ++ct) {
            const LAS bf16* tp = Vt + (ks * 32 + q * 8 + ((r >> 2) & 3)) * SGU_P + ct * 16 + (r & 3) * 4;
            const s16x4 lo = __builtin_bit_cast(s16x4, __builtin_amdgcn_ds_read_tr16_b64_v4i16((LAS v4i16_t*)tp));
            const s16x4 hi = __builtin_bit_cast(s16x4, __builtin_amdgcn_ds_read_tr16_b64_v4i16((LAS v4i16_t*)(tp + 4 * SGU_P)));
            const bf16x8 vf = (bf16x8){lo[0], lo[1], lo[2], lo[3], hi[0], hi[1], hi[2], hi[3]};
            acc[ct] = __builtin_amdgcn_mfma_f32_16x16x32_bf16(vf, wf, acc[ct], 0, 0, 0);
        }
    }
#pragma unroll
    for (int ct = 0; ct < 8; ++ct) {
        const size_t offz = (size_t)(tok0 + t) * YP + g * 128 + ct * 16 + q * 4;
        v2u o; o.x = pk2((acc[ct][0] + bias) * bflo(uu[ct].x) * bflo(zz[ct].x), (acc[ct][1] + bias) * bfhi(uu[ct].x) * bfhi(zz[ct].x));
        o.y = pk2((acc[ct][2] + bias) * bflo(uu[ct].y) * bflo(zz[ct].y), (acc[ct][3] + bias) * bfhi(uu[ct].y) * bfhi(zz[ct].y));
        *(v2u*)(BZ + offz) = o;
    }
    __syncthreads();
}

constexpr int CM_PB = 144, CM_NG = 4, CM_BLK = 128 * CM_NG;
constexpr int CM_S0 = (CM_BLK + 128) / 32, CM_S1 = (512 + CM_BLK - 8 + 4 * 32 - 1) / (4 * 32), CM_S2 = (2048 + CM_BLK - 8 + 8 * 32 - 1) / (8 * 32), CM_NSTEP = CM_S0 + CM_S1 + CM_S2;
struct CmStep { int kbase, sl, window, dmask, kk0; };
__device__ __forceinline__ CmStep cm_step(int j, int T0, int wid) {
    CmStep p;
    if (j < CM_S0) { p.kbase = T0 - 128; p.sl = 0; p.window = 128; p.dmask = 0; p.kk0 = 32 * j; }
    else if (j < CM_S0 + CM_S1) { p.kbase = T0 + wid - 512; p.sl = 2; p.window = 512; p.dmask = 0; p.kk0 = 32 * (j - CM_S0); }
    else { p.kbase = T0 + wid - 2048; p.sl = 3; p.window = 2048; p.dmask = 15; p.kk0 = 32 * (j - CM_S0 - CM_S1); }
    return p;
}
__device__ __forceinline__ void cm_load(int j, int T0, int wid, int h, int r, int q, int vkey, int vch, const bf16* CK, const bf16* CV, bf16x8 (&kf)[4], bf16x8 (&vv)[4]) {
    if (j >= CM_NSTEP) return;
    const CmStep p = cm_step(j, T0, wid);
    int tA = p.kbase + ((p.kk0 + r) << p.sl), tB = p.kbase + ((p.kk0 + 16 + r) << p.sl);
    tA = min(max(tA, 0), SEQ - 1); tB = min(max(tB, 0), SEQ - 1);
    const bf16* pa = CK + (size_t)tA * 512 + h * 64 + q * 8; const bf16* pb = CK + (size_t)tB * 512 + h * 64 + q * 8;
    kf[0] = *(const bf16x8*)pa; kf[1] = *(const bf16x8*)(pa + 32); kf[2] = *(const bf16x8*)pb; kf[3] = *(const bf16x8*)(pb + 32);
#pragma unroll
    for (int c = 0; c < 4; ++c) { int tv = p.kbase + ((p.kk0 + vkey + 8 * c) << p.sl); tv = min(max(tv, 0), SEQ - 1); vv[c] = *(const bf16x8*)(CV + (size_t)tv * 512 + h * 64 + vch * 8); }
}
struct CmQ { bf16x8 qf[2]; float mrun, lpart; f32x4 o[4]; int tq; };
__device__ __forceinline__ void cm_group(const CmStep& p, int r, int q, LAS unsigned char* Vl, const bf16x8 (&kf)[4], CmQ& Q, const s16x4 (&lo)[4], const s16x4 (&hi)[4]) {
    f32x4 sA = (f32x4){0.f, 0.f, 0.f, 0.f}, sB = sA;
    sA = __builtin_amdgcn_mfma_f32_16x16x32_bf16(kf[0], Q.qf[0], sA, 0, 0, 0); sA = __builtin_amdgcn_mfma_f32_16x16x32_bf16(kf[1], Q.qf[1], sA, 0, 0, 0);
    sB = __builtin_amdgcn_mfma_f32_16x16x32_bf16(kf[2], Q.qf[0], sB, 0, 0, 0); sB = __builtin_amdgcn_mfma_f32_16x16x32_bf16(kf[3], Q.qf[1], sB, 0, 0, 0);
    float sv[8]; bool ok[8]; float mx = -1e30f;
    const int R = Q.tq - p.kbase - ((p.kk0 + 4 * q) << p.sl); const unsigned lim = (unsigned)min(p.window, Q.tq);
#pragma unroll
    for (int jj = 0; jj < 8; ++jj) {
        const int rel = R - ((((jj < 4) ? 0 : 16) + (jj & 3)) << p.sl);
        ok[jj] = ((unsigned)rel <= lim) && ((rel & p.dmask) == 0);
        sv[jj] = ok[jj] ? (jj < 4 ? sA[jj & 3] : sB[jj & 3]) : -1e30f; mx = fmaxf(mx, sv[jj]);
    }
    mx = fmaxf(mx, __shfl_xor(mx, 16)); mx = fmaxf(mx, __shfl_xor(mx, 32));
    const float mnew = fmaxf(Q.mrun, mx), alpha = fexp2(Q.mrun - mnew); Q.mrun = mnew;
    float pp[8], ps = 0.f;
#pragma unroll
    for (int jj = 0; jj < 8; ++jj) { pp[jj] = ok[jj] ? fexp2(sv[jj] - mnew) : 0.f; ps += pp[jj]; }
    Q.lpart = Q.lpart * alpha + ps;
    v4u pw; pw.x = pk2(pp[0], pp[1]); pw.y = pk2(pp[2], pp[3]); pw.z = pk2(pp[4], pp[5]); pw.w = pk2(pp[6], pp[7]);
    const bf16x8 pf = __builtin_bit_cast(bf16x8, pw);
    const bool resc = __any(alpha != 1.f);
#pragma unroll
    for (int dt = 0; dt < 4; ++dt) {
        const bf16x8 vf = (bf16x8){lo[dt][0], lo[dt][1], lo[dt][2], lo[dt][3], hi[dt][0], hi[dt][1], hi[dt][2], hi[dt][3]};
        if (resc) Q.o[dt] = Q.o[dt] * alpha;
        Q.o[dt] = __builtin_amdgcn_mfma_f32_16x16x32_bf16(vf, pf, Q.o[dt], 0, 0, 0);
    }
}
__device__ __forceinline__ void cm_compute(int j, int T0, int wid, int r, int q, int vkey, int vch, LAS unsigned char* Vl, const bf16x8 (&kf)[4], const bf16x8 (&vv)[4], CmQ (&Q)[CM_NG]) {
    if (j >= CM_NSTEP) return;
    const CmStep p = cm_step(j, T0, wid);
    const int klo = p.kbase + (p.kk0 << p.sl), khi = p.kbase + ((p.kk0 + 31) << p.sl);
    if (khi < 0) return;
    bool act[CM_NG]; bool any = false;
#pragma unroll
    for (int g = 0; g < CM_NG; ++g) { const int qlo = T0 + 128 * g + wid; act[g] = (khi >= qlo - p.window) && (klo <= qlo + 120); any |= act[g]; }
    if (!any) return;
#pragma unroll
    for (int c = 0; c < 4; ++c) *(LAS bf16x8*)(Vl + (vkey + 8 * c) * CM_PB + vch * 16) = vv[c];
    asm volatile("s_waitcnt lgkmcnt(0)" ::: "memory");
    typedef short v4i16_t __attribute__((ext_vector_type(4)));
    LAS unsigned char* tp = Vl + (4 * q + ((r >> 2) & 3)) * CM_PB + (r & 3) * 8;
    s16x4 lo[4], hi[4];
#pragma unroll
    for (int dt = 0; dt < 4; ++dt) {
        lo[dt] = __builtin_bit_cast(s16x4, __builtin_amdgcn_ds_read_tr16_b64_v4i16((LAS v4i16_t*)(tp + dt * 32)));
        hi[dt] = __builtin_bit_cast(s16x4, __builtin_amdgcn_ds_read_tr16_b64_v4i16((LAS v4i16_t*)(tp + 16 * CM_PB + dt * 32)));
    }
    asm volatile("s_waitcnt lgkmcnt(0)" ::: "memory");
#pragma unroll
    for (int g = 0; g < CM_NG; ++g) if (act[g]) cm_group(p, r, q, Vl, kf, Q[g], lo, hi);
}
__device__ __forceinline__ void cm_compute_sh(int j, int T0, int wid, int r, int q, const LAS unsigned char* Ksh, const LAS unsigned char* Vsh, int row0, CmQ (&Q)[CM_NG]) {
    const CmStep p = cm_step(j, T0, wid);
    const int klo = p.kbase + (p.kk0 << p.sl), khi = p.kbase + ((p.kk0 + 31) << p.sl);
    if (khi < 0) return;
    bool act[CM_NG]; bool any = false;
#pragma unroll
    for (int g = 0; g < CM_NG; ++g) { const int qlo = T0 + 128 * g + wid; act[g] = (khi >= qlo - p.window) && (klo <= qlo + 120); any |= act[g]; }
    if (!any) return;
    typedef short v4i16_t __attribute__((ext_vector_type(4)));
    bf16x8 kf[4];
    const LAS unsigned char* kp = Ksh + (row0 + r) * CM_PB + q * 16;
    kf[0] = *(const LAS bf16x8*)kp; kf[1] = *(const LAS bf16x8*)(kp + 64); kf[2] = *(const LAS bf16x8*)(kp + 16 * CM_PB); kf[3] = *(const LAS bf16x8*)(kp + 16 * CM_PB + 64);
    const LAS unsigned char* tp = Vsh + (row0 + 4 * q + ((r >> 2) & 3)) * CM_PB + (r & 3) * 8;
    s16x4 lo[4], hi[4];
#pragma unroll
    for (int dt = 0; dt < 4; ++dt) {
        lo[dt] = __builtin_bit_cast(s16x4, __builtin_amdgcn_ds_read_tr16_b64_v4i16((LAS v4i16_t*)(tp + dt * 32)));
        hi[dt] = __builtin_bit_cast(s16x4, __builtin_amdgcn_ds_read_tr16_b64_v4i16((LAS v4i16_t*)(tp + 16 * CM_PB + dt * 32)));
    }
    asm volatile("s_waitcnt lgkmcnt(0)" ::: "memory");
#pragma unroll
    for (int g = 0; g < CM_NG; ++g) if (act[g]) cm_group(p, r, q, nullptr, kf, Q[g], lo, hi);
}
__device__ __forceinline__ void cm_init(CmQ& Q, int tq, int h, int q, const bf16* CQ) {
    Q.tq = tq; Q.mrun = -1e30f; Q.lpart = 0.f;
#pragma unroll
    for (int ks = 0; ks < 2; ++ks) Q.qf[ks] = *(const bf16x8*)(CQ + (size_t)tq * 512 + h * 64 + ks * 32 + q * 8);
#pragma unroll
    for (int dt = 0; dt < 4; ++dt) Q.o[dt] = (f32x4){0.f, 0.f, 0.f, 0.f};
}
__device__ __forceinline__ void cm_store(const CmQ& Q, int h, int q, bf16* CZ) {
    float l = Q.lpart; l += __shfl_xor(l, 16); l += __shfl_xor(l, 32);
    const float inv = 1.f / l;
#pragma unroll
    for (int dt = 0; dt < 4; ++dt) {
        const size_t off = (size_t)Q.tq * YP + h * 64 + dt * 16 + 4 * q;
        const v2u zz = *(const v2u*)(CZ + off);
        v2u w; w.x = pk2(Q.o[dt][0] * inv * bflo(zz.x), Q.o[dt][1] * inv * bfhi(zz.x)); w.y = pk2(Q.o[dt][2] * inv * bflo(zz.y), Q.o[dt][3] * inv * bfhi(zz.y));
        *(v2u*)(CZ + off) = w;
    }
}
__device__ __forceinline__ void cmix_item(int tb, int h, const bf16* CQ, const bf16* CK, const bf16* CV, bf16* CZ, LAS unsigned char* lds_blk, int tid, int wid, int lane) {
    const int r = lane & 15, q = lane >> 4, T0 = tb * CM_BLK;
    LAS unsigned char* ldsw = lds_blk + wid * 8192; LAS unsigned char* Ksh = lds_blk + 65536; LAS unsigned char* Vsh = Ksh + 128 * CM_PB;
    CmQ Q[CM_NG];
#pragma unroll
    for (int g = 0; g < CM_NG; ++g) cm_init(Q[g], T0 + 128 * g + wid + 8 * r, h, q, CQ);
    constexpr int NCH = CM_S0 / 4;
    bf16x8 kreg[2], vreg[2];
    auto ld_chunk = [&](int c) {
#pragma unroll
        for (int i = 0; i < 2; ++i) { const int idx = tid + 512 * i, key = idx >> 3, ch = idx & 7; int tk = T0 - 128 + 128 * c + key; tk = min(max(tk, 0), SEQ - 1);
            kreg[i] = *(const bf16x8*)(CK + (size_t)tk * 512 + h * 64 + ch * 8); vreg[i] = *(const bf16x8*)(CV + (size_t)tk * 512 + h * 64 + ch * 8); }
    };
    ld_chunk(0);
#pragma unroll 1
    for (int c = 0; c < NCH; ++c) {
        __syncthreads();
#pragma unroll
        for (int i = 0; i < 2; ++i) { const int idx = tid + 512 * i, key = idx >> 3, ch = idx & 7; *(LAS bf16x8*)(Ksh + key * CM_PB + ch * 16) = kreg[i]; *(LAS bf16x8*)(Vsh + key * CM_PB + ch * 16) = vreg[i]; }
        __syncthreads();
        if (c + 1 < NCH) ld_chunk(c + 1);
#pragma unroll 1
        for (int st = 0; st < 4; ++st) cm_compute_sh(4 * c + st, T0, wid, r, q, Ksh, Vsh, 32 * st, Q);
    }
    const int vkey = lane >> 3, vch = lane & 7;
    bf16x8 K0[4], V0[4], K1[4], V1[4];
    cm_load(CM_S0, T0, wid, h, r, q, vkey, vch, CK, CV, K0, V0);
#pragma unroll 1
    for (int j = CM_S0; j < CM_NSTEP; j += 2) {
        cm_load(j + 1, T0, wid, h, r, q, vkey, vch, CK, CV, K1, V1); cm_compute(j, T0, wid, r, q, vkey, vch, ldsw, K0, V0, Q);
        cm_load(j + 2, T0, wid, h, r, q, vkey, vch, CK, CV, K0, V0); cm_compute(j + 1, T0, wid, r, q, vkey, vch, ldsw, K1, V1, Q);
    }
#pragma unroll
    for (int g = 0; g < CM_NG; ++g) cm_store(Q[g], h, q, CZ);
}

#define RLX_AGENT __ATOMIC_RELAXED, __HIP_MEMORY_SCOPE_AGENT
#define XB_TMO      128
#define XB_XCNT(j)  (256  + 64 * (j))
#define XB_XSUB(j)  (1280 + 64 * (j))
#define XB_XGEN(j)  (2304 + 64 * (j))
#define XB_TOP      3328
#define XB_TOPGEN   3392
#define XCD_BAR_WORDS 3456
#define XB_SPIN_CAP (1u << 18)

__device__ __forceinline__ unsigned xb_ld(unsigned* p)              { return __hip_atomic_load(p, __ATOMIC_RELAXED, __HIP_MEMORY_SCOPE_AGENT); }
__device__ __forceinline__ unsigned xb_add(unsigned* p, unsigned v) { return __hip_atomic_fetch_add(p, v, __ATOMIC_RELAXED, __HIP_MEMORY_SCOPE_AGENT); }
__device__ __forceinline__ unsigned xb_xcc_id() { return (unsigned)__builtin_amdgcn_s_getreg((3 << 11) | 20) & 0xFu; }
#define XB_SPIN(cond, bar) do { unsigned _sp = 0; while (cond) { __builtin_amdgcn_s_sleep(1); \
    if ((++_sp & 255u) == 0u) { if (xb_ld(&(bar)[XB_TMO])) break; if (_sp > XB_SPIN_CAP) { atomicAdd(&(bar)[XB_TMO], 1u); break; } } } } while (0)

struct XcdBarrier {
    unsigned* bar; unsigned x; int wave;
    volatile LAS unsigned* st;
};

__device__ __forceinline__ XcdBarrier xcd_barrier_post(unsigned* bar, volatile LAS unsigned* st, int wave) {
    XcdBarrier b; b.bar = bar; b.x = xb_xcc_id(); b.st = st; b.wave = wave;
    if (wave == 0 && mk_lane() == 0) (void)xb_add(&bar[XB_XCNT(b.x)], 1u);
    return b;
}
__device__ __forceinline__ void xcd_barrier_complete(unsigned* bar, unsigned x, unsigned& nloc, unsigned& nx) {
    const unsigned G = gridDim.x * gridDim.y * gridDim.z;
    unsigned sum, cnt, mine, sp = 0u;
    for (;;) {
        sum = 0u; cnt = 0u; mine = 0u;
#pragma unroll
        for (unsigned j = 0; j < 16; ++j) { const unsigned c = xb_ld(&bar[XB_XCNT(j)]); sum += c; cnt += (c > 0u) ? 1u : 0u; mine = (j == x) ? c : mine; }
        if (sum == G) break;
        __builtin_amdgcn_s_sleep(1);
        if ((++sp & 255u) == 0u) { if (xb_ld(&bar[XB_TMO])) break; if (sp > XB_SPIN_CAP) { atomicAdd(&bar[XB_TMO], 1u); break; } }
    }
    nloc = mine > 0u ? mine : 1u; nx = cnt > 0u ? cnt : 1u;
}

__device__ __forceinline__ void xcd_barrier(const XcdBarrier& b) {
    asm volatile("s_waitcnt vmcnt(0)" ::: "memory");
    __syncthreads();
    if (b.wave == 0 && mk_lane() == 0) {
        unsigned* bar = b.bar;
        __builtin_amdgcn_s_waitcnt(0);
        unsigned nloc = b.st[0], nx = b.st[1];
        if (nloc == 0u) { xcd_barrier_complete(bar, b.x, nloc, nx); b.st[0] = nloc; b.st[1] = nx; }
        const unsigned old = xb_add(&bar[XB_XSUB(b.x)], 1u);
        const unsigned gen = old / nloc;
        if (old + 1u == (gen + 1u) * nloc) {
            __builtin_amdgcn_fence(__ATOMIC_RELEASE, "agent");
            asm volatile("s_waitcnt vmcnt(0)" ::: "memory");
            const unsigned og = xb_add(&bar[XB_TOP], 1u);
            const unsigned tg = og / nx;
            if (og + 1u == (tg + 1u) * nx) xb_add(&bar[XB_TOPGEN], 1u);
            else XB_SPIN(xb_ld(&bar[XB_TOPGEN]) == tg, bar);
            __builtin_amdgcn_fence(__ATOMIC_ACQUIRE, "agent");
            xb_add(&bar[XB_XGEN(b.x)], 1u);
            asm volatile("s_waitcnt vmcnt(0)" ::: "memory");
        } else {
            XB_SPIN(xb_ld(&bar[XB_XGEN(b.x)]) == gen, bar);
            __builtin_amdgcn_fence(__ATOMIC_ACQUIRE, "agent");
            asm volatile("s_waitcnt vmcnt(0)" ::: "memory");
        }
    }
    __syncthreads();
}

struct Args { const void* in[16]; float* out; unsigned char* ws; int ph_lo, ph_hi; };
constexpr int N_PHASES = 6 * DEPTH + 1;

__global__ void __launch_bounds__(NWAVES * 64, 2) trunk_fwd(Args args) {
    extern __shared__ __attribute__((aligned(16))) unsigned char lds[];
    LAS unsigned char* L = (LAS unsigned char*)lds;
#define FRESH_TID() const int tid = mk_tid(wave0), lane = tid & 63, wid = __builtin_amdgcn_readfirstlane(tid >> 6); const int gw = vcu * NWAVES + wid; (void)tid; (void)lane; (void)gw
    const int wave0 = __builtin_amdgcn_readfirstlane((int)threadIdx.x >> 6);
    const int G = gridDim.x, bx = blockIdx.x;
    const int vcu = (G % 8 == 0) ? (bx % 8) * (G / 8) + bx / 8 : bx;
    const int NGW = G * NWAVES;
    unsigned char* ws = args.ws;
    const float* x_in = (const float*)args.in[0]; const int* pos = (const int*)args.in[1];
    float* out = args.out;
    float* ropec = (float*)(ws + WS_ROPE); float* ropes = ropec + SEQ * 8;
    bf16* WinT = (bf16*)(ws + WS_WIN); bf16* WbT = (bf16*)(ws + WS_WB); bf16* WoT = (bf16*)(ws + WS_WO);
    bf16* HB = (bf16*)(ws + WS_HB); bf16* OB = (bf16*)(ws + WS_O); bf16* PJ = (bf16*)(ws + WS_PJ);
    bf16* GL = PJ;
    const int lo = args.ph_lo, hi = args.ph_hi;
#define IN(k) (lo <= (k) && (k) < hi)
#ifdef PROBE_S1A
#define MARK(i) do { if (blockIdx.x == 0 && wave0 == 0 && mk_lane() == 0) ((LAS unsigned long long*)(L + LDS_BYTES - 512))[i] = __builtin_amdgcn_s_memrealtime(); } while (0)
#define MARKG(i) do { if (wave0 == 0 && mk_lane() == 0) atomicMax((unsigned long long*)(ws + WS_BAR + 32768) + (i), (unsigned long long)__builtin_amdgcn_s_memrealtime()); } while (0)
#else
#define MARK(i) do {} while (0)
#define MARKG(i) do {} while (0)
#endif
#define SEAM(k) do { if (IN(k) && IN((k) + 1)) { xcd_barrier(xbar); } MARK((k) + 1); } while (0)

    MARK(0);
    XcdBarrier xbar; xbar.bar = (unsigned*)(ws + WS_BAR); xbar.x = 0; xbar.wave = wave0; xbar.st = (volatile LAS unsigned*)(L + LDS_BYTES - 1024);
    {
        if (wave0 == 0 && mk_lane() < 2) ((LAS unsigned*)(L + LDS_BYTES - 1024))[mk_lane()] = 0u;
        __syncthreads();
        if (hi - lo > 1) xbar = xcd_barrier_post((unsigned*)(ws + WS_BAR), (volatile LAS unsigned*)(L + LDS_BYTES - 1024), wave0);
        if (lo < 0) cg::this_grid().sync();
    }
    for (int layer = 0; layer < DEPTH; ++layer) {
        const int pb = 6 * layer;
        const float* xsrc = layer == 0 ? x_in : out;
#ifndef SKIP_P0
        if (IN(pb + 0)) {
            FRESH_TID();
            const float* w_in = (const float*)args.in[3] + (size_t)layer * DM * NIN;
            const float* w_br = (const float*)args.in[13] + (size_t)layer * 3 * 512 * DM;
            const float* w_out = (const float*)args.in[14] + (size_t)layer * DM * DM;
            const float* ng = (const float*)args.in[2] + layer * DM;
            LAS float* scr = (LAS float*)(L + wid * 16384);
            constexpr int I_IN = (DM / 64) * (NIN / 32), I_B = (512 / 64) * (DM / 32), I_O = (DM / 64) * (DM / 32);
            constexpr int NITEMS = I_IN + 3 * I_B + I_O;
            for (int it = gw; it < NITEMS; it += NGW) {
                int r = it;
                if (r < I_IN) { p0_transpose_item(w_in, DM, NIN, WinT, DM, scr, r, lane); continue; } r -= I_IN;
                if (r < 3 * I_B) { const int br = r / I_B; p0_transpose_item(w_br + (size_t)br * 512 * DM, 512, DM, WbT + br * 512, YP, scr, r % I_B, lane); continue; } r -= 3 * I_B;
                p0_transpose_item(w_out, DM, DM, WoT, DM, scr, r, lane);
            }
            for (int m = gw; m < SEQ; m += 4 * NGW) rms_rows<4, true>(xsrc + (size_t)m * DM, (size_t)NGW * DM, ng, HB + (size_t)m * DM, lane);
            if (layer == 0) {
                for (int idx = (vcu * NWAVES * 64) + tid; idx < SEQ * 8; idx += G * NWAVES * 64) {
                    const int tok = idx >> 3, i = idx & 7;
                    const float ang = (float)pos[tok] * __builtin_amdgcn_exp2f(-(float)i * (18.931568569324174f / 8.0f));
                    const double rev = (double)ang * 0.15915494309189535; const double fr_ = rev - __builtin_rint(rev);
                    ropec[idx] = __builtin_amdgcn_cosf((float)fr_); ropes[idx] = __builtin_amdgcn_sinf((float)fr_);
                }
            }
        }
#endif
        SEAM(pb + 0);
#ifndef SKIP_P1
        if (IN(pb + 1)) {
            pg8::Gemm g{HB, WinT, SEQ, NMAIN, DM}; pg8::StaticOrder S; S.init(SEQ, NMAIN, G, bx);
            EpiProj E{PJ, ropec, ropes};
            pg8::gemm_phase<EpiProj, pg8::StaticOrder, true, true>(L, g, S, E, pg8::NoHook(), wave0);
        }
#endif
        SEAM(pb + 1);
        if (IN(pb + 2)) {
#ifndef SKIP_ATT
            {
                const int hm = vcu >> 5, s = vcu & 31;
                const int nit = (G == 256) ? 2 : (vcu < 512 ? (512 - vcu + G - 1) / G : 0);
                for (int i = 0; i < nit; ++i) {
                    int hm2, qb; if (G == 256) { hm2 = hm; qb = i ? 63 - s : s; } else { const int u = vcu + i * G; hm2 = u >> 6; qb = u & 63; }
                    attn_body::attn_unit<8>(qb, (const attn_body::bf16*)(PJ + SL_AQ * SLOT_ELEMS) + hm2 * 64, (const attn_body::bf16*)(PJ + SL_AK * SLOT_ELEMS) + hm2 * 64,
                                            (const attn_body::bf16*)(PJ + SL_AV * SLOT_ELEMS) + (hm2 >> 1) * 128, (attn_body::bf16*)OB + hm2 * 128, (char*)lds, wave0);
                }
            }
#endif
            if (layer == 0) { MARK(20); MARKG(0); }
#ifndef SKIP_CMIX
            {
                FRESH_TID();
                for (int it = vcu; it < (SEQ / CM_BLK) * 8; it += G) cmix_item(it & (SEQ / CM_BLK - 1), it / (SEQ / CM_BLK),     PJ + SL_CQ * SLOT_ELEMS, PJ + SL_CK * SLOT_ELEMS, PJ + SL_CV * SLOT_ELEMS, PJ + SL_AZ * SLOT_ELEMS + 1024, L, tid, wid, lane);
                __syncthreads();
            }
#endif
            if (layer == 0) { MARK(21); MARKG(1); }
#ifndef SKIP_SGU
            {
                FRESH_TID();
                const float* lng = (const float*)args.in[9] + layer * 512; const float* lnb = (const float*)args.in[10] + layer * 512;
                const float* sw = (const float*)args.in[11] + (size_t)layer * 4 * 128 * 128; const float* sb = (const float*)args.in[12] + layer * 4 * 128;
                unsigned* qctr = (unsigned*)(ws + WS_BAR + 40960) + layer * 64;
                volatile LAS unsigned* qword = (volatile LAS unsigned*)(L + LDS_BYTES - 768);
                for (;;) {
                    if (tid == 0) *qword = xb_add(qctr, 1u);
                    __syncthreads();
                    const unsigned it = *qword;
                    __syncthreads();
                    if (it >= 512u) break;
                    sgu_item((int)it, PJ + SL_BU * SLOT_ELEMS, PJ + SL_BV * SLOT_ELEMS, PJ + SL_AZ * SLOT_ELEMS + 512, lng, lnb, sw, sb, L, tid, wid, lane);
                }
            }
#endif
            if (layer == 0) { MARK(22); MARKG(2); }
        }
        SEAM(pb + 2);
#ifndef SKIP_P3
        if (IN(pb + 3)) {
            { FRESH_TID();
            const float lam_init = 0.8f - 0.6f * __expf(-0.3f * (float)layer);
            const float* lq1 = (const float*)args.in[4] + layer * 64; const float* lk1 = (const float*)args.in[5] + layer * 64;
            const float* lq2 = (const float*)args.in[6] + layer * 64; const float* lk2 = (const float*)args.in[7] + layer * 64;
            const float lam = __expf(wave_sum(lq1[lane] * lk1[lane])) - __expf(wave_sum(lq2[lane] * lk2[lane])) + lam_init;
            const float* sg = (const float*)args.in[8] + layer * 128;
            const int e0 = (lane & 15) * 8, hh = lane >> 4;
            const f32x4 g0 = *(const f32x4*)(sg + e0), g1 = *(const f32x4*)(sg + e0 + 4);
            bf16* AZ = PJ + SL_AZ * SLOT_ELEMS;
            for (int m0 = gw; m0 < SEQ; m0 += 4 * NGW) {
                v4u A4[4], B4[4], Z4[4];
#pragma unroll
                for (int k = 0; k < 4; ++k) { const size_t m = (size_t)m0 + (size_t)k * NGW;
                    A4[k] = *(const v4u*)(OB + m * DM + hh * 256 + e0); B4[k] = *(const v4u*)(OB + m * DM + hh * 256 + 128 + e0); Z4[k] = *(const v4u*)(AZ + m * YP + hh * 128 + e0); }
#pragma unroll
                for (int k = 0; k < 4; ++k) { const size_t m = (size_t)m0 + (size_t)k * NGW; const v4u a = A4[k], b = B4[k], z = Z4[k];
                float d[8] = {bflo(a.x) - lam * bflo(b.x), bfhi(a.x) - lam * bfhi(b.x), bflo(a.y) - lam * bflo(b.y), bfhi(a.y) - lam * bfhi(b.y),
                              bflo(a.z) - lam * bflo(b.z), bfhi(a.z) - lam * bfhi(b.z), bflo(a.w) - lam * bflo(b.w), bfhi(a.w) - lam * bfhi(b.w)};
                float ss = 0.f;
#pragma unroll
                for (int e = 0; e < 8; ++e) ss += d[e] * d[e];
                ss += __shfl_xor(ss, 1); ss += __shfl_xor(ss, 2); ss += __shfl_xor(ss, 4); ss += __shfl_xor(ss, 8);
                const float rr = (1.f / sqrtf(ss * (1.f / 128.f) + EPS)) * (1.f - lam_init);
                v4u w; w.x = pk2(d[0] * rr * g0[0] * bflo(z.x), d[1] * rr * g0[1] * bfhi(z.x)); w.y = pk2(d[2] * rr * g0[2] * bflo(z.y), d[3] * rr * g0[3] * bfhi(z.y));
                w.z = pk2(d[4] * rr * g1[0] * bflo(z.z), d[5] * rr * g1[1] * bfhi(z.z)); w.w = pk2(d[6] * rr * g1[2] * bflo(z.w), d[7] * rr * g1[3] * bfhi(z.w));
                *(v4u*)(AZ + m * YP + hh * 128 + e0) = w; }
            } }
            asm volatile("s_waitcnt vmcnt(0) lgkmcnt(0)" ::: "memory"); __syncthreads();
            pg8::Gemm g{HB, WinT + (size_t)NMAIN * DM, SEQ, NGATE, DM}; pg8::StaticOrder S; S.init(SEQ, NGATE, G, bx);
            EpiGate E{GL};
            pg8::gemm_phase<EpiGate, pg8::StaticOrder, true, true>(L, g, S, E, pg8::NoHook(), wave0);
        }
#endif
        SEAM(pb + 3);
#ifndef SKIP_P4
        if (IN(pb + 4)) {
            pg8::StaticOrder S; S.init(SEQ, DM, G, bx);
            pg8::Gemm g{PJ + (size_t)SL_AZ * SLOT_ELEMS, WbT, SEQ, DM, YP}; EpiMerge E{GL, OB}; MergeHook H{GL};
            pg8::gemm_phase<EpiMerge, pg8::StaticOrder, false, true, MergeHook>(L, g, S, E, H, wave0);
        }
#endif
        SEAM(pb + 4);
#ifdef PROBE_S1A
        if (layer == 0 && IN(pb + 4) && IN(pb + 5)) { MARK(23); xcd_barrier(xbar); MARK(24); }
#endif
#ifndef SKIP_P5
        if (IN(pb + 5)) {
            pg8::Gemm g{OB, WoT, SEQ, DM, DM}; pg8::StaticOrder S; S.init(SEQ, DM, G, bx);
            EpiOut E{xsrc, out};
            pg8::gemm_phase<EpiOut, pg8::StaticOrder, false, true>(L, g, S, E, pg8::NoHook(), wave0);
        }
#endif
        SEAM(pb + 5);
    }
    if (IN(6 * DEPTH)) {
        FRESH_TID();
        const float* fg = (const float*)args.in[15];
        for (int m = gw; m < SEQ; m += 4 * NGW) rms_rows<4, false>(out + (size_t)m * DM, (size_t)NGW * DM, fg, out + (size_t)m * DM, lane);
    }
#ifdef PROBE_S1A
    MARK(13);
    __syncthreads();
    if (blockIdx.x == 0 && wave0 == 0 && mk_lane() == 0) {
        LAS unsigned long long* T = (LAS unsigned long long*)(L + LDS_BYTES - 512);
        for (int i = 0; i < 3; ++i) T[40 + i] = __hip_atomic_load((unsigned long long*)(ws + WS_BAR + 32768) + i, __ATOMIC_RELAXED, __HIP_MEMORY_SCOPE_AGENT);
        const unsigned long long s1 = T[PROBE_S1B] - T[PROBE_S1A], s2 = T[PROBE_S2B] - T[PROBE_S2A];
        const unsigned long long spin = 4ull * s1 + 300000ull * ((s2 + 1000ull) / 2000ull);
        const unsigned long long t0 = __builtin_amdgcn_s_memrealtime();
        while (__builtin_amdgcn_s_memrealtime() - t0 < spin) __builtin_amdgcn_s_sleep(8);
    }
#endif
#undef IN
#undef SEAM
}

extern "C" void kernel_launch(void* const* d_in, const int* in_sizes, int n_in, void* d_out, int out_size, void* d_ws, size_t ws_size, hipStream_t stream) {
    static int grid = 0;
    if (grid == 0) {
        if (n_in != 16 || out_size != SEQ * DM || ws_size < WS_END) { fprintf(stderr, "kernel_launch: unexpected shapes (n_in %d out %d ws %zu need %zu)\n", n_in, out_size, ws_size, (size_t)WS_END); grid = -1; return; }
        int dev = 0, cus = 0, per_cu = 0;
        hipGetDevice(&dev); hipDeviceGetAttribute(&cus, hipDeviceAttributeMultiprocessorCount, dev);
        if (hipFuncSetAttribute((const void*)trunk_fwd, hipFuncAttributeMaxDynamicSharedMemorySize, LDS_BYTES) != hipSuccess) { fprintf(stderr, "kernel_launch: hipFuncSetAttribute failed\n"); grid = -1; return; }
        hipOccupancyMaxActiveBlocksPerMultiprocessor(&per_cu, (const void*)trunk_fwd, NWAVES * 64, LDS_BYTES);
        (void)hipGetLastError();
        if (per_cu < 1) per_cu = 1;
        grid = cus * (per_cu > 1 ? 1 : per_cu);
        fprintf(stderr, "kernel_launch: grid %d (cus %d per_cu %d)\n", grid, cus, per_cu);
    }
    if (grid < 0) return;
    Args a{};
    for (int i = 0; i < 16; ++i) a.in[i] = d_in[i];
    a.out = (float*)d_out; a.ws = (unsigned char*)d_ws;
#if MK_ONE_LAUNCH
    if (hipMemsetAsync((unsigned char*)d_ws + WS_BAR, 0, 65536, stream) != hipSuccess) { fprintf(stderr, "kernel_launch: memset failed\n"); return; }
    a.ph_lo = 0; a.ph_hi = N_PHASES;
    void* kargs[] = {&a};
    hipError_t e = hipLaunchCooperativeKernel((const void*)trunk_fwd, dim3(grid), dim3(NWAVES * 64), kargs, LDS_BYTES, stream);
    if (e != hipSuccess) fprintf(stderr, "cooperative launch failed: %s (grid %d)\n", hipGetErrorString(e), grid);
#else
    for (int p = 0; p < N_PHASES; ++p) { a.ph_lo = p; a.ph_hi = p + 1; hipLaunchKernelGGL(trunk_fwd, dim3(grid), dim3(NWAVES * 64), LDS_BYTES, stream, a);
    }
#endif
}
```
